# Optimizing an MI355X kernel written in HIP

```python
import math
import jax, jax.numpy as jnp
from jax import lax
import numpy as np

D_MODEL = 1024
BATCH = 4
SEQ = 8192
DEPTH = 2

CTX_LEN = 256
GRID_W = 64
D_MIX = D_MODEL
D_CONV = D_MIX // 2
D_RWKV = D_MIX - D_CONV
RWKV_HEAD = 64
RWKV_HEADS = D_RWKV // RWKV_HEAD
W_LORA = 64
A_LORA = 64
G_LORA = 128
N_DIR = 2
D_FF = ((8 * D_MODEL // 3 + 127) // 128) * 128
PROJ = 3 * D_CONV + 3 * D_RWKV + W_LORA + A_LORA + G_LORA
RMS_EPS = 1e-6
GN_EPS = 64e-5
DECAY_SCALE = math.exp(-0.5)

kernel_name = "hybrid_conv_rwkv7_convffn_dit"


def rms_norm(x, g):
    xf = x.astype(jnp.float32)
    y = xf * lax.rsqrt(jnp.mean(xf * xf, axis=-1, keepdims=True) + RMS_EPS)
    return (y * g.astype(jnp.float32)).astype(x.dtype)


def modulate(h, shift, scale):
    return h * (1 + scale) + shift


def split_proj(p):
    sizes = (D_CONV, D_CONV, D_CONV, D_RWKV, D_RWKV, D_RWKV, W_LORA, A_LORA, G_LORA)
    idx = [int(i) for i in np.cumsum(sizes)[:-1]]
    return jnp.split(p, idx, axis=-1)


def shortconv1d(u, w):
    up = jnp.pad(u, ((0, 0), (1, 1), (0, 0)))
    return up[:, :-2] * w[0] + up[:, 1:-1] * w[1] + up[:, 2:] * w[2]


def dwconv_grid(u, w, b, rows, cols):
    bsz, t, ch = u.shape
    img = u.reshape(bsz, rows, cols, ch)
    out = lax.conv_general_dilated(img, w[:, :, None, :].astype(u.dtype), (1, 1), "SAME",
                                   dimension_numbers=("NHWC", "HWIO", "NHWC"),
                                   feature_group_count=ch)
    return out.reshape(bsz, t, ch) + b


def to_heads(t):
    return t.astype(jnp.float32).reshape(t.shape[0], t.shape[1], RWKV_HEADS, RWKV_HEAD)


def wkv_scan(state0, r, decay, kk, b, v, k, reverse):
    def step(S, inp):
        r_t, w_t, kk_t, b_t, v_t, k_t = inp
        sa = jnp.einsum("bhvk,bhk->bhv", S, kk_t)
        S = (S * w_t[:, :, None, :] - sa[..., None] * b_t[:, :, None, :]
             + v_t[..., None] * k_t[:, :, None, :])
        return S, jnp.einsum("bhvk,bhk->bhv", S, r_t)
    xs = tuple(jnp.swapaxes(t, 0, 1) for t in (r, decay, kk, b, v, k))
    S, ys = lax.scan(step, state0, xs, reverse=reverse)
    return S, jnp.swapaxes(ys, 0, 1)


def rwkv_scans(r, k, v, w_lo, a_lo, lp, init):
    kk = to_heads(k * lp["k_k"])
    kk = kk * lax.rsqrt(jnp.maximum(jnp.sum(kk * kk, axis=-1, keepdims=True), 1e-24))
    rh, vh = to_heads(r), to_heads(v)
    y_sum = None
    finals = []
    for d in range(N_DIR):
        decay = jnp.exp(-DECAY_SCALE * jax.nn.sigmoid(lp["w0"][d] + jnp.tanh(w_lo) @ lp["w_up"][d]))
        a = jax.nn.sigmoid(lp["a0"][d] + a_lo @ lp["a_up"][d])
        k_d = k * (1 + (a - 1) * lp["k_a"])
        state, y = wkv_scan(init[d], rh, to_heads(decay), kk, kk * to_heads(a), vh, to_heads(k_d),
                            reverse=(d == 1))
        y_sum = y if y_sum is None else y_sum + y
        finals.append(state)
    return y_sum, finals


def rwkv_output(y, r, k, v, g_lo, lp):
    bsz, t = y.shape[:2]
    mu = jnp.mean(y, axis=-1, keepdims=True)
    var = jnp.mean(jnp.square(y - mu), axis=-1, keepdims=True)
    yn = ((y - mu) * lax.rsqrt(var + GN_EPS)).reshape(bsz, t, D_RWKV) * lp["ln_g"] + lp["ln_b"]
    bonus = jnp.sum(to_heads(r) * to_heads(k) * lp["r_k"].astype(jnp.float32), axis=-1, keepdims=True) * to_heads(v)
    gate = jax.nn.sigmoid(g_lo) @ lp["g_up"]
    return ((yn + bonus.reshape(bsz, t, D_RWKV)) * gate).astype(r.dtype)


def mixer_block(h, lp, init, need_output):
    cb, cc, cx, r, k, v, w_lo, a_lo, g_lo = split_proj(h @ lp["w_in"])
    y, finals = rwkv_scans(r, k, v, w_lo, a_lo, lp, init)
    if not need_output:
        return None, finals
    y_conv = cb * shortconv1d(cc * cx, lp["conv_a_w"])
    y_rwkv = rwkv_output(y, r, k, v, g_lo, lp)
    return jnp.concatenate([y_conv, y_rwkv], axis=-1) @ lp["w_out"], finals


def conv_ffn(h, lp, rows, cols):
    gate, val = jnp.split(h @ lp["ffn_w_up"], 2, axis=-1)
    gate = dwconv_grid(gate, lp["ffn_conv_w"], lp["ffn_conv_b"], rows, cols)
    return (jax.nn.silu(gate) * val) @ lp["ffn_w_down"]


def setup_inputs(seed: int = 0) -> dict:
    key = jax.random.key(seed)
    ks = jax.random.split(key, 32)
    L, D = DEPTH, D_MODEL

    def nrm(k, shape, s):
        return jax.random.normal(k, shape, jnp.float32) * s

    return {
        "x": nrm(ks[0], (BATCH, SEQ, D), 1.0),
        "c": nrm(ks[1], (BATCH, D), 1.0),
        "ctx": nrm(ks[2], (BATCH, CTX_LEN, D), 1.0),
        "c_ctx": nrm(ks[3], (D,), 1.0),
        "ada_w": nrm(ks[4], (L, D, 6 * D), 0.5 * D ** -0.5),
        "ada_b": nrm(ks[5], (L, 6 * D), 0.01),
        "norm1_g": 1.0 + nrm(ks[6], (L, D), 0.1),
        "norm2_g": 1.0 + nrm(ks[7], (L, D), 0.1),
        "w_in": nrm(ks[8], (L, D, PROJ), D ** -0.5),
        "conv_a_w": nrm(ks[9], (L, 3, D_CONV), 3 ** -0.5),
        "rw_w0": nrm(ks[10], (L, N_DIR, D_RWKV), 0.5),
        "rw_w_up": nrm(ks[11], (L, N_DIR, W_LORA, D_RWKV), 0.5 * W_LORA ** -0.5),
        "rw_a0": nrm(ks[12], (L, N_DIR, D_RWKV), 0.5),
        "rw_a_up": nrm(ks[13], (L, N_DIR, A_LORA, D_RWKV), 0.5 * A_LORA ** -0.5),
        "rw_k_k": 0.85 + nrm(ks[14], (L, D_RWKV), 0.05),
        "rw_k_a": 1.0 + nrm(ks[15], (L, D_RWKV), 0.05),
        "rw_r_k": nrm(ks[16], (L, RWKV_HEADS, RWKV_HEAD), 0.1),
        "rw_g_up": nrm(ks[17], (L, G_LORA, D_RWKV), G_LORA ** -0.5),
        "rw_ln_g": 1.0 + nrm(ks[18], (L, D_RWKV), 0.1),
        "rw_ln_b": nrm(ks[19], (L, D_RWKV), 0.01),
        "w_out": nrm(ks[20], (L, D_MIX, D), D_MIX ** -0.5),
        "ffn_w_up": nrm(ks[21], (L, D, 2 * D_FF), D ** -0.5),
        "ffn_conv_w": nrm(ks[22], (L, 3, 3, D_FF), 1.0 / 3.0),
        "ffn_conv_b": nrm(ks[23], (L, D_FF), 0.01),
        "ffn_w_down": nrm(ks[24], (L, D_FF, D), D_FF ** -0.5),
        "final_g": 1.0 + nrm(ks[25], (D,), 0.1),
    }


def reference(x, c, ctx, c_ctx, ada_w, ada_b, norm1_g, norm2_g, w_in, conv_a_w,
              rw_w0, rw_w_up, rw_a0, rw_a_up, rw_k_k, rw_k_a, rw_r_k, rw_g_up, rw_ln_g, rw_ln_b,
              w_out, ffn_w_up, ffn_conv_w, ffn_conv_b, ffn_w_down, final_g):
    bsz = x.shape[0]
    rows = x.shape[1] // GRID_W
    zero_state = jnp.zeros((bsz, RWKV_HEADS, RWKV_HEAD, RWKV_HEAD), jnp.float32)
    for l in range(DEPTH):
        last = l == DEPTH - 1
        lp = {
            "w_in": w_in[l], "conv_a_w": conv_a_w[l], "w0": rw_w0[l], "w_up": rw_w_up[l],
            "a0": rw_a0[l], "a_up": rw_a_up[l], "k_k": rw_k_k[l], "k_a": rw_k_a[l],
            "r_k": rw_r_k[l], "g_up": rw_g_up[l], "ln_g": rw_ln_g[l], "ln_b": rw_ln_b[l],
            "w_out": w_out[l], "ffn_w_up": ffn_w_up[l], "ffn_conv_w": ffn_conv_w[l],
            "ffn_conv_b": ffn_conv_b[l], "ffn_w_down": ffn_w_down[l],
        }
        mod = jax.nn.silu(c) @ ada_w[l] + ada_b[l]
        sh1, sc1, g1, sh2, sc2, g2 = [m[:, None, :] for m in jnp.split(mod, 6, axis=-1)]
        csh1, csc1, cg1, csh2, csc2, cg2 = jnp.split(jax.nn.silu(c_ctx) @ ada_w[l] + ada_b[l], 6, axis=-1)

        hc = modulate(rms_norm(ctx, norm1_g[l]), csh1, csc1)
        out_c, ctx_states = mixer_block(hc, lp, (zero_state, zero_state), not last)

        hx = modulate(rms_norm(x, norm1_g[l]), sh1, sc1)
        out_x, _ = mixer_block(hx, lp, ctx_states, True)
        x = x + g1 * out_x
        hx = modulate(rms_norm(x, norm2_g[l]), sh2, sc2)
        x = x + g2 * conv_ffn(hx, lp, rows, GRID_W)

        if not last:
            ctx = ctx + cg1 * out_c
            hc = modulate(rms_norm(ctx, norm2_g[l]), csh2, csc2)
            ctx = ctx + cg2 * conv_ffn(hc, lp, 1, ctx.shape[1])
    return rms_norm(x, final_g)
```

```cpp
#include <hip/hip_runtime.h>
#include <cstdio>
#include <cstdint>
__device__ __forceinline__ int fresh_lane() { int z; asm volatile("v_mov_b32 %0, 0" : "=v"(z)); return (int)__builtin_amdgcn_mbcnt_hi(~0u, __builtin_amdgcn_mbcnt_lo(~0u, (unsigned)z)); }
namespace pg8 {
#define PG8_LAS __attribute__((address_space(3)))
typedef unsigned short bf16_t;
typedef short bf16x8 __attribute__((ext_vector_type(8)));
typedef float f32x4 __attribute__((ext_vector_type(4)));
typedef unsigned u32x4 __attribute__((ext_vector_type(4)));
constexpr int BM = 256, BK = 64, HALF = 128, HTB = HALF * BK * 2  , STAGE_BYTES = 8 * HTB, NXCD = 8, WGM = 8;

__host__ __device__ __forceinline__ int lds_byte(int r, int c) { const int st = (r >> 4) * 2 + (c >> 5), rr = r & 15, cc = c & 31, ob = rr * 64 + cc * 2; return st * 1024 + (ob ^ (((ob >> 9) & 1) << 5)); }
__host__ __device__ __forceinline__ void stage_rc(int b, int& R, int& C) { const int st = b / 1024, sb = b % 1024, swz = sb ^ (((sb >> 9) & 1) << 5); R = (st >> 1) * 16 + swz / 64; C = (st & 1) * 32 + (swz % 64) / 2; }
__host__ __device__ __forceinline__ int perm32(int rho) { const int n = rho >> 4, i = rho & 15; return 8 * (i >> 2) + 4 * n + (i & 3); }

struct Unit { int pm, pn; };
struct Gemm { const bf16_t* A; const bf16_t* Bt; int M, N, K; };

struct StaticOrder {
    int nM, nN, nwg, G, c;
    __host__ __device__ void init(int M, int N, int G_, int c_) { nM = M / BM; nN = N / BM; nwg = nM * nN; G = G_; c = c_; }
    __host__ __device__ bool next(int i, Unit& u) const {
        const long L = (long)i * G + c; if (L >= nwg) return false;
        int wgid = (int)L; { const int q = nwg / NXCD, r = nwg % NXCD, xcd = wgid % NXCD, off = wgid / NXCD; wgid = (xcd < r ? xcd * (q + 1) : r * (q + 1) + (xcd - r) * q) + off; }
        const int nig = WGM * nN, gid = wgid / nig, fm = gid * WGM, gsz = (nM - fm) < WGM ? (nM - fm) : WGM;
        u.pm = fm + ((wgid % nig) % gsz); u.pn = (wgid % nig) / gsz; return true;
    }
    __device__ __forceinline__ void a_ready(const Unit&) const {}
    __device__ __forceinline__ void done(const Unit&) const {}
};

template <class Epi, class Sched, bool ALIGN_EPI = false, bool SP2 = false>
__device__ __forceinline__ void gemm_phase(PG8_LAS unsigned char* lds, const Gemm g, const Sched& S, const Epi& E, const int wid_in) {
    const int wid = wid_in, lane = fresh_lane(), tid = wid * 64 + lane, wr = wid >> 2, wc = wid & 3, fr = lane & 15, fq = lane >> 4;
    const int K = g.K, nt = K / BK;
    unsigned voffA[2], voffB[2];
#pragma unroll
    for (int i = 0; i < 2; ++i) { int R, C; stage_rc(tid * 16 + i * 8192, R, C); const int Rb = Epi::PERM ? ((R & ~31) + perm32(R & 31)) : R;
        voffA[i] = (unsigned)(R * K + C) * 2u; voffB[i] = (unsigned)(Rb * K + C) * 2u; }
    const size_t kstep = (size_t)(BK * 2);
    const size_t hstep = (size_t)HALF * K * 2;
    const size_t tstep = 2 * hstep;
    const unsigned ldsw = (unsigned)wid * 1024u;
    const int aoff = lds_byte(wr * 64 + fr, fq * 8), boff = lds_byte(wc * 32 + fr, fq * 8);
#define PG8_SA(b, h) (((b) * 2 + (h)) * HTB)
#define PG8_SB(b, h) ((4 + (b) * 2 + (h)) * HTB)
#define PG8_STAGE(bufoff, gbase, voff) do { _Pragma("unroll") for (int _i = 0; _i < 2; ++_i) \
        __builtin_amdgcn_global_load_lds((const unsigned*)((const char*)(gbase) + (voff)[_i]), (PG8_LAS unsigned*)(lds + (bufoff) + ldsw + _i * 8192), 16, 0, 0); } while (0)
#define PG8_LDA(dst, b, h) do { _Pragma("unroll") for (int m = 0; m < 4; ++m) _Pragma("unroll") for (int k = 0; k < 2; ++k) dst[m][k] = *(const PG8_LAS bf16x8*)(lds + PG8_SA(b, h) + aoff + m * 2048 + k * 1024); } while (0)
#define PG8_LDB(dst, b, h) do { _Pragma("unroll") for (int n = 0; n < 2; ++n) _Pragma("unroll") for (int k = 0; k < 2; ++k) dst[n][k] = *(const PG8_LAS bf16x8*)(lds + PG8_SB(b, h) + boff + n * 2048 + k * 1024); } while (0)
#define PG8_MMA(ai, bj, At, Bt) do { __builtin_amdgcn_s_setprio(1); _Pragma("unroll") for (int m = 0; m < 4; ++m) _Pragma("unroll") for (int n = 0; n < 2; ++n) _Pragma("unroll") for (int k = 0; k < 2; ++k) \
        acc[ai][bj][m][n] = __builtin_amdgcn_mfma_f32_16x16x32_bf16(Bt[n][k], At[m][k], acc[ai][bj][m][n], 0, 0, 0); __builtin_amdgcn_s_setprio(0); } while (0)
#define PG8_WAIT_V(n) asm volatile("s_waitcnt vmcnt(" #n ")" ::: "memory")
#define PG8_WAIT_L(n) asm volatile("s_waitcnt lgkmcnt(" #n ")" ::: "memory")
#define PG8_BAR __builtin_amdgcn_s_barrier()
#define PG8_SCHED __builtin_amdgcn_sched_barrier(0)
    Unit cur, nxt; int ui = 0;
    if (!S.next(0, cur)) return;
    f32x4 acc[2][2][4][2];
#pragma unroll
    for (int a = 0; a < 2; ++a)
#pragma unroll
        for (int b = 0; b < 2; ++b)
#pragma unroll
            for (int m = 0; m < 4; ++m)
#pragma unroll
                for (int n = 0; n < 2; ++n) acc[a][b][m][n] = (f32x4){0.f, 0.f, 0.f, 0.f};
    bf16x8 At[4][2], B0[2][2], B1[2][2];
    const char* cA = (const char*)g.A + (size_t)cur.pm * tstep; const char* cB = (const char*)g.Bt + (size_t)cur.pn * tstep;
    S.a_ready(cur);
    if constexpr (SP2) {
        PG8_STAGE(PG8_SB(0, 0), cB, voffB); PG8_STAGE(PG8_SB(0, 1), cB + hstep, voffB); PG8_STAGE(PG8_SA(0, 0), cA, voffA); PG8_STAGE(PG8_SA(0, 1), cA + hstep, voffA);
        if (wr == 1) PG8_BAR;
        PG8_WAIT_V(2); PG8_BAR;
        PG8_STAGE(PG8_SB(1, 0), cB + kstep, voffB); PG8_STAGE(PG8_SA(1, 0), cA + kstep, voffA); PG8_STAGE(PG8_SB(1, 1), cB + hstep + kstep, voffB);
        PG8_WAIT_V(6); PG8_BAR;
    } else {
        PG8_STAGE(PG8_SB(0, 0), cB, voffB); PG8_STAGE(PG8_SA(0, 0), cA, voffA); PG8_STAGE(PG8_SB(0, 1), cB + hstep, voffB); PG8_STAGE(PG8_SA(0, 1), cA + hstep, voffA);
        if (wr == 1) PG8_BAR;
        PG8_WAIT_V(4); PG8_BAR;
        PG8_STAGE(PG8_SB(1, 0), cB + kstep, voffB); PG8_STAGE(PG8_SA(1, 0), cA + kstep, voffA); PG8_STAGE(PG8_SB(1, 1), cB + hstep + kstep, voffB);
        PG8_WAIT_V(6); PG8_BAR;
    }
    for (;;) {
        const bool has_next = S.next(ui + 1, nxt);
        const char* nA = has_next ? (const char*)g.A + (size_t)nxt.pm * tstep : cA; const char* nB = has_next ? (const char*)g.Bt + (size_t)nxt.pn * tstep : cB;
        for (int t = 0; t < nt; t += 2) {
            const bool last = (t == nt - 2);
            const char* a1 = cA + (size_t)(t + 1) * kstep;
            const char* a2 = last ? nA : cA + (size_t)(t + 2) * kstep; const char* b2 = last ? nB : cB + (size_t)(t + 2) * kstep;
            const char* a3 = a2 + kstep; const char* b3 = b2 + kstep;
            if (last && has_next) S.a_ready(nxt);
            if constexpr (SP2) {
            PG8_LDB(B0, 0, 0); PG8_LDB(B1, 0, 1); PG8_SCHED; PG8_LDA(At, 0, 0); PG8_STAGE(PG8_SA(1, 1), a1 + hstep, voffA);
            PG8_WAIT_V(8); PG8_WAIT_L(0); PG8_BAR; PG8_MMA(0, 0, At, B0); PG8_MMA(0, 1, At, B1); PG8_BAR; PG8_SCHED;
            PG8_LDA(At, 0, 1); PG8_STAGE(PG8_SB(0, 0), b2, voffB); PG8_STAGE(PG8_SB(0, 1), b2 + hstep, voffB); PG8_STAGE(PG8_SA(0, 0), a2, voffA);
            PG8_WAIT_V(8); PG8_WAIT_L(0); PG8_BAR; PG8_MMA(1, 0, At, B0); PG8_MMA(1, 1, At, B1); PG8_BAR; PG8_SCHED;
            PG8_LDB(B0, 1, 0); PG8_LDB(B1, 1, 1); PG8_SCHED; PG8_LDA(At, 1, 0); PG8_STAGE(PG8_SA(0, 1), a2 + hstep, voffA);
            PG8_WAIT_V(8); PG8_WAIT_L(0); PG8_BAR; PG8_MMA(0, 0, At, B0); PG8_MMA(0, 1, At, B1); PG8_BAR; PG8_SCHED;
            PG8_LDA(At, 1, 1); PG8_STAGE(PG8_SB(1, 0), b3, voffB); PG8_STAGE(PG8_SB(1, 1), b3 + hstep, voffB); PG8_STAGE(PG8_SA(1, 0), a3, voffA);
            PG8_WAIT_V(8); PG8_WAIT_L(0); PG8_BAR; PG8_MMA(1, 0, At, B0); PG8_MMA(1, 1, At, B1); PG8_BAR; PG8_SCHED;
            } else {
            PG8_LDB(B0, 0, 0); PG8_SCHED; PG8_LDA(At, 0, 0); PG8_STAGE(PG8_SA(1, 1), a1 + hstep, voffA);
            PG8_WAIT_L(8); PG8_BAR; PG8_WAIT_L(0); PG8_MMA(0, 0, At, B0); PG8_BAR; PG8_SCHED;
            PG8_LDB(B1, 0, 1); PG8_STAGE(PG8_SB(0, 0), b2, voffB);
            PG8_BAR; PG8_WAIT_L(0); PG8_MMA(0, 1, At, B1); PG8_BAR;
            PG8_LDA(At, 0, 1); PG8_STAGE(PG8_SA(0, 0), a2, voffA);
            PG8_BAR; PG8_WAIT_L(0); PG8_MMA(1, 0, At, B0); PG8_BAR; PG8_SCHED;
            PG8_STAGE(PG8_SB(0, 1), b2 + hstep, voffB);
            PG8_WAIT_V(6); PG8_BAR; PG8_MMA(1, 1, At, B1); PG8_BAR;
            PG8_LDB(B0, 1, 0); PG8_SCHED; PG8_LDA(At, 1, 0); PG8_STAGE(PG8_SA(0, 1), a2 + hstep, voffA);
            PG8_WAIT_L(8); PG8_BAR; PG8_WAIT_L(0); PG8_MMA(0, 0, At, B0); PG8_BAR; PG8_SCHED;
            PG8_LDB(B1, 1, 1); PG8_STAGE(PG8_SB(1, 0), b3, voffB);
            PG8_BAR; PG8_WAIT_L(0); PG8_MMA(0, 1, At, B1); PG8_BAR;
            PG8_LDA(At, 1, 1); PG8_STAGE(PG8_SA(1, 0), a3, voffA);
            PG8_BAR; PG8_WAIT_L(0); PG8_MMA(1, 0, At, B0); PG8_BAR; PG8_SCHED;
            PG8_STAGE(PG8_SB(1, 1), b3 + hstep, voffB);
            PG8_WAIT_V(6); PG8_BAR; PG8_MMA(1, 1, At, B1); PG8_BAR;
            }
        }
        if constexpr (ALIGN_EPI) { if (wr == 0) PG8_BAR; }
        if constexpr (!Epi::AFTER_DRAIN) { const int el = fresh_lane(); E(acc, cur, wr, wc, el & 15, el >> 4); S.done(cur); }
        if (!has_next) break;
#pragma unroll
        for (int a = 0; a < 2; ++a)
#pragma unroll
            for (int b = 0; b < 2; ++b)
#pragma unroll
                for (int m = 0; m < 4; ++m)
#pragma unroll
                    for (int n = 0; n < 2; ++n) acc[a][b][m][n] = (f32x4){0.f, 0.f, 0.f, 0.f};
        cur = nxt; cA = nA; cB = nB; ++ui;
        if constexpr (ALIGN_EPI) { if (wr == 1) PG8_BAR; }
    }
    PG8_WAIT_V(0);
    if constexpr (!ALIGN_EPI) { if (wr == 0) PG8_BAR; }
    PG8_BAR;
    if constexpr (Epi::AFTER_DRAIN) { E.fused(acc, cur, wr, wc, fr, fq, lds, wid, lane); S.done(cur); }
#undef PG8_SA
#undef PG8_SB
#undef PG8_STAGE
#undef PG8_LDA
#undef PG8_LDB
#undef PG8_MMA
#undef PG8_WAIT_V
#undef PG8_WAIT_L
#undef PG8_BAR
#undef PG8_SCHED
}
}
#define GAS __attribute__((address_space(1)))
#define LAS __attribute__((address_space(3)))
typedef unsigned short bf16;
typedef unsigned v4u __attribute__((ext_vector_type(4)));
typedef float f32x4 __attribute__((ext_vector_type(4)));
typedef short bf16x8 __attribute__((ext_vector_type(8)));
typedef GAS unsigned gu32;
typedef GAS unsigned long long gu64;
#define RLX_AGENT __ATOMIC_RELAXED, __HIP_MEMORY_SCOPE_AGENT
#define LDS_WAIT() asm volatile("s_waitcnt lgkmcnt(0)" ::: "memory")
#define VM_WAIT() asm volatile("s_waitcnt vmcnt(0)" ::: "memory")
__device__ __forceinline__ unsigned long long rt() { return __builtin_amdgcn_s_memrealtime(); }
__device__ __forceinline__ unsigned f2bf(float f) { unsigned u = __builtin_bit_cast(unsigned, f); return (u + 0x7fffu + ((u >> 16) & 1u)) >> 16; }
__device__ __forceinline__ unsigned pk2(float lo, float hi) { return f2bf(lo) | (f2bf(hi) << 16); }

#define XB_TMO      128
#define XB_XCNT(j)  (256  + 64 * (j))
#define XB_XSUB(j)  (1280 + 64 * (j))
#define XB_XGEN(j)  (2304 + 64 * (j))
#define XB_TOP      3328
#define XB_TOPGEN   3392
#define XCD_BAR_WORDS 3456
#define XB_SPIN_CAP (1u << 18)

__device__ __forceinline__ unsigned xb_ld(unsigned* p)              { return __hip_atomic_load(p, __ATOMIC_RELAXED, __HIP_MEMORY_SCOPE_AGENT); }
__device__ __forceinline__ unsigned xb_add(unsigned* p, unsigned v) { return __hip_atomic_fetch_add(p, v, __ATOMIC_RELAXED, __HIP_MEMORY_SCOPE_AGENT); }
__device__ __forceinline__ unsigned xb_xcc_id() { return (unsigned)__builtin_amdgcn_s_getreg((3 << 11) | 20) & 0xFu; }
#define XB_SPIN(cond, bar) do { unsigned _sp = 0; while (cond) { __builtin_amdgcn_s_sleep(1); \
    if ((++_sp & 255u) == 0u) { if (xb_ld(&(bar)[XB_TMO])) break; if (_sp > XB_SPIN_CAP) { atomicAdd(&(bar)[XB_TMO], 1u); break; } } } } while (0)

struct XcdBarrier {
    unsigned* bar; unsigned x;
    volatile LAS unsigned* st;
};

__device__ __forceinline__ XcdBarrier xcd_barrier_post(unsigned* bar, volatile LAS unsigned* st) {
    XcdBarrier b; b.bar = bar; b.x = xb_xcc_id(); b.st = st;
    if (threadIdx.x == 0) (void)xb_add(&bar[XB_XCNT(b.x)], 1u);
    return b;
}
__device__ __forceinline__ void xcd_barrier_complete(unsigned* bar, unsigned x, unsigned& nloc, unsigned& nx) {
    const unsigned G = gridDim.x * gridDim.y * gridDim.z;
    unsigned sum, cnt, mine, sp = 0u;
    for (;;) {
        sum = 0u; cnt = 0u; mine = 0u;
#pragma unroll
        for (unsigned j = 0; j < 16; ++j) { const unsigned c = xb_ld(&bar[XB_XCNT(j)]); sum += c; cnt += (c > 0u) ? 1u : 0u; mine = (j == x) ? c : mine; }
        if (sum == G) break;
        __builtin_amdgcn_s_sleep(1);
        if ((++sp & 255u) == 0u) { if (xb_ld(&bar[XB_TMO])) break; if (sp > XB_SPIN_CAP) { atomicAdd(&bar[XB_TMO], 1u); break; } }
    }
    nloc = mine > 0u ? mine : 1u; nx = cnt > 0u ? cnt : 1u;
}

__device__ __forceinline__ void xcd_barrier(const XcdBarrier& b, const int wave) {
    asm volatile("s_waitcnt vmcnt(0)" ::: "memory");
    __syncthreads();
    if (wave == 0 && fresh_lane() == 0) {
        unsigned* bar = b.bar; asm volatile("" : "+s"(bar)); const unsigned bx_ = xb_xcc_id();
        __builtin_amdgcn_s_waitcnt(0);
        unsigned nloc = b.st[0], nx = b.st[1];
        if (nloc == 0u) { xcd_barrier_complete(bar, bx_, nloc, nx); b.st[0] = nloc; b.st[1] = nx; }
        const unsigned old = xb_add(&bar[XB_XSUB(bx_)], 1u);
        const unsigned gen = old / nloc;
        if (old + 1u == (gen + 1u) * nloc) {
            __builtin_amdgcn_fence(__ATOMIC_RELEASE, "agent");
            asm volatile("s_waitcnt vmcnt(0)" ::: "memory");
            const unsigned og = xb_add(&bar[XB_TOP], 1u);
            const unsigned tg = og / nx;
            if (og + 1u == (tg + 1u) * nx) xb_add(&bar[XB_TOPGEN], 1u);
            else XB_SPIN(xb_ld(&bar[XB_TOPGEN]) == tg, bar);
            __builtin_amdgcn_fence(__ATOMIC_ACQUIRE, "agent");
            xb_add(&bar[XB_XGEN(bx_)], 1u);
            asm volatile("s_waitcnt vmcnt(0)" ::: "memory");
        } else {
            XB_SPIN(xb_ld(&bar[XB_XGEN(bx_)]) == gen, bar);
            __builtin_amdgcn_fence(__ATOMIC_ACQUIRE, "agent");
            asm volatile("s_waitcnt vmcnt(0)" ::: "memory");
        }
    }
    __syncthreads();
}


#ifndef PHM
#define PHM 0xFFFF
#endif
constexpr int NWAVES = 8;
constexpr int D = 1024, NB = 4, T = 8192, TC = 256, NL = 2;
constexpr int DC = 512, DR = 512, HS = 64, FF = 2816, PROJ = 3328, NMOD = 6144;
constexpr int MLAT = NB * T, MCTX = NB * TC, M = MLAT + MCTX;
constexpr int NLORA = 2560, KLORA = 256;
constexpr float RMS_EPS = 1e-6f, GN_EPS = 64e-5f, DECAY_SCALE = 0.6065306597126334f;

typedef unsigned short u16;
typedef unsigned v4u __attribute__((ext_vector_type(4)));
typedef unsigned v2u __attribute__((ext_vector_type(2)));
typedef _Float16 h2 __attribute__((ext_vector_type(2)));

constexpr size_t MiB = 1u << 20;
constexpr size_t WS_CTL = 0, CTL_ZERO_BYTES = 1 * MiB;
constexpr size_t WS_MOD = 1 * MiB;
constexpr size_t WS_XCTX = 2 * MiB;
constexpr size_t WS_WIN = 6 * MiB;
constexpr size_t WS_WOUT = 19 * MiB;
constexpr size_t WS_WUP = 23 * MiB;
constexpr size_t WS_WDN = 45 * MiB;
constexpr size_t WS_BLORA = 56 * MiB;
constexpr size_t WS_XN = 60 * MiB;
constexpr size_t WS_PC = 126 * MiB;
constexpr size_t WS_PRKV = 225 * MiB;
constexpr size_t WS_ALORA = 324 * MiB;
constexpr size_t WS_DEC = 341 * MiB;
constexpr size_t WS_AA = 407 * MiB;
constexpr size_t WS_GATE = 473 * MiB;
constexpr size_t WS_GATEB = 126 * MiB;
constexpr size_t WS_VALB = 308 * MiB;
constexpr size_t WS_END = 506 * MiB;
static_assert(WS_XN + (size_t)M * D * 2 <= WS_PC, "map");
static_assert(WS_PC + (size_t)M * 1536 * 2 <= WS_PRKV, "map");
static_assert(WS_PRKV + (size_t)M * 1536 * 2 <= WS_ALORA, "map");
static_assert(WS_ALORA + (size_t)M * 256 * 2 <= WS_DEC, "map");
static_assert(WS_DEC + (size_t)M * 1024 * 2 <= WS_AA, "map");
static_assert(WS_AA + (size_t)M * 1024 * 2 <= WS_GATE, "map");
static_assert(WS_GATE + (size_t)M * 512 * 2 <= WS_END, "map");
static_assert(WS_GATEB + (size_t)M * FF * 2 <= WS_VALB, "map");
static_assert(WS_VALB + (size_t)M * FF * 2 <= WS_END, "map");
static_assert(WS_BLORA + (size_t)NL * NLORA * KLORA * 2 <= WS_XN, "map");
constexpr int CW_BAR = 4096;

constexpr int RING_OFF = 0, RING_BYTES = 131072;
constexpr int LDSCTL_OFF = RING_BYTES, MISC_OFF = LDSCTL_OFF + 320;
constexpr int LDS_BYTES = 147456;

__device__ __forceinline__ unsigned pk_bf16(float lo, float hi) { return pk2(lo, hi); }
__device__ __forceinline__ unsigned pk_f16(float lo, float hi) { h2 v; v.x = (_Float16)lo; v.y = (_Float16)hi; return __builtin_bit_cast(unsigned, v); }
__device__ __forceinline__ void unpk_f16(unsigned u, float& lo, float& hi) { const h2 v = __builtin_bit_cast(h2, u); lo = (float)v.x; hi = (float)v.y; }
__device__ __forceinline__ void unpk8_f16(const v4u u, float (&f)[8]) { unpk_f16(u.x, f[0], f[1]); unpk_f16(u.y, f[2], f[3]); unpk_f16(u.z, f[4], f[5]); unpk_f16(u.w, f[6], f[7]); }
__device__ __forceinline__ float sigmoidf_(float x) { return 1.0f / (1.0f + __expf(-x)); }
__device__ __forceinline__ float siluf_(float x) { return x / (1.0f + __expf(-x)); }
__device__ __forceinline__ float tanhf_(float x) { const float e = __expf(-2.0f * fabsf(x)); const float t = (1.0f - e) / (1.0f + e); return x < 0.f ? -t : t; }
template <int CTRL> __device__ __forceinline__ float dppf(float x) { return __builtin_bit_cast(float, __builtin_amdgcn_update_dpp(0, __builtin_bit_cast(int, x), CTRL, 0xF, 0xF, true)); }
__device__ __forceinline__ float allreduce16(float x) { x += dppf<0x121>(x); x += dppf<0x122>(x); x += dppf<0x124>(x); x += dppf<0x128>(x); return x; }
__device__ __forceinline__ float group8_sum(float v) { v += dppf<0xB1>(v); v += dppf<0x4E>(v); v += dppf<0x141>(v); return v; }
__device__ __forceinline__ float wave_sum(float v) {
    v = allreduce16(v);
    const int vi = __builtin_bit_cast(int, v);
    const float s0 = __builtin_bit_cast(float, __builtin_amdgcn_readlane(vi, 0)), s1 = __builtin_bit_cast(float, __builtin_amdgcn_readlane(vi, 16)), s2 = __builtin_bit_cast(float, __builtin_amdgcn_readlane(vi, 32)), s3 = __builtin_bit_cast(float, __builtin_amdgcn_readlane(vi, 48));
    return (s0 + s1) + (s2 + s3);
}

struct EpiArgs {
    u16 *o0, *o1, *o2;
    const float *p0, *p1;
    const float *xl, *xc;
    float *ol, *oc;
    const float* mod;
};
template <int MODE> struct Epi {
    static constexpr bool PERM = true, AFTER_DRAIN = false;
    EpiArgs a;
    __device__ __forceinline__ void operator()(const pg8::f32x4 (&acc)[2][2][4][2], const pg8::Unit& u, int wr, int wc, int fr, int fq) const {
        using pg8::f32x4;
        const int row0 = u.pm * 256 + wr * 64 + fr;
        const int colb = u.pn * 256 + wc * 32 + 8 * fq;
        if constexpr (MODE == 1) {
#pragma unroll
            for (int ai = 0; ai < 2; ++ai)
#pragma unroll
                for (int m = 0; m < 4; ++m) {
                    const size_t row = (size_t)(row0 + ai * 128 + m * 16);
#pragma unroll
                    for (int bj = 0; bj < 2; ++bj) {
                        const f32x4 v0 = acc[ai][bj][m][0], v1 = acc[ai][bj][m][1];
                        const int col = colb + bj * 128;
                        v4u w;
                        if (u.pn < 12) {
                            w.x = pk_f16(v0[0], v0[1]); w.y = pk_f16(v0[2], v0[3]); w.z = pk_f16(v1[0], v1[1]); w.w = pk_f16(v1[2], v1[3]);
                            u16* dst = (u.pn < 6) ? (a.o0 + row * 1536 + col) : (a.o1 + row * 1536 + (col - 1536));
                            *(v4u*)dst = w;
                        } else {
                            const int cl = col - 3072;
                            float f[8] = {v0[0], v0[1], v0[2], v0[3], v1[0], v1[1], v1[2], v1[3]};
#pragma unroll
                            for (int j = 0; j < 8; ++j) f[j] = (cl < 64) ? tanhf_(f[j]) : ((cl < 128) ? f[j] : sigmoidf_(f[j]));
                            w.x = pk_bf16(f[0], f[1]); w.y = pk_bf16(f[2], f[3]); w.z = pk_bf16(f[4], f[5]); w.w = pk_bf16(f[6], f[7]);
                            *(v4u*)(a.o2 + row * 256 + cl) = w;
                        }
                    }
                }
        } else if constexpr (MODE == 2) {
#pragma unroll
            for (int bj = 0; bj < 2; ++bj) {
                const int col = colb + bj * 128;
                float pv[8];
                if (u.pn < 8) { const float* pp = (u.pn < 4) ? (a.p0 + col) : (a.p1 + (col - 1024));
#pragma unroll
                    for (int j = 0; j < 8; ++j) pv[j] = pp[j]; }
#pragma unroll
                for (int ai = 0; ai < 2; ++ai)
#pragma unroll
                    for (int m = 0; m < 4; ++m) {
                        const size_t row = (size_t)(row0 + ai * 128 + m * 16);
                        const f32x4 v0 = acc[ai][bj][m][0], v1 = acc[ai][bj][m][1];
                        float f[8] = {v0[0], v0[1], v0[2], v0[3], v1[0], v1[1], v1[2], v1[3]};
                        u16* dst;
                        if (u.pn < 4) {
#pragma unroll
                            for (int j = 0; j < 8; ++j) f[j] = __expf(-DECAY_SCALE * sigmoidf_(pv[j] + f[j]));
                            dst = a.o0 + row * 1024 + col;
                        } else if (u.pn < 8) {
#pragma unroll
                            for (int j = 0; j < 8; ++j) f[j] = sigmoidf_(pv[j] + f[j]);
                            dst = a.o1 + row * 1024 + (col - 1024);
                        } else dst = a.o2 + row * 512 + (col - 2048);
                        v4u w; w.x = pk_f16(f[0], f[1]); w.y = pk_f16(f[2], f[3]); w.z = pk_f16(f[4], f[5]); w.w = pk_f16(f[6], f[7]);
                        *(v4u*)dst = w;
                    }
            }
        } else if constexpr (MODE == 3) {
            const int s = (u.pm < 128) ? (u.pm >> 5) : 4;
            const bool lat = u.pm < 128;
#pragma unroll
            for (int bj = 0; bj < 2; ++bj) {
                const int col = colb + bj * 128;
                const f32x4 g0 = *(const f32x4*)(a.mod + s * NMOD + col), g1 = *(const f32x4*)(a.mod + s * NMOD + col + 4);
#pragma unroll
                for (int ai = 0; ai < 2; ++ai)
#pragma unroll
                    for (int m = 0; m < 4; ++m) {
                        const int row = row0 + ai * 128 + m * 16;
                        const size_t off = lat ? ((size_t)row * D + col) : ((size_t)(row - MLAT) * D + col);
                        const float* xi = (lat ? a.xl : a.xc) + off; float* xo = (lat ? a.ol : a.oc) + off;
                        const f32x4 x0 = *(const f32x4*)xi, x1 = *(const f32x4*)(xi + 4);
                        *(f32x4*)xo = x0 + g0 * acc[ai][bj][m][0]; *(f32x4*)(xo + 4) = x1 + g1 * acc[ai][bj][m][1];
                    }
            }
        } else {
#pragma unroll
            for (int ai = 0; ai < 2; ++ai)
#pragma unroll
                for (int m = 0; m < 4; ++m) {
                    const size_t row = (size_t)(row0 + ai * 128 + m * 16);
#pragma unroll
                    for (int bj = 0; bj < 2; ++bj) {
                        const f32x4 v0 = acc[ai][bj][m][0], v1 = acc[ai][bj][m][1];
                        const int col = colb + bj * 128;
                        v4u w; w.x = pk_f16(v0[0], v0[1]); w.y = pk_f16(v0[2], v0[3]); w.z = pk_f16(v1[0], v1[1]); w.w = pk_f16(v1[2], v1[3]);
                        u16* dst = (u.pn < 11) ? (a.o0 + row * FF + col) : (a.o1 + row * FF + (col - FF));
                        *(v4u*)dst = w;
                    }
                }
        }
    }
};

struct Frame {
    LAS unsigned char* lds;
    volatile LAS unsigned* MISC;
    gu32* ctl;
    int tid, lane, wave, vcu, G;
    float* out;
    unsigned char* ws;
};
#define PHASE_BEGIN(F) do { (F).lane = fresh_lane(); (F).tid = (F).wave * 64 + (F).lane; } while (0)
#define IN_X 0
#define IN_C 1
#define IN_CTX 2
#define IN_CCTX 3
#define IN_ADAW 4
#define IN_ADAB 5
#define IN_N1G 6
#define IN_N2G 7
#define IN_WIN 8
#define IN_CONVA 9
#define IN_W0 10
#define IN_WUP 11
#define IN_A0 12
#define IN_AUP 13
#define IN_KK 14
#define IN_KA 15
#define IN_RK 16
#define IN_GUP 17
#define IN_LNG 18
#define IN_LNB 19
#define IN_WOUT 20
#define IN_FUP 21
#define IN_FCW 22
#define IN_FCB 23
#define IN_FDN 24
#define IN_FG 25

__device__ __forceinline__ void p0_mod(Frame& F, const float* cvec, const float* cctx, const float* adaw, const float* adab) {
    PHASE_BEGIN(F);
    LAS float* sl = (LAS float*)(F.lds);
    LAS float* red = (LAS float*)(F.lds + 20480);
    float* mod = (float*)(F.ws + WS_MOD);
    const int nchunk = NL * (NMOD / 64);
    if ((int)blockIdx.x >= nchunk) return;
    for (int i = F.tid; i < 5 * 1024; i += NWAVES * 64) { const int s = i >> 10, k = i & 1023; const float c = (s < 4) ? cvec[s * 1024 + k] : cctx[k]; sl[i] = siluf_(c); }
    __syncthreads();
    for (int ci = blockIdx.x; ci < nchunk; ci += F.G) {
        const int l = ci / (NMOD / 64), n = (ci % (NMOD / 64)) * 64 + F.lane;
        const float* w = adaw + (size_t)l * D * NMOD + n;
        float acc[5] = {0.f, 0.f, 0.f, 0.f, 0.f};
        const int k0 = F.wave * 128;
#pragma unroll 8
        for (int k = k0; k < k0 + 128; ++k) { const float wv = w[(size_t)k * NMOD];
#pragma unroll
            for (int s = 0; s < 5; ++s) acc[s] += sl[s * 1024 + k] * wv; }
#pragma unroll
        for (int s = 0; s < 5; ++s) red[(F.wave * 5 + s) * 64 + F.lane] = acc[s];
        __syncthreads();
        if (F.tid < 320) { const int s = F.tid >> 6, ln = F.tid & 63; float t = 0.f;
#pragma unroll
            for (int w8 = 0; w8 < 8; ++w8) t += red[(w8 * 5 + s) * 64 + ln];
            const int nn = (ci % (NMOD / 64)) * 64 + ln;
            mod[((size_t)l * 5 + s) * NMOD + nn] = t + adab[l * NMOD + nn]; }
        __syncthreads();
    }
}
__device__ __forceinline__ void p0_transpose_item(const float* W, int K, int N, u16* WT, LAS float* scr, int item, int lane) {
    const int nblk = N / 32, kb = item / nblk, nb = item % nblk, k0 = 64 * kb, n0 = 32 * nb;
#pragma unroll 8
    for (int i = 0; i < 32; ++i) { const int kk = 2 * i + (lane >> 5); scr[kk * 33 + (lane & 31)] = W[(size_t)(k0 + kk) * N + n0 + (lane & 31)]; }
    LDS_WAIT(); asm volatile("" ::: "memory");
    const int c = lane & 7;
#pragma unroll
    for (int j = 0; j < 4; ++j) { const int n = (lane >> 3) + 8 * j; const LAS float* s = scr + (8 * c) * 33 + n;
        v4u o; o.x = pk2(s[0 * 33], s[1 * 33]); o.y = pk2(s[2 * 33], s[3 * 33]); o.z = pk2(s[4 * 33], s[5 * 33]); o.w = pk2(s[6 * 33], s[7 * 33]);
        *(GAS v4u*)(WT + (size_t)(n0 + n) * K + k0 + 8 * c) = o; }
    LDS_WAIT(); asm volatile("" ::: "memory");
}
__device__ __forceinline__ void p0_weights(Frame& F, const float* win, const float* wout, const float* fup, const float* fdn, const float* wup, const float* aup, const float* gup) {
    PHASE_BEGIN(F);
    LAS float* scr = (LAS float*)(F.lds + 32768 + F.wave * 8704);
    const int gw = F.vcu * NWAVES + F.wave, NGW = F.G * NWAVES;
    constexpr int I_IN = (D / 64) * (PROJ / 32), I_OUT = (D / 64) * (D / 32), I_UP = (D / 64) * (2 * FF / 32), I_DN = (FF / 64) * (D / 32);
    constexpr int PER_L = I_IN + I_OUT + I_UP + I_DN;
    for (int it = gw; it < NL * PER_L; it += NGW) {
        const int l = it / PER_L; int r = it % PER_L;
        if (r < I_IN) { p0_transpose_item(win + (size_t)l * D * PROJ, D, PROJ, (u16*)(F.ws + WS_WIN) + (size_t)l * PROJ * D, scr, r, F.lane); continue; } r -= I_IN;
        if (r < I_OUT) { p0_transpose_item(wout + (size_t)l * D * D, D, D, (u16*)(F.ws + WS_WOUT) + (size_t)l * D * D, scr, r, F.lane); continue; } r -= I_OUT;
        if (r < I_UP) { p0_transpose_item(fup + (size_t)l * D * 2 * FF, D, 2 * FF, (u16*)(F.ws + WS_WUP) + (size_t)l * 2 * FF * D, scr, r, F.lane); continue; } r -= I_UP;
        p0_transpose_item(fdn + (size_t)l * FF * D, FF, D, (u16*)(F.ws + WS_WDN) + (size_t)l * D * FF, scr, r, F.lane);
    }
    const int gt = F.vcu * NWAVES * 64 + F.tid, NGT = F.G * NWAVES * 64;
    u16* bl = (u16*)(F.ws + WS_BLORA);
    for (int e = gt; e < NL * NLORA * (KLORA / 8); e += NGT) {
        const int kc = e % (KLORA / 8), n = (e / (KLORA / 8)) % NLORA, l = e / ((KLORA / 8) * NLORA);
        float f[8];
#pragma unroll
        for (int j = 0; j < 8; ++j) { const int k = kc * 8 + j; float v = 0.f;
            if (n < 1024) { if (k < 64) v = wup[(((size_t)l * 2 + (n >> 9)) * 64 + k) * 512 + (n & 511)]; }
            else if (n < 2048) { if (k >= 64 && k < 128) v = aup[(((size_t)l * 2 + ((n - 1024) >> 9)) * 64 + (k - 64)) * 512 + (n & 511)]; }
            else { if (k >= 128) v = gup[((size_t)l * 128 + (k - 128)) * 512 + (n - 2048)]; }
            f[j] = v; }
        v4u o; o.x = pk2(f[0], f[1]); o.y = pk2(f[2], f[3]); o.z = pk2(f[4], f[5]); o.w = pk2(f[6], f[7]);
        *(v4u*)(bl + ((size_t)l * NLORA + n) * KLORA + kc * 8) = o;
    }
}
__device__ __forceinline__ void norm_rows(Frame& F, const float* xl, const float* xc, const float* g, const float* modl, int sh_off, int sc_off, int nrows) {
    PHASE_BEGIN(F);
    const int gw = F.vcu * NWAVES + F.wave, NGW = F.G * NWAVES;
    u16* XN = (u16*)(F.ws + WS_XN);
    pg8::f32x4 gv[4];
#pragma unroll
    for (int j = 0; j < 4; ++j) gv[j] = *(const pg8::f32x4*)(g + 4 * F.lane + 256 * j);
    for (int r = gw; r < nrows; r += NGW) {
        const int s = (r < MLAT) ? (r >> 13) : 4;
        const float* xr = (r < MLAT) ? (xl + (size_t)r * D) : (xc + (size_t)(r - MLAT) * D);
        pg8::f32x4 v[4]; float ss = 0.f;
#pragma unroll
        for (int j = 0; j < 4; ++j) { v[j] = *(const pg8::f32x4*)(xr + 4 * F.lane + 256 * j); ss += (v[j][0] * v[j][0] + v[j][1] * v[j][1]) + (v[j][2] * v[j][2] + v[j][3] * v[j][3]); }
        const float rstd = rsqrtf(wave_sum(ss) * (1.0f / D) + RMS_EPS);
        const float* shp = modl + s * NMOD + sh_off; const float* scp = modl + s * NMOD + sc_off;
#pragma unroll
        for (int j = 0; j < 4; ++j) {
            const pg8::f32x4 sh = *(const pg8::f32x4*)(shp + 4 * F.lane + 256 * j), sc = *(const pg8::f32x4*)(scp + 4 * F.lane + 256 * j);
            const pg8::f32x4 y = (v[j] * rstd) * gv[j];
            const pg8::f32x4 h = y * (sc + 1.0f) + sh;
            v2u o; o.x = pk2(h[0], h[1]); o.y = pk2(h[2], h[3]);
            *(v2u*)(XN + (size_t)r * D + 4 * F.lane + 256 * j) = o;
        }
    }
}
__device__ __forceinline__ void conv_branch(Frame& F, const float* cw, int nrows) {
    PHASE_BEGIN(F);
    const int gw = F.vcu * NWAVES + F.wave, NGW = F.G * NWAVES;
    const u16* Pc = (const u16*)(F.ws + WS_PC); u16* A2 = (u16*)(F.ws + WS_XN);
    const int c0 = 8 * F.lane;
    float w0[8], w1[8], w2[8];
    {
#pragma unroll
      for (int j = 0; j < 8; ++j) { w0[j] = cw[c0 + j]; w1[j] = cw[DC + c0 + j]; w2[j] = cw[2 * DC + c0 + j]; } }
    for (int r = gw; r < nrows; r += NGW) {
        int t, len; if (r < MLAT) { t = r & (T - 1); len = T; } else { t = (r - MLAT) & (TC - 1); len = TC; }
        const u16* p = Pc + (size_t)r * 1536 + c0;
        const v4u ucb = *(const v4u*)p, ucc = *(const v4u*)(p + 512), ucx = *(const v4u*)(p + 1024);
        v4u pcc = {0u, 0u, 0u, 0u}, pcx = pcc, ncc = pcc, ncx = pcc;
        if (t > 0) { pcc = *(const v4u*)(p - 1536 + 512); pcx = *(const v4u*)(p - 1536 + 1024); }
        if (t < len - 1) { ncc = *(const v4u*)(p + 1536 + 512); ncx = *(const v4u*)(p + 1536 + 1024); }
        float cb[8], cc[8], cx[8], pa[8], pb[8], na[8], nb[8], o[8];
        unpk8_f16(ucb, cb); unpk8_f16(ucc, cc); unpk8_f16(ucx, cx); unpk8_f16(pcc, pa); unpk8_f16(pcx, pb); unpk8_f16(ncc, na); unpk8_f16(ncx, nb);
#pragma unroll
        for (int j = 0; j < 8; ++j) o[j] = cb[j] * (w0[j] * (pa[j] * pb[j]) + w1[j] * (cc[j] * cx[j]) + w2[j] * (na[j] * nb[j]));
        v4u w; w.x = pk2(o[0], o[1]); w.y = pk2(o[2], o[3]); w.z = pk2(o[4], o[5]); w.w = pk2(o[6], o[7]);
        *(v4u*)(A2 + (size_t)r * D + c0) = w;
    }
}
__device__ __forceinline__ void rwkv_out(Frame& F, const float* lng, const float* lnb, const float* rkp, int nrows) {
    PHASE_BEGIN(F);
    const int gw = F.vcu * NWAVES + F.wave, NGW = F.G * NWAVES;
    const u16* Y = (const u16*)(F.ws + WS_PC); const u16* Prkv = (const u16*)(F.ws + WS_PRKV); const u16* GATE = (const u16*)(F.ws + WS_GATE);
    u16* A2 = (u16*)(F.ws + WS_XN);
    const int c0 = 8 * F.lane;
    float lg[8], lb[8], rk[8];
#pragma unroll
    for (int j = 0; j < 8; ++j) { lg[j] = lng[c0 + j]; lb[j] = lnb[c0 + j]; rk[j] = rkp[c0 + j]; }
    for (int r = gw; r < nrows; r += NGW) {
        const v4u uy0 = *(const v4u*)(Y + (size_t)r * 1024 + c0), uy1 = *(const v4u*)(Y + (size_t)r * 1024 + 512 + c0);
        const u16* p = Prkv + (size_t)r * 1536 + c0;
        const v4u ur = *(const v4u*)p, uk = *(const v4u*)(p + 512), uv = *(const v4u*)(p + 1024);
        const v4u ug = *(const v4u*)(GATE + (size_t)r * 512 + c0);
        float y0[8], y1[8], rr[8], kk[8], vv[8], gg[8], y[8], o[8];
        unpk8_f16(uy0, y0); unpk8_f16(uy1, y1); unpk8_f16(ur, rr); unpk8_f16(uk, kk); unpk8_f16(uv, vv); unpk8_f16(ug, gg);
        float s = 0.f, bs = 0.f;
#pragma unroll
        for (int j = 0; j < 8; ++j) { y[j] = y0[j] + y1[j]; s += y[j]; bs += rr[j] * kk[j] * rk[j]; }
        const float mu = group8_sum(s) * (1.0f / 64.0f); bs = group8_sum(bs);
        float q = 0.f;
#pragma unroll
        for (int j = 0; j < 8; ++j) { const float dd = y[j] - mu; q += dd * dd; }
        const float rstd = rsqrtf(group8_sum(q) * (1.0f / 64.0f) + GN_EPS);
#pragma unroll
        for (int j = 0; j < 8; ++j) o[j] = (((y[j] - mu) * rstd) * lg[j] + lb[j] + bs * vv[j]) * gg[j];
        v4u w; w.x = pk2(o[0], o[1]); w.y = pk2(o[2], o[3]); w.z = pk2(o[4], o[5]); w.w = pk2(o[6], o[7]);
        *(v4u*)(A2 + (size_t)r * D + 512 + c0) = w;
    }
}
constexpr int SC_CH = 32;
constexpr int SC_NSTEP = TC + T, SC_NCH = SC_NSTEP / SC_CH;
constexpr int SC_BUF = (5 * 64 + 16) * SC_CH * 4;
constexpr int SC_YB = 2 * SC_BUF;
static_assert(SC_YB + 2 * SC_CH * 16 * 4 <= RING_BYTES, "scan LDS");
struct ScanRegs { v4u k, r, dec, a, v; };
__device__ __forceinline__ int scan_row(int b, int d, int p) {
    if (p < TC) { const int tc = d ? (TC - 1 - p) : p; return MLAT + b * TC + tc; }
    const int q = p - TC; const int tl = d ? (T - 1 - q) : q; return b * T + tl;
}
__device__ __forceinline__ void scan_load(Frame& F, ScanRegs& R, int b, int h, int d, int rg, int chunk, int lt) {
    const int si = lt >> 3, cg = lt & 7;
    int p = chunk * SC_CH + si; if (p >= SC_NSTEP) p = SC_NSTEP - 1;
    const int row = scan_row(b, d, p);
    const u16* Prkv = (const u16*)(F.ws + WS_PRKV) + (size_t)row * 1536 + h * 64;
    R.r = *(const v4u*)(Prkv + 8 * cg); R.k = *(const v4u*)(Prkv + 512 + 8 * cg);
    R.v = *(const v4u*)(Prkv + 1024 + 16 * rg + 8 * (cg & 1));
    R.dec = *(const v4u*)((const u16*)(F.ws + WS_DEC) + (size_t)row * 1024 + d * 512 + h * 64 + 8 * cg);
    R.a = *(const v4u*)((const u16*)(F.ws + WS_AA) + (size_t)row * 1024 + d * 512 + h * 64 + 8 * cg);
}
__device__ __forceinline__ void scan_stage(Frame& F, const ScanRegs& R, const float (&kkw)[8], const float (&kaw)[8], int buf, int lt) {
    const int si = lt >> 3, cg = lt & 7;
    LAS float* base = (LAS float*)(F.lds + buf * SC_BUF);
    float k[8], r[8], w[8], a[8], kk[8], nb[8], kd[8];
    unpk8_f16(R.k, k); unpk8_f16(R.r, r); unpk8_f16(R.dec, w); unpk8_f16(R.a, a);
    float ss = 0.f;
#pragma unroll
    for (int j = 0; j < 8; ++j) { kk[j] = k[j] * kkw[j]; ss += kk[j] * kk[j]; }
    const float rn = rsqrtf(fmaxf(group8_sum(ss), 1e-24f));
#pragma unroll
    for (int j = 0; j < 8; ++j) { kk[j] *= rn; nb[j] = -(kk[j] * a[j]); kd[j] = k[j] * (1.0f + (a[j] - 1.0f) * kaw[j]); }
    const int o = si * 64 + 8 * cg;
    typedef float f4 __attribute__((ext_vector_type(4)));
    *(LAS f4*)(base + 0 * SC_CH * 64 + o) = (f4){w[0], w[1], w[2], w[3]};     *(LAS f4*)(base + 0 * SC_CH * 64 + o + 4) = (f4){w[4], w[5], w[6], w[7]};
    *(LAS f4*)(base + 1 * SC_CH * 64 + o) = (f4){kk[0], kk[1], kk[2], kk[3]}; *(LAS f4*)(base + 1 * SC_CH * 64 + o + 4) = (f4){kk[4], kk[5], kk[6], kk[7]};
    *(LAS f4*)(base + 2 * SC_CH * 64 + o) = (f4){nb[0], nb[1], nb[2], nb[3]}; *(LAS f4*)(base + 2 * SC_CH * 64 + o + 4) = (f4){nb[4], nb[5], nb[6], nb[7]};
    *(LAS f4*)(base + 3 * SC_CH * 64 + o) = (f4){kd[0], kd[1], kd[2], kd[3]}; *(LAS f4*)(base + 3 * SC_CH * 64 + o + 4) = (f4){kd[4], kd[5], kd[6], kd[7]};
    *(LAS f4*)(base + 4 * SC_CH * 64 + o) = (f4){r[0], r[1], r[2], r[3]};     *(LAS f4*)(base + 4 * SC_CH * 64 + o + 4) = (f4){r[4], r[5], r[6], r[7]};
    if (cg < 2) { float v[8]; unpk8_f16(R.v, v); LAS float* vb = base + 5 * SC_CH * 64 + si * 16 + 8 * cg;
        *(LAS f4*)(vb) = (f4){v[0], v[1], v[2], v[3]}; *(LAS f4*)(vb + 4) = (f4){v[4], v[5], v[6], v[7]}; }
}
__device__ __forceinline__ void scan_flush(Frame& F, int b, int h, int d, int rg, int chunk, int lt) {
    const int si = lt >> 3, pr = lt & 7;
    const int p = chunk * SC_CH + si;
    const int row = scan_row(b, d, p);
    const LAS float* yb = (const LAS float*)(F.lds + SC_YB) + (chunk & 1) * SC_CH * 16 + si * 16 + 2 * pr;
    u16* Y = (u16*)(F.ws + WS_PC) + (size_t)row * 1024 + d * 512 + h * 64 + 16 * rg + 2 * pr;
    *(unsigned*)Y = pk_f16(yb[0], yb[1]);
}
__device__ __forceinline__ void scan_phase(Frame& F, const float* kkp, const float* kap) {
    PHASE_BEGIN(F);
    typedef float f4 __attribute__((ext_vector_type(4)));
    for (int unit = F.vcu; unit < 256; unit += F.G) {
        const int combo = unit >> 2, rg = unit & 3;
        const int b = combo >> 4, h = (combo >> 1) & 7, d = combo & 1;
        if (F.wave >= 4) {
            const int lt = F.tid - 256, cg = lt & 7;
            float kkw[8], kaw[8];
#pragma unroll
            for (int j = 0; j < 8; ++j) { kkw[j] = kkp[h * 64 + 8 * cg + j]; kaw[j] = kap[h * 64 + 8 * cg + j]; }
            ScanRegs R;
            scan_load(F, R, b, h, d, rg, 0, lt);
            scan_stage(F, R, kkw, kaw, 0, lt);
            scan_load(F, R, b, h, d, rg, 1, lt);
            __syncthreads();
            for (int c = 0; c < SC_NCH; ++c) {
                scan_stage(F, R, kkw, kaw, (c + 1) & 1, lt);
                scan_load(F, R, b, h, d, rg, c + 2, lt);
                if (c > 0) scan_flush(F, b, h, d, rg, c - 1, lt);
                __syncthreads();
            }
            scan_flush(F, b, h, d, rg, SC_NCH - 1, lt);
        } else {
            const int rw = F.lane >> 4, ks = F.lane & 15;
            float S0 = 0.f, S1 = 0.f, S2 = 0.f, S3 = 0.f;
            __syncthreads();
            for (int c = 0; c < SC_NCH; ++c) {
                const LAS float* base = (const LAS float*)(F.lds + (c & 1) * SC_BUF);
                LAS float* yb = (LAS float*)(F.lds + SC_YB) + (c & 1) * SC_CH * 16;
#pragma unroll 4
                for (int s = 0; s < SC_CH; ++s) {
                    const int o = s * 64 + 4 * ks;
                    const f4 w = *(const LAS f4*)(base + 0 * SC_CH * 64 + o), kk = *(const LAS f4*)(base + 1 * SC_CH * 64 + o), nb = *(const LAS f4*)(base + 2 * SC_CH * 64 + o);
                    const f4 kd = *(const LAS f4*)(base + 3 * SC_CH * 64 + o), rr = *(const LAS f4*)(base + 4 * SC_CH * 64 + o);
                    const float vv = base[5 * SC_CH * 64 + s * 16 + 4 * F.wave + rw];
                    float pa = S0 * kk[0] + S1 * kk[1] + S2 * kk[2] + S3 * kk[3];
                    const float u0 = S0 * w[0] + vv * kd[0], u1 = S1 * w[1] + vv * kd[1], u2 = S2 * w[2] + vv * kd[2], u3 = S3 * w[3] + vv * kd[3];
                    const float sa = allreduce16(pa);
                    S0 = u0 + sa * nb[0]; S1 = u1 + sa * nb[1]; S2 = u2 + sa * nb[2]; S3 = u3 + sa * nb[3];
                    float q = S0 * rr[0] + S1 * rr[1] + S2 * rr[2] + S3 * rr[3];
                    q = allreduce16(q);
                    if (ks == 0) yb[s * 16 + 4 * F.wave + rw] = q;
                }
                __syncthreads();
            }
        }
        __syncthreads();
    }
}
__device__ __forceinline__ void ffn_conv(Frame& F, const float* cw, const float* cb, int nrows) {
    PHASE_BEGIN(F);
    const int gw = F.vcu * NWAVES + F.wave, NGW = F.G * NWAVES;
    const u16* G = (const u16*)(F.ws + WS_GATEB); u16* V = (u16*)(F.ws + WS_VALB);
    const int nstrip = nrows / 16, nitem = nstrip * 6;
    for (int it = gw; it < nitem; it += NGW) {
        const int j = it % 6, strip = it / 6;
        const int ch = F.lane + 64 * j;
        if (ch >= FF / 8) continue;
        const int c0 = 8 * ch;
        float wt[9][8], bias[8];
#pragma unroll
        for (int q = 0; q < 9; ++q)
#pragma unroll
            for (int e = 0; e < 8; ++e) wt[q][e] = cw[(size_t)q * FF + c0 + e];
#pragma unroll
        for (int e = 0; e < 8; ++e) bias[e] = cb[c0 + e];
        const int r0 = strip * 16;
        const bool lat = r0 < MLAT;
        for (int i = 0; i < 16; ++i) {
            const int r = r0 + i;
            int gr, gc, nr, ncol;
            if (lat) { const int t = r & (T - 1); gr = t >> 6; gc = t & 63; nr = T / 64; ncol = 64; }
            else { gr = 0; gc = (r - MLAT) & (TC - 1); nr = 1; ncol = TC; }
            float acc[8];
#pragma unroll
            for (int e = 0; e < 8; ++e) acc[e] = bias[e];
#pragma unroll
            for (int dr = 0; dr < 3; ++dr)
#pragma unroll
                for (int dc = 0; dc < 3; ++dc) {
                    const int rr = gr + dr - 1, cc = gc + dc - 1;
                    if (rr >= 0 && rr < nr && cc >= 0 && cc < ncol) {
                        const int rn = r + (dr - 1) * ncol + (dc - 1);
                        const v4u ug = *(const v4u*)(G + (size_t)rn * FF + c0);
                        float g[8]; unpk8_f16(ug, g);
#pragma unroll
                        for (int e = 0; e < 8; ++e) acc[e] += wt[dr * 3 + dc][e] * g[e];
                    }
                }
            const v4u uv = *(const v4u*)(V + (size_t)r * FF + c0);
            float v[8]; unpk8_f16(uv, v);
            float o[8];
#pragma unroll
            for (int e = 0; e < 8; ++e) o[e] = siluf_(acc[e]) * v[e];
            v4u w; w.x = pk2(o[0], o[1]); w.y = pk2(o[2], o[3]); w.z = pk2(o[4], o[5]); w.w = pk2(o[6], o[7]);
            *(v4u*)(V + (size_t)r * FF + c0) = w;
        }
    }
}
__device__ __forceinline__ void final_norm(Frame& F, const float* fg) {
    PHASE_BEGIN(F);
    const int gw = F.vcu * NWAVES + F.wave, NGW = F.G * NWAVES;
    pg8::f32x4 gv[4];
#pragma unroll
    for (int j = 0; j < 4; ++j) gv[j] = *(const pg8::f32x4*)(fg + 4 * F.lane + 256 * j);
    for (int r = gw; r < MLAT; r += NGW) {
        float* xr = F.out + (size_t)r * D;
        pg8::f32x4 v[4]; float ss = 0.f;
#pragma unroll
        for (int j = 0; j < 4; ++j) { v[j] = *(const pg8::f32x4*)(xr + 4 * F.lane + 256 * j); ss += (v[j][0] * v[j][0] + v[j][1] * v[j][1]) + (v[j][2] * v[j][2] + v[j][3] * v[j][3]); }
        const float rstd = rsqrtf(wave_sum(ss) * (1.0f / D) + RMS_EPS);
#pragma unroll
        for (int j = 0; j < 4; ++j) *(pg8::f32x4*)(xr + 4 * F.lane + 256 * j) = (v[j] * rstd) * gv[j];
    }
}

struct Args { const float* in[26]; float* out; unsigned char* ws; };
__device__ __forceinline__ const float* inp(const Args& a, int i) { asm volatile("" : "+s"(i)); return a.in[i]; }
template <int MODE> __device__ __forceinline__ void run_gemm(Frame& F, const u16* A, const u16* Bt, int Mr, int N, int K, const EpiArgs& ea) {
    pg8::Gemm g{A, Bt, Mr, N, K}; pg8::StaticOrder S; S.init(Mr, N, F.G, (int)blockIdx.x);
    Epi<MODE> E{ea};
    pg8::gemm_phase<Epi<MODE>, pg8::StaticOrder, true, true>(F.lds + RING_OFF, g, S, E, F.wave);
}
__global__ void __launch_bounds__(NWAVES * 64, 2) mk_fwd(Args args) {
    extern __shared__ __attribute__((aligned(16))) unsigned char lds[];
    Frame F;
    F.lds = (LAS unsigned char*)lds;
    F.MISC = (volatile LAS unsigned*)(F.lds + MISC_OFF);
    F.tid = threadIdx.x; F.lane = F.tid & 63; F.wave = __builtin_amdgcn_readfirstlane(F.tid >> 6);
    F.G = gridDim.x; { const int bx = blockIdx.x; F.vcu = (F.G % 8 == 0) ? (bx % 8) * (F.G / 8) + bx / 8 : bx; }
    unsigned char* ws = args.ws; F.ws = ws;
    F.ctl = (gu32*)(ws + WS_CTL);
    F.out = args.out;
    for (int u = F.tid; u < (LDS_BYTES - LDSCTL_OFF) / 4; u += NWAVES * 64) ((LAS unsigned*)(F.lds + LDSCTL_OFF))[u] = 0u;
    __syncthreads();
    XcdBarrier bar = xcd_barrier_post((unsigned*)(F.ctl + CW_BAR), F.MISC + 8);
#define GRID_BAR() xcd_barrier(bar, F.wave)

#if (PHM & 1)
    p0_mod(F, inp(args, IN_C), inp(args, IN_CCTX), inp(args, IN_ADAW), inp(args, IN_ADAB));
#endif
#if (PHM & 2)
    p0_weights(F, inp(args, IN_WIN), inp(args, IN_WOUT), inp(args, IN_FUP), inp(args, IN_FDN), inp(args, IN_WUP), inp(args, IN_AUP), inp(args, IN_GUP));
#endif
    GRID_BAR();

    float* xctx = (float*)(ws + WS_XCTX);
    const float* mod = (const float*)(ws + WS_MOD);
    for (int l = 0; l < NL; ++l) {
        const float* modl = mod + (size_t)l * 5 * NMOD;
        const float* xl = (l == 0) ? inp(args, IN_X) : F.out;
        const float* xc = (l == 0) ? inp(args, IN_CTX) : xctx;
        const int Mpost = (l == NL - 1) ? MLAT : M;
#if (PHM & 4)
        norm_rows(F, xl, xc, inp(args, IN_N1G) + l * D, modl, 0, 1024, M);
#endif
        GRID_BAR();
#if (PHM & 8)
        { EpiArgs ea{}; ea.o0 = (u16*)(ws + WS_PC); ea.o1 = (u16*)(ws + WS_PRKV); ea.o2 = (u16*)(ws + WS_ALORA);
          run_gemm<1>(F, (const u16*)(ws + WS_XN), (const u16*)(ws + WS_WIN) + (size_t)l * PROJ * D, M, PROJ, D, ea); }
#endif
        GRID_BAR();
#if (PHM & 16)
        conv_branch(F, inp(args, IN_CONVA) + (size_t)l * 3 * DC, Mpost);
#endif
#if (PHM & 32)
        { EpiArgs ea{}; ea.o0 = (u16*)(ws + WS_DEC); ea.o1 = (u16*)(ws + WS_AA); ea.o2 = (u16*)(ws + WS_GATE); ea.p0 = inp(args, IN_W0) + l * 1024; ea.p1 = inp(args, IN_A0) + l * 1024;
          run_gemm<2>(F, (const u16*)(ws + WS_ALORA), (const u16*)(ws + WS_BLORA) + (size_t)l * NLORA * KLORA, M, NLORA, KLORA, ea); }
#endif
        GRID_BAR();
#if (PHM & 64)
        scan_phase(F, inp(args, IN_KK) + l * DR, inp(args, IN_KA) + l * DR);
#endif
        GRID_BAR();
#if (PHM & 128)
        rwkv_out(F, inp(args, IN_LNG) + l * DR, inp(args, IN_LNB) + l * DR, inp(args, IN_RK) + l * DR, Mpost);
#endif
        GRID_BAR();
#if (PHM & 256)
        { EpiArgs ea{}; ea.xl = xl; ea.xc = xc; ea.ol = F.out; ea.oc = xctx; ea.mod = modl + 2048;
          run_gemm<3>(F, (const u16*)(ws + WS_XN), (const u16*)(ws + WS_WOUT) + (size_t)l * D * D, Mpost, D, D, ea); }
#endif
        GRID_BAR();
#if (PHM & 512)
        norm_rows(F, F.out, xctx, inp(args, IN_N2G) + l * D, modl, 3072, 4096, Mpost);
#endif
        GRID_BAR();
#if (PHM & 1024)
        { EpiArgs ea{}; ea.o0 = (u16*)(ws + WS_GATEB); ea.o1 = (u16*)(ws + WS_VALB);
          run_gemm<4>(F, (const u16*)(ws + WS_XN), (const u16*)(ws + WS_WUP) + (size_t)l * 2 * FF * D, Mpost, 2 * FF, D, ea); }
#endif
        GRID_BAR();
#if (PHM & 2048)
        ffn_conv(F, inp(args, IN_FCW) + (size_t)l * 9 * FF, inp(args, IN_FCB) + (size_t)l * FF, Mpost);
#endif
        GRID_BAR();
#if (PHM & 4096)
        { EpiArgs ea{}; ea.xl = F.out; ea.xc = xctx; ea.ol = F.out; ea.oc = xctx; ea.mod = modl + 5120;
          run_gemm<3>(F, (const u16*)(ws + WS_VALB), (const u16*)(ws + WS_WDN) + (size_t)l * D * FF, Mpost, D, FF, ea); }
#endif
        GRID_BAR();
    }
#if (PHM & 8192)
    final_norm(F, inp(args, IN_FG));
#endif
}

extern "C" void kernel_launch(void* const* d_in, const int* in_sizes, int n_in, void* d_out, int out_size, void* d_ws, size_t ws_size, hipStream_t stream) {
    static int grid = 0;
    if (grid == 0) {
        if (n_in != 26 || out_size != MLAT * D || ws_size < WS_END) { fprintf(stderr, "kernel_launch: unexpected shapes n_in %d out %d ws %zu\n", n_in, out_size, ws_size); grid = -1; return; }
        int dev = 0, cus = 0, per_cu = 0;
        if (hipGetDevice(&dev) != hipSuccess || hipDeviceGetAttribute(&cus, hipDeviceAttributeMultiprocessorCount, dev) != hipSuccess) { grid = -1; return; }
        if (hipFuncSetAttribute((const void*)mk_fwd, hipFuncAttributeMaxDynamicSharedMemorySize, LDS_BYTES) != hipSuccess) { fprintf(stderr, "kernel_launch: hipFuncSetAttribute failed\n"); grid = -1; return; }
        if (hipOccupancyMaxActiveBlocksPerMultiprocessor(&per_cu, (const void*)mk_fwd, NWAVES * 64, LDS_BYTES) != hipSuccess || per_cu < 1) fprintf(stderr, "kernel_launch: occupancy query says %d\n", per_cu);
        (void)hipGetLastError();
        grid = cus;
    }
    if (grid < 0) return;
    if (hipMemsetAsync((char*)d_ws + WS_CTL, 0, CTL_ZERO_BYTES, stream) != hipSuccess) { fprintf(stderr, "kernel_launch: memset failed\n"); return; }
    Args a{};
    for (int i = 0; i < 26; ++i) a.in[i] = (const float*)d_in[i];
    a.out = (float*)d_out; a.ws = (unsigned char*)d_ws;
    hipLaunchKernelGGL(mk_fwd, dim3(grid), dim3(NWAVES * 64), LDS_BYTES, stream, a);
    const hipError_t le = hipPeekAtLastError();
    if (le != hipSuccess) fprintf(stderr, "kernel_launch: launch failed: %s\n", hipGetErrorName(le));
}
```

```cpp
#include <hip/hip_runtime.h>
#include <cstdio>
#include <cstdint>
__device__ __forceinline__ int fresh_lane() { int z; asm volatile("v_mov_b32 %0, 0" : "=v"(z)); return (int)__builtin_amdgcn_mbcnt_hi(~0u, __builtin_amdgcn_mbcnt_lo(~0u, (unsigned)z)); }
namespace pg8 {
#define PG8_LAS __attribute__((address_space(3)))
typedef unsigned short bf16_t;
typedef short bf16x8 __attribute__((ext_vector_type(8)));
typedef float f32x4 __attribute__((ext_vector_type(4)));
typedef unsigned u32x4 __attribute__((ext_vector_type(4)));
constexpr int BM = 256, BK = 64, HALF = 128, HTB = HALF * BK * 2  , STAGE_BYTES = 8 * HTB, NXCD = 8, WGM = 8;

__host__ __device__ __forceinline__ int lds_byte(int r, int c) { const int st = (r >> 4) * 2 + (c >> 5), rr = r & 15, cc = c & 31, ob = rr * 64 + cc * 2; return st * 1024 + (ob ^ (((ob >> 9) & 1) << 5)); }
__host__ __device__ __forceinline__ void stage_rc(int b, int& R, int& C) { const int st = b / 1024, sb = b % 1024, swz = sb ^ (((sb >> 9) & 1) << 5); R = (st >> 1) * 16 + swz / 64; C = (st & 1) * 32 + (swz % 64) / 2; }
__host__ __device__ __forceinline__ int perm32(int rho) { const int n = rho >> 4, i = rho & 15; return 8 * (i >> 2) + 4 * n + (i & 3); }

struct Unit { int pm, pn, koff; };
struct Gemm { const bf16_t* A; const bf16_t* Bt; int M, N, K, ld; };

struct StaticOrder {
    int nM, nN, nwg, G, c;
    __host__ __device__ void init(int M, int N, int G_, int c_) { nM = M / BM; nN = N / BM; nwg = nM * nN; G = G_; c = c_; }
    __host__ __device__ bool next(int i, Unit& u) const {
        const long L = (long)i * G + c; if (L >= nwg) return false;
        int wgid = (int)L; { const int q = nwg / NXCD, r = nwg % NXCD, xcd = wgid % NXCD, off = wgid / NXCD; wgid = (xcd < r ? xcd * (q + 1) : r * (q + 1) + (xcd - r) * q) + off; }
        const int nig = WGM * nN, gid = wgid / nig, fm = gid * WGM, gsz = (nM - fm) < WGM ? (nM - fm) : WGM;
        u.pm = fm + ((wgid % nig) % gsz); u.pn = (wgid % nig) / gsz; u.koff = 0; return true;
    }
    __device__ __forceinline__ void a_ready(const Unit&) const {}
    __device__ __forceinline__ void done(const Unit&) const {}
};
struct SplitOrder {
    int pm0, nN, nsplit, ksb, total, G, c;
    __host__ __device__ void init(int pm0_, int nM_, int nN_, int nsplit_, int kslice_elems, int G_, int c_) { pm0 = pm0_; nN = nN_; nsplit = nsplit_; ksb = kslice_elems * 2; total = nM_ * nN_ * nsplit_; G = G_; c = c_; }
    __host__ __device__ bool next(int i, Unit& u) const {
        const long L = (long)i * G + c; if (L >= total) return false;
        const int t = (int)L / nsplit, ks = (int)L % nsplit;
        u.pm = pm0 + t / nN; u.pn = t % nN; u.koff = ks * ksb; return true;
    }
    __device__ __forceinline__ void a_ready(const Unit&) const {}
    __device__ __forceinline__ void done(const Unit&) const {}
};

template <class Epi, class Sched, bool ALIGN_EPI = false, bool SP2 = false>
__device__ __forceinline__ void gemm_phase(PG8_LAS unsigned char* lds, const Gemm g, const Sched& S, const Epi& E, const int wid_in) {
    const int wid = wid_in, lane = fresh_lane(), tid = wid * 64 + lane, wr = wid >> 2, wc = wid & 3, fr = lane & 15, fq = lane >> 4;
    const int K = g.K, nt = K / BK;
    unsigned voffA, voffB; int aoff, boff;
#define PG8_ADDR() do { const int l_ = fresh_lane(), t_ = wid * 64 + l_, fr_ = l_ & 15, fq_ = l_ >> 4; \
        { int R, C; stage_rc(t_ * 16, R, C); const int Rb = Epi::PERM ? ((R & ~31) + perm32(R & 31)) : R;     \
            voffA = (unsigned)(R * g.ld + C) * 2u; voffB = (unsigned)(Rb * g.ld + C) * 2u; } \
        aoff = lds_byte(wr * 64 + fr_, fq_ * 8); boff = lds_byte(wc * 32 + fr_, fq_ * 8); } while (0)
    PG8_ADDR();
    const size_t kstep = (size_t)(BK * 2);
    const size_t hstep = (size_t)HALF * g.ld * 2;
    const size_t qstep = hstep / 2;
    const size_t tstep = 2 * hstep;
    const unsigned ldsw = (unsigned)wid * 1024u;
#define PG8_SA(b, h) (((b) * 2 + (h)) * HTB)
#define PG8_SB(b, h) ((4 + (b) * 2 + (h)) * HTB)
#define PG8_STAGE(bufoff, gbase, voff) do { _Pragma("unroll") for (int _i = 0; _i < 2; ++_i) \
        __builtin_amdgcn_global_load_lds((const unsigned*)((const char*)(gbase) + (size_t)_i * qstep + (voff)), (PG8_LAS unsigned*)(lds + (bufoff) + ldsw + _i * 8192), 16, 0, 0); } while (0)
#define PG8_LDA(dst, b, h) do { _Pragma("unroll") for (int m = 0; m < 4; ++m) _Pragma("unroll") for (int k = 0; k < 2; ++k) dst[m][k] = *(const PG8_LAS bf16x8*)(lds + PG8_SA(b, h) + aoff + m * 2048 + k * 1024); } while (0)
#define PG8_LDB(dst, b, h) do { _Pragma("unroll") for (int n = 0; n < 2; ++n) _Pragma("unroll") for (int k = 0; k < 2; ++k) dst[n][k] = *(const PG8_LAS bf16x8*)(lds + PG8_SB(b, h) + boff + n * 2048 + k * 1024); } while (0)
#define PG8_MMA(ai, bj, At, Bt) do { __builtin_amdgcn_s_setprio(1); _Pragma("unroll") for (int m = 0; m < 4; ++m) _Pragma("unroll") for (int n = 0; n < 2; ++n) _Pragma("unroll") for (int k = 0; k < 2; ++k) \
        acc[ai][bj][m][n] = __builtin_amdgcn_mfma_f32_16x16x32_bf16(Bt[n][k], At[m][k], acc[ai][bj][m][n], 0, 0, 0); __builtin_amdgcn_s_setprio(0); } while (0)
#define PG8_WAIT_V(n) asm volatile("s_waitcnt vmcnt(" #n ")" ::: "memory")
#define PG8_WAIT_L(n) asm volatile("s_waitcnt lgkmcnt(" #n ")" ::: "memory")
#define PG8_BAR __builtin_amdgcn_s_barrier()
#define PG8_SCHED __builtin_amdgcn_sched_barrier(0)
    Unit cur, nxt; int ui = 0;
    if (!S.next(0, cur)) return;
    f32x4 acc[2][2][4][2];
#pragma unroll
    for (int a = 0; a < 2; ++a)
#pragma unroll
        for (int b = 0; b < 2; ++b)
#pragma unroll
            for (int m = 0; m < 4; ++m)
#pragma unroll
                for (int n = 0; n < 2; ++n) acc[a][b][m][n] = (f32x4){0.f, 0.f, 0.f, 0.f};
    bf16x8 At[4][2], B0[2][2], B1[2][2];
    const char* cA = (const char*)g.A + (size_t)cur.pm * tstep + cur.koff; const char* cB = (const char*)g.Bt + (size_t)cur.pn * tstep + cur.koff;
    S.a_ready(cur);
    if constexpr (SP2) {
        PG8_STAGE(PG8_SB(0, 0), cB, voffB); PG8_STAGE(PG8_SB(0, 1), cB + hstep, voffB); PG8_STAGE(PG8_SA(0, 0), cA, voffA); PG8_STAGE(PG8_SA(0, 1), cA + hstep, voffA);
        if (wr == 1) PG8_BAR;
        PG8_WAIT_V(2); PG8_BAR;
        PG8_STAGE(PG8_SB(1, 0), cB + kstep, voffB); PG8_STAGE(PG8_SA(1, 0), cA + kstep, voffA); PG8_STAGE(PG8_SB(1, 1), cB + hstep + kstep, voffB);
        PG8_WAIT_V(6); PG8_BAR;
    } else {
        PG8_STAGE(PG8_SB(0, 0), cB, voffB); PG8_STAGE(PG8_SA(0, 0), cA, voffA); PG8_STAGE(PG8_SB(0, 1), cB + hstep, voffB); PG8_STAGE(PG8_SA(0, 1), cA + hstep, voffA);
        if (wr == 1) PG8_BAR;
        PG8_WAIT_V(4); PG8_BAR;
        PG8_STAGE(PG8_SB(1, 0), cB + kstep, voffB); PG8_STAGE(PG8_SA(1, 0), cA + kstep, voffA); PG8_STAGE(PG8_SB(1, 1), cB + hstep + kstep, voffB);
        PG8_WAIT_V(6); PG8_BAR;
    }
    for (;;) {
        const bool has_next = S.next(ui + 1, nxt);
        const char* nA = has_next ? (const char*)g.A + (size_t)nxt.pm * tstep + nxt.koff : cA; const char* nB = has_next ? (const char*)g.Bt + (size_t)nxt.pn * tstep + nxt.koff : cB;
        for (int t = 0; t < nt; t += 2) {
            const bool last = (t == nt - 2);
            const char* a1 = cA + (size_t)(t + 1) * kstep;
            const char* a2 = last ? nA : cA + (size_t)(t + 2) * kstep; const char* b2 = last ? nB : cB + (size_t)(t + 2) * kstep;
            const char* a3 = a2 + kstep; const char* b3 = b2 + kstep;
            if (last && has_next) S.a_ready(nxt);
            if constexpr (SP2) {
            PG8_LDB(B0, 0, 0); PG8_LDB(B1, 0, 1); PG8_SCHED; PG8_LDA(At, 0, 0); PG8_STAGE(PG8_SA(1, 1), a1 + hstep, voffA);
            PG8_WAIT_V(8); PG8_WAIT_L(0); PG8_BAR; PG8_MMA(0, 0, At, B0); PG8_MMA(0, 1, At, B1); PG8_BAR; PG8_SCHED;
            PG8_LDA(At, 0, 1); PG8_STAGE(PG8_SB(0, 0), b2, voffB); PG8_STAGE(PG8_SB(0, 1), b2 + hstep, voffB); PG8_STAGE(PG8_SA(0, 0), a2, voffA);
            PG8_WAIT_V(8); PG8_WAIT_L(0); PG8_BAR; PG8_MMA(1, 0, At, B0); PG8_MMA(1, 1, At, B1); PG8_BAR; PG8_SCHED;
            PG8_LDB(B0, 1, 0); PG8_LDB(B1, 1, 1); PG8_SCHED; PG8_LDA(At, 1, 0); PG8_STAGE(PG8_SA(0, 1), a2 + hstep, voffA);
            PG8_WAIT_V(8); PG8_WAIT_L(0); PG8_BAR; PG8_MMA(0, 0, At, B0); PG8_MMA(0, 1, At, B1); PG8_BAR; PG8_SCHED;
            PG8_LDA(At, 1, 1); PG8_STAGE(PG8_SB(1, 0), b3, voffB); PG8_STAGE(PG8_SB(1, 1), b3 + hstep, voffB); PG8_STAGE(PG8_SA(1, 0), a3, voffA);
            PG8_WAIT_V(8); PG8_WAIT_L(0); PG8_BAR; PG8_MMA(1, 0, At, B0); PG8_MMA(1, 1, At, B1); PG8_BAR; PG8_SCHED;
            } else {
            PG8_LDB(B0, 0, 0); PG8_SCHED; PG8_LDA(At, 0, 0); PG8_STAGE(PG8_SA(1, 1), a1 + hstep, voffA);
            PG8_WAIT_L(8); PG8_BAR; PG8_WAIT_L(0); PG8_MMA(0, 0, At, B0); PG8_BAR; PG8_SCHED;
            PG8_LDB(B1, 0, 1); PG8_STAGE(PG8_SB(0, 0), b2, voffB);
            PG8_BAR; PG8_WAIT_L(0); PG8_MMA(0, 1, At, B1); PG8_BAR;
            PG8_LDA(At, 0, 1); PG8_STAGE(PG8_SA(0, 0), a2, voffA);
            PG8_BAR; PG8_WAIT_L(0); PG8_MMA(1, 0, At, B0); PG8_BAR; PG8_SCHED;
            PG8_STAGE(PG8_SB(0, 1), b2 + hstep, voffB);
            PG8_WAIT_V(6); PG8_BAR; PG8_MMA(1, 1, At, B1); PG8_BAR;
            PG8_LDB(B0, 1, 0); PG8_SCHED; PG8_LDA(At, 1, 0); PG8_STAGE(PG8_SA(0, 1), a2 + hstep, voffA);
            PG8_WAIT_L(8); PG8_BAR; PG8_WAIT_L(0); PG8_MMA(0, 0, At, B0); PG8_BAR; PG8_SCHED;
            PG8_LDB(B1, 1, 1); PG8_STAGE(PG8_SB(1, 0), b3, voffB);
            PG8_BAR; PG8_WAIT_L(0); PG8_MMA(0, 1, At, B1); PG8_BAR;
            PG8_LDA(At, 1, 1); PG8_STAGE(PG8_SA(1, 0), a3, voffA);
            PG8_BAR; PG8_WAIT_L(0); PG8_MMA(1, 0, At, B0); PG8_BAR; PG8_SCHED;
            PG8_STAGE(PG8_SB(1, 1), b3 + hstep, voffB);
            PG8_WAIT_V(6); PG8_BAR; PG8_MMA(1, 1, At, B1); PG8_BAR;
            }
        }
        if constexpr (ALIGN_EPI) { if (wr == 0) PG8_BAR; }
        if constexpr (!Epi::AFTER_DRAIN) { const int el = fresh_lane(); E(acc, cur, wr, wc, el & 15, el >> 4); S.done(cur); PG8_ADDR(); }
        if (!has_next) break;
#pragma unroll
        for (int a = 0; a < 2; ++a)
#pragma unroll
            for (int b = 0; b < 2; ++b)
#pragma unroll
                for (int m = 0; m < 4; ++m)
#pragma unroll
                    for (int n = 0; n < 2; ++n) acc[a][b][m][n] = (f32x4){0.f, 0.f, 0.f, 0.f};
        cur = nxt; cA = nA; cB = nB; ++ui;
        if constexpr (ALIGN_EPI) { if (wr == 1) PG8_BAR; }
    }
    PG8_WAIT_V(0);
    if constexpr (!ALIGN_EPI) { if (wr == 0) PG8_BAR; }
    PG8_BAR;
    if constexpr (Epi::AFTER_DRAIN) { E.fused(acc, cur, wr, wc, fr, fq, lds, wid, lane); S.done(cur); }
#undef PG8_ADDR
#undef PG8_SA
#undef PG8_SB
#undef PG8_STAGE
#undef PG8_LDA
#undef PG8_LDB
#undef PG8_MMA
#undef PG8_WAIT_V
#undef PG8_WAIT_L
#undef PG8_BAR
#undef PG8_SCHED
}
}
#define GAS __attribute__((address_space(1)))
#define LAS __attribute__((address_space(3)))
typedef unsigned short bf16;
typedef unsigned v4u __attribute__((ext_vector_type(4)));
typedef float f32x4 __attribute__((ext_vector_type(4)));
typedef short bf16x8 __attribute__((ext_vector_type(8)));
typedef GAS unsigned gu32;
typedef GAS unsigned long long gu64;
#define RLX_AGENT __ATOMIC_RELAXED, __HIP_MEMORY_SCOPE_AGENT
#define LDS_WAIT() asm volatile("s_waitcnt lgkmcnt(0)" ::: "memory")
#define VM_WAIT() asm volatile("s_waitcnt vmcnt(0)" ::: "memory")
__device__ __forceinline__ unsigned long long rt() { return __builtin_amdgcn_s_memrealtime(); }
__device__ __forceinline__ unsigned f2bf(float f) { unsigned u = __builtin_bit_cast(unsigned, f); return (u + 0x7fffu + ((u >> 16) & 1u)) >> 16; }
typedef __bf16 bf2v_t __attribute__((ext_vector_type(2)));
__device__ __forceinline__ unsigned pk2(float lo, float hi) { bf2v_t v; v.x = (__bf16)lo; v.y = (__bf16)hi; return __builtin_bit_cast(unsigned, v); }

#define XB_TMO      128
#define XB_XCNT(j)  (256  + 64 * (j))
#define XB_XSUB(j)  (1280 + 64 * (j))
#define XB_XGEN(j)  (2304 + 64 * (j))
#define XB_TOP      3328
#define XB_TOPGEN   3392
#define XCD_BAR_WORDS 3456
#define XB_SPIN_CAP (1u << 18)

__device__ __forceinline__ unsigned xb_ld(unsigned* p)              { return __hip_atomic_load(p, __ATOMIC_RELAXED, __HIP_MEMORY_SCOPE_AGENT); }
__device__ __forceinline__ unsigned xb_add(unsigned* p, unsigned v) { return __hip_atomic_fetch_add(p, v, __ATOMIC_RELAXED, __HIP_MEMORY_SCOPE_AGENT); }
__device__ __forceinline__ unsigned xb_xcc_id() { return (unsigned)__builtin_amdgcn_s_getreg((3 << 11) | 20) & 0xFu; }
#define XB_SPIN(cond, bar) do { unsigned _sp = 0; while (cond) { __builtin_amdgcn_s_sleep(1); \
    if ((++_sp & 255u) == 0u) { if (xb_ld(&(bar)[XB_TMO])) break; if (_sp > XB_SPIN_CAP) { atomicAdd(&(bar)[XB_TMO], 1u); break; } } } } while (0)

struct XcdBarrier {
    unsigned* bar; unsigned x;
    volatile LAS unsigned* st;
};

__device__ __forceinline__ XcdBarrier xcd_barrier_post(unsigned* bar, volatile LAS unsigned* st) {
    XcdBarrier b; b.bar = bar; b.x = xb_xcc_id(); b.st = st;
    if (threadIdx.x == 0) (void)xb_add(&bar[XB_XCNT(b.x)], 1u);
    return b;
}
__device__ __forceinline__ void xcd_barrier_complete(unsigned* bar, unsigned x, unsigned& nloc, unsigned& nx) {
    const unsigned G = gridDim.x * gridDim.y * gridDim.z;
    unsigned sum, cnt, mine, sp = 0u;
    for (;;) {
        sum = 0u; cnt = 0u; mine = 0u;
#pragma unroll
        for (unsigned j = 0; j < 16; ++j) { const unsigned c = xb_ld(&bar[XB_XCNT(j)]); sum += c; cnt += (c > 0u) ? 1u : 0u; mine = (j == x) ? c : mine; }
        if (sum == G) break;
        __builtin_amdgcn_s_sleep(1);
        if ((++sp & 255u) == 0u) { if (xb_ld(&bar[XB_TMO])) break; if (sp > XB_SPIN_CAP) { atomicAdd(&bar[XB_TMO], 1u); break; } }
    }
    nloc = mine > 0u ? mine : 1u; nx = cnt > 0u ? cnt : 1u;
}

__device__ __forceinline__ void xcd_barrier(const XcdBarrier& b, const int wave) {
    asm volatile("s_waitcnt vmcnt(0)" ::: "memory");
    __syncthreads();
    if (wave == 0 && fresh_lane() == 0) {
        unsigned* bar = b.bar; asm volatile("" : "+s"(bar)); const unsigned bx_ = xb_xcc_id();
        __builtin_amdgcn_s_waitcnt(0);
        unsigned nloc = b.st[0], nx = b.st[1];
        if (nloc == 0u) { xcd_barrier_complete(bar, bx_, nloc, nx); b.st[0] = nloc; b.st[1] = nx; }
        const unsigned old = xb_add(&bar[XB_XSUB(bx_)], 1u);
        const unsigned gen = old / nloc;
        if (old + 1u == (gen + 1u) * nloc) {
            __builtin_amdgcn_fence(__ATOMIC_RELEASE, "agent");
            asm volatile("s_waitcnt vmcnt(0)" ::: "memory");
            const unsigned og = xb_add(&bar[XB_TOP], 1u);
            const unsigned tg = og / nx;
            if (og + 1u == (tg + 1u) * nx) xb_add(&bar[XB_TOPGEN], 1u);
            else XB_SPIN(xb_ld(&bar[XB_TOPGEN]) == tg, bar);
            __builtin_amdgcn_fence(__ATOMIC_ACQUIRE, "agent");
            xb_add(&bar[XB_XGEN(bx_)], 1u);
            asm volatile("s_waitcnt vmcnt(0)" ::: "memory");
        } else {
            XB_SPIN(xb_ld(&bar[XB_XGEN(bx_)]) == gen, bar);
            __builtin_amdgcn_fence(__ATOMIC_ACQUIRE, "agent");
            asm volatile("s_waitcnt vmcnt(0)" ::: "memory");
        }
    }
    __syncthreads();
}


#ifndef PHM
#define PHM 0xFFFF
#endif
#ifndef DUPM
#define DUPM 0
#endif
#ifndef DUPS
#define DUPS 0
#endif
constexpr int NWAVES = 8;
constexpr int D = 1024, NB = 4, T = 8192, TC = 256, NL = 2;
constexpr int DC = 512, DR = 512, HS = 64, FF = 2816, PROJ = 3328, NMOD = 6144;
constexpr int MLAT = NB * T, MCTX = NB * TC, M = MLAT + MCTX;
constexpr int NLORA = 2560, KLORA = 256;
constexpr float RMS_EPS = 1e-6f, GN_EPS = 64e-5f, DECAY_SCALE = 0.6065306597126334f;

typedef unsigned short u16;
typedef unsigned v4u __attribute__((ext_vector_type(4)));
typedef unsigned v2u __attribute__((ext_vector_type(2)));
typedef _Float16 h2 __attribute__((ext_vector_type(2)));

constexpr size_t MiB = 1u << 20;
constexpr size_t WS_CTL = 0, CTL_ZERO_BYTES = 1 * MiB;
constexpr size_t WS_MOD = 1 * MiB;
constexpr size_t WS_XCTX = 2 * MiB;
constexpr size_t WS_WIN = 6 * MiB;
constexpr size_t WS_WOUT = 19 * MiB;
constexpr size_t WS_WUP = 23 * MiB;
constexpr size_t WS_WDN = 45 * MiB;
constexpr size_t WS_BLORA = 56 * MiB;
constexpr size_t WS_XN = 60 * MiB;
constexpr size_t WS_PC = 126 * MiB;
constexpr size_t WS_PRKV = 225 * MiB;
constexpr size_t WS_ALORA = 324 * MiB;
constexpr size_t WS_DEC = 341 * MiB;
constexpr size_t WS_AA = 407 * MiB;
constexpr size_t WS_GATE = 473 * MiB;
constexpr size_t WS_GATEB = 126 * MiB;
constexpr size_t WS_VALB = 308 * MiB;
constexpr size_t WS_END = 506 * MiB;
static_assert(WS_XN + (size_t)M * D * 2 <= WS_PC, "map");
static_assert(WS_PC + (size_t)M * 1536 * 2 <= WS_PRKV, "map");
static_assert(WS_PRKV + (size_t)M * 1536 * 2 <= WS_ALORA, "map");
static_assert(WS_ALORA + (size_t)M * 256 * 2 <= WS_DEC, "map");
static_assert(WS_DEC + (size_t)M * 1024 * 2 <= WS_AA, "map");
static_assert(WS_AA + (size_t)M * 1024 * 2 <= WS_GATE, "map");
static_assert(WS_GATE + (size_t)M * 512 * 2 <= WS_END, "map");
static_assert(WS_GATEB + (size_t)M * FF * 2 <= WS_VALB, "map");
static_assert(WS_VALB + (size_t)M * FF * 2 <= WS_END, "map");
static_assert(WS_BLORA + (size_t)NL * NLORA * KLORA * 2 <= WS_XN, "map");
constexpr int CW_BAR = 4096;

constexpr int RING_OFF = 0, RING_BYTES = 131072;
constexpr int LDS_BYTES = 147456;
constexpr int LDSCTL_OFF = LDS_BYTES - 1024, MISC_OFF = LDSCTL_OFF + 320;

#ifdef NT_M2
#define ST_NT2(ptr_, val_) __builtin_nontemporal_store((val_), (ptr_))
#else
#define ST_NT2(ptr_, val_) (*(ptr_) = (val_))
#endif
#ifdef NT_C
#define ST_NT3(ptr_, val_) __builtin_nontemporal_store((val_), (ptr_))
#else
#define ST_NT3(ptr_, val_) (*(ptr_) = (val_))
#endif
#ifndef NO_NT
#define ST_NT(ptr_, val_) __builtin_nontemporal_store((val_), (ptr_))
#else
#define ST_NT(ptr_, val_) (*(ptr_) = (val_))
#endif
__device__ __forceinline__ unsigned pk_bf16(float lo, float hi) { return pk2(lo, hi); }
__device__ __forceinline__ unsigned pk_f16(float lo, float hi) { h2 v; v.x = (_Float16)lo; v.y = (_Float16)hi; return __builtin_bit_cast(unsigned, v); }
__device__ __forceinline__ void unpk_f16(unsigned u, float& lo, float& hi) { const h2 v = __builtin_bit_cast(h2, u); lo = (float)v.x; hi = (float)v.y; }
__device__ __forceinline__ void unpk8_f16(const v4u u, float (&f)[8]) { unpk_f16(u.x, f[0], f[1]); unpk_f16(u.y, f[2], f[3]); unpk_f16(u.z, f[4], f[5]); unpk_f16(u.w, f[6], f[7]); }
__device__ __forceinline__ float sigmoidf_(float x) { return __builtin_amdgcn_rcpf(1.0f + __builtin_amdgcn_exp2f(-1.4426950408889634f * x)); }
__device__ __forceinline__ float siluf_(float x) { return x * __builtin_amdgcn_rcpf(1.0f + __builtin_amdgcn_exp2f(-1.4426950408889634f * x)); }
__device__ __forceinline__ float tanhf_(float x) { const float e = __builtin_amdgcn_exp2f(-2.8853900817779268f * fabsf(x)); const float t = (1.0f - e) * __builtin_amdgcn_rcpf(1.0f + e); return x < 0.f ? -t : t; }
template <int CTRL> __device__ __forceinline__ float dppf(float x) { return __builtin_bit_cast(float, __builtin_amdgcn_update_dpp(0, __builtin_bit_cast(int, x), CTRL, 0xF, 0xF, true)); }
template <int CTRL, int ROWMASK> __device__ __forceinline__ float dpp1(float x) { return __builtin_bit_cast(float, __builtin_amdgcn_update_dpp(0x3f800000, __builtin_bit_cast(int, x), CTRL, ROWMASK, 0xF, false)); }
__device__ __forceinline__ float allreduce16(float x) { x += dppf<0x121>(x); x += dppf<0x122>(x); x += dppf<0x124>(x); x += dppf<0x128>(x); return x; }
__device__ __forceinline__ float group8_sum(float v) { v += dppf<0xB1>(v); v += dppf<0x4E>(v); v += dppf<0x141>(v); return v; }
__device__ __forceinline__ float wave_sum(float v) {
    v = allreduce16(v);
    const int vi = __builtin_bit_cast(int, v);
    const float s0 = __builtin_bit_cast(float, __builtin_amdgcn_readlane(vi, 0)), s1 = __builtin_bit_cast(float, __builtin_amdgcn_readlane(vi, 16)), s2 = __builtin_bit_cast(float, __builtin_amdgcn_readlane(vi, 32)), s3 = __builtin_bit_cast(float, __builtin_amdgcn_readlane(vi, 48));
    return (s0 + s1) + (s2 + s3);
}

#define IN_X 0
#define IN_C 1
#define IN_CTX 2
#define IN_CCTX 3
#define IN_ADAW 4
#define IN_ADAB 5
#define IN_N1G 6
#define IN_N2G 7
#define IN_WIN 8
#define IN_CONVA 9
#define IN_W0 10
#define IN_WUP 11
#define IN_A0 12
#define IN_AUP 13
#define IN_KK 14
#define IN_KA 15
#define IN_RK 16
#define IN_GUP 17
#define IN_LNG 18
#define IN_LNB 19
#define IN_WOUT 20
#define IN_FUP 21
#define IN_FCW 22
#define IN_FCB 23
#define IN_FDN 24
#define IN_FG 25
struct Args;
__device__ __forceinline__ const float* inp(const Args& a, int i);
struct EpiArgs {
    unsigned char* ws; float* out; const Args* ap; int l; int in_is_input; int goff;
};
template <int MODE> struct Epi {
    static constexpr bool PERM = true, AFTER_DRAIN = false;
    EpiArgs a;
    __device__ __forceinline__ void operator()(const pg8::f32x4 (&acc)[2][2][4][2], const pg8::Unit& u, int wr, int wc, int fr, int fq) const {
        using pg8::f32x4;
        const int row0 = u.pm * 256 + wr * 64 + fr;
        const int colb = u.pn * 256 + wc * 32 + 8 * fq;
        unsigned char* const ws_ = a.ws;
        if constexpr (MODE == 0) {
#pragma unroll
            for (int ai = 0; ai < 2; ++ai)
#pragma unroll
                for (int bj = 0; bj < 2; ++bj)
#pragma unroll
                    for (int m = 0; m < 4; ++m) { asm volatile("" :: "v"(acc[ai][bj][m][0]), "v"(acc[ai][bj][m][1])); }
        } else if constexpr (MODE == 1) {
#pragma unroll
            for (int ai = 0; ai < 2; ++ai)
#pragma unroll
                for (int m = 0; m < 4; ++m) {
                    const size_t row = (size_t)(row0 + ai * 128 + m * 16);
                    if (u.pn >= 2 && u.pn < 6) {
                        const f32x4 c0v = acc[ai][0][m][0], c1v = acc[ai][0][m][1], x0v = acc[ai][1][m][0], x1v = acc[ai][1][m][1];
                        v4u w; w.x = pk_f16(c0v[0] * x0v[0], c0v[1] * x0v[1]); w.y = pk_f16(c0v[2] * x0v[2], c0v[3] * x0v[3]); w.z = pk_f16(c1v[0] * x1v[0], c1v[1] * x1v[1]); w.w = pk_f16(c1v[2] * x1v[2], c1v[3] * x1v[3]);
                        *(v4u*)((u16*)(ws_ + WS_PC) + row * 1536 + 512 + (u.pn - 2) * 128 + wc * 32 + 8 * fq) = w;
                    } else
#pragma unroll
                    for (int bj = 0; bj < 2; ++bj) {
                        const f32x4 v0 = acc[ai][bj][m][0], v1 = acc[ai][bj][m][1];
                        const int col = colb + bj * 128;
                        v4u w;
                        if (u.pn < 12) {
                            w.x = pk_f16(v0[0], v0[1]); w.y = pk_f16(v0[2], v0[3]); w.z = pk_f16(v1[0], v1[1]); w.w = pk_f16(v1[2], v1[3]);
                            u16* dst = (u.pn < 6) ? ((u16*)(ws_ + WS_PC) + row * 1536 + col) : ((u16*)(ws_ + WS_PRKV) + row * 1536 + (col - 1536));
#ifdef NT_PRKV
                            if (u.pn >= 6) __builtin_nontemporal_store(w, (v4u*)dst); else *(v4u*)dst = w;
#else
                            *(v4u*)dst = w;
#endif
                        } else {
                            const int cl = col - 3072;
                            float f[8] = {v0[0], v0[1], v0[2], v0[3], v1[0], v1[1], v1[2], v1[3]};
#pragma unroll
                            for (int j = 0; j < 8; ++j) f[j] = (cl < 64) ? tanhf_(f[j]) : ((cl < 128) ? f[j] : sigmoidf_(f[j]));
                            w.x = pk_bf16(f[0], f[1]); w.y = pk_bf16(f[2], f[3]); w.z = pk_bf16(f[4], f[5]); w.w = pk_bf16(f[6], f[7]);
                            *(v4u*)((u16*)(ws_ + WS_ALORA) + row * 256 + cl) = w;
                        }
                    }
                }
        } else if constexpr (MODE == 2) {
#pragma unroll
            for (int bj = 0; bj < 2; ++bj) {
                const int col = colb + bj * 128;
                float pv[8];
                if (u.pn < 8) { const float* pp = (u.pn < 4) ? (inp(*a.ap, IN_W0) + a.l * 1024 + col) : (inp(*a.ap, IN_A0) + a.l * 1024 + (col - 1024));
#pragma unroll
                    for (int j = 0; j < 8; ++j) pv[j] = pp[j]; }
#pragma unroll
                for (int ai = 0; ai < 2; ++ai)
#pragma unroll
                    for (int m = 0; m < 4; ++m) {
                        const size_t row = (size_t)(row0 + ai * 128 + m * 16);
                        const f32x4 v0 = acc[ai][bj][m][0], v1 = acc[ai][bj][m][1];
                        float f[8] = {v0[0], v0[1], v0[2], v0[3], v1[0], v1[1], v1[2], v1[3]};
                        u16* dst;
                        if (u.pn < 4) {
#pragma unroll
                            for (int j = 0; j < 8; ++j) f[j] = __builtin_amdgcn_exp2f((-DECAY_SCALE * 1.4426950408889634f) * sigmoidf_(pv[j] + f[j]));
                            dst = (u16*)(ws_ + WS_DEC) + row * 1024 + col;
                        } else if (u.pn < 8) {
#pragma unroll
                            for (int j = 0; j < 8; ++j) f[j] = sigmoidf_(pv[j] + f[j]);
                            dst = (u16*)(ws_ + WS_AA) + row * 1024 + (col - 1024);
                        } else dst = (u16*)(ws_ + WS_GATE) + row * 512 + (col - 2048);
                        v4u w; w.x = pk_f16(f[0], f[1]); w.y = pk_f16(f[2], f[3]); w.z = pk_f16(f[4], f[5]); w.w = pk_f16(f[6], f[7]);
                        ST_NT2((v4u*)dst, w);
                        asm volatile("" ::: "memory");
                    }
            }
        } else if constexpr (MODE == 3) {
            const int s = (u.pm < 128) ? (u.pm >> 5) : 4;
            const bool lat = u.pm < 128;
            const bool fin = (a.l == NL - 1) && (a.goff == 5120);
            const float* modp = (const float*)(ws_ + WS_MOD) + (size_t)a.l * 5 * NMOD + a.goff;
            u16* const xb = lat ? (u16*)a.out : (u16*)(ws_ + WS_XCTX);
            u16* const ob = fin ? (u16*)(ws_ + WS_XN) : xb;
            const float* const ibase = lat ? inp(*a.ap, IN_X) : inp(*a.ap, IN_CTX);
#pragma unroll
            for (int bj = 0; bj < 2; ++bj) {
                const int col = colb + bj * 128;
                const f32x4 g0 = *(const f32x4*)(modp + s * NMOD + col), g1 = *(const f32x4*)(modp + s * NMOD + col + 4);
#pragma unroll
                for (int ai = 0; ai < 2; ++ai)
#pragma unroll
                    for (int m = 0; m < 4; ++m) {
                        const int row = row0 + ai * 128 + m * 16;
                        const size_t off = lat ? ((size_t)row * D + col) : ((size_t)(row - MLAT) * D + col);
                        f32x4 x0, x1;
                        if (a.in_is_input) { x0 = *(const f32x4*)(ibase + off); x1 = *(const f32x4*)(ibase + off + 4); }
                        else { const v4u xu = *(const v4u*)(xb + off);
                            x0 = (f32x4){__uint_as_float(xu.x << 16), __uint_as_float(xu.x & 0xffff0000u), __uint_as_float(xu.y << 16), __uint_as_float(xu.y & 0xffff0000u)};
                            x1 = (f32x4){__uint_as_float(xu.z << 16), __uint_as_float(xu.z & 0xffff0000u), __uint_as_float(xu.w << 16), __uint_as_float(xu.w & 0xffff0000u)}; }
                        const f32x4 y0 = x0 + g0 * acc[ai][bj][m][0], y1 = x1 + g1 * acc[ai][bj][m][1];
                        v4u w; w.x = pk2(y0[0], y0[1]); w.y = pk2(y0[2], y0[3]); w.z = pk2(y1[0], y1[1]); w.w = pk2(y1[2], y1[3]);
                        *(v4u*)(ob + off) = w;
                    }
            }
        } else {
#pragma unroll
            for (int ai = 0; ai < 2; ++ai)
#pragma unroll
                for (int m = 0; m < 4; ++m) {
                    const size_t row = (size_t)(row0 + ai * 128 + m * 16);
#pragma unroll
                    for (int bj = 0; bj < 2; ++bj) {
                        const f32x4 v0 = acc[ai][bj][m][0], v1 = acc[ai][bj][m][1];
                        const int col = colb + bj * 128;
                        v4u w; w.x = pk_f16(v0[0], v0[1]); w.y = pk_f16(v0[2], v0[3]); w.z = pk_f16(v1[0], v1[1]); w.w = pk_f16(v1[2], v1[3]);
                        u16* dst = (u.pn < 11) ? ((u16*)(ws_ + WS_GATEB) + row * FF + col) : ((u16*)(ws_ + WS_VALB) + row * FF + (col - FF));
                        ST_NT((v4u*)dst, w);
                    }
                }
        }
    }
};

struct Frame {
    LAS unsigned char* lds;
    volatile LAS unsigned* MISC;
    gu32* ctl;
    int tid, lane, wave, vcu, G;
    float* out;
    unsigned char* ws;
};
#define PHASE_BEGIN(F) do { (F).lane = fresh_lane(); (F).tid = (F).wave * 64 + (F).lane; } while (0)

__device__ __forceinline__ void p0_mod(Frame& F, const float* cvec, const float* cctx, const float* adaw, const float* adab) {
    PHASE_BEGIN(F);
    LAS float* sl = (LAS float*)(F.lds);
    LAS float* red = (LAS float*)(F.lds + 20480);
    float* mod = (float*)(F.ws + WS_MOD);
    const int nchunk = NL * (NMOD / 64);
    if ((int)blockIdx.x >= nchunk) return;
    for (int i = F.tid; i < 5 * 1024; i += NWAVES * 64) { const int s = i >> 10, k = i & 1023; const float c = (s < 4) ? cvec[s * 1024 + k] : cctx[k]; sl[i] = siluf_(c); }
    __syncthreads();
    for (int ci = blockIdx.x; ci < nchunk; ci += F.G) {
        const int l = ci / (NMOD / 64), n = (ci % (NMOD / 64)) * 64 + F.lane;
        const float* w = adaw + (size_t)l * D * NMOD + n;
        float acc[5] = {0.f, 0.f, 0.f, 0.f, 0.f};
        const int k0 = F.wave * 128;
#pragma unroll 8
        for (int k = k0; k < k0 + 128; ++k) { const float wv = w[(size_t)k * NMOD];
#pragma unroll
            for (int s = 0; s < 5; ++s) acc[s] += sl[s * 1024 + k] * wv; }
#pragma unroll
        for (int s = 0; s < 5; ++s) red[(F.wave * 5 + s) * 64 + F.lane] = acc[s];
        __syncthreads();
        if (F.tid < 320) { const int s = F.tid >> 6, ln = F.tid & 63; float t = 0.f;
#pragma unroll
            for (int w8 = 0; w8 < 8; ++w8) t += red[(w8 * 5 + s) * 64 + ln];
            const int nn = (ci % (NMOD / 64)) * 64 + ln;
            mod[((size_t)l * 5 + s) * NMOD + nn] = t + adab[l * NMOD + nn]; }
        __syncthreads();
    }
}
__device__ __forceinline__ void p0_transpose_item(const float* W, int K, int N, u16* WT, LAS float* scr, int item, int lane, const bool perm_in = false) {
    const int nblk = N / 32, kb = item / nblk, nb = item % nblk, k0 = 64 * kb, n0 = 32 * nb;
    int d0 = n0;
    if (perm_in && n0 >= 512 && n0 < 1536) { const int isx = n0 >= 1024, c = n0 - (isx ? 1024 : 512); d0 = 512 + 256 * (c >> 7) + 128 * isx + (c & 127); }
#pragma unroll 8
    for (int i = 0; i < 32; ++i) { const int kk = 2 * i + (lane >> 5); scr[kk * 33 + (lane & 31)] = W[(size_t)(k0 + kk) * N + n0 + (lane & 31)]; }
    LDS_WAIT(); asm volatile("" ::: "memory");
    const int c = lane & 7;
#pragma unroll
    for (int j = 0; j < 4; ++j) { const int n = (lane >> 3) + 8 * j; const LAS float* s = scr + (8 * c) * 33 + n;
        v4u o; o.x = pk2(s[0 * 33], s[1 * 33]); o.y = pk2(s[2 * 33], s[3 * 33]); o.z = pk2(s[4 * 33], s[5 * 33]); o.w = pk2(s[6 * 33], s[7 * 33]);
        *(GAS v4u*)(WT + (size_t)(d0 + n) * K + k0 + 8 * c) = o; }
    LDS_WAIT(); asm volatile("" ::: "memory");
}
__device__ __forceinline__ void p0_weights(Frame& F, const float* win, const float* wout, const float* fup, const float* fdn, const float* wup, const float* aup, const float* gup) {
    PHASE_BEGIN(F);
    LAS float* scr = (LAS float*)(F.lds + 32768 + F.wave * 8704);
    const int gw = F.vcu * NWAVES + F.wave, NGW = F.G * NWAVES;
    constexpr int I_IN = (D / 64) * (PROJ / 32), I_OUT = (D / 64) * (D / 32), I_UP = (D / 64) * (2 * FF / 32), I_DN = (FF / 64) * (D / 32);
    constexpr int PER_L = I_IN + I_OUT + I_UP + I_DN;
    for (int it = gw; it < NL * PER_L; it += NGW) {
        const int l = it / PER_L; int r = it % PER_L;
        if (r < I_IN) { p0_transpose_item(win + (size_t)l * D * PROJ, D, PROJ, (u16*)(F.ws + WS_WIN) + (size_t)l * PROJ * D, scr, r, F.lane, true); continue; } r -= I_IN;
        if (r < I_OUT) { p0_transpose_item(wout + (size_t)l * D * D, D, D, (u16*)(F.ws + WS_WOUT) + (size_t)l * D * D, scr, r, F.lane); continue; } r -= I_OUT;
        if (r < I_UP) { p0_transpose_item(fup + (size_t)l * D * 2 * FF, D, 2 * FF, (u16*)(F.ws + WS_WUP) + (size_t)l * 2 * FF * D, scr, r, F.lane); continue; } r -= I_UP;
        p0_transpose_item(fdn + (size_t)l * FF * D, FF, D, (u16*)(F.ws + WS_WDN) + (size_t)l * D * FF, scr, r, F.lane);
    }
    const int gt = F.vcu * NWAVES * 64 + F.tid, NGT = F.G * NWAVES * 64;
    u16* bl = (u16*)(F.ws + WS_BLORA);
    for (int e = gt; e < NL * NLORA * (KLORA / 8); e += NGT) {
        const int kc = e % (KLORA / 8), n = (e / (KLORA / 8)) % NLORA, l = e / ((KLORA / 8) * NLORA);
        float f[8];
#pragma unroll
        for (int j = 0; j < 8; ++j) { const int k = kc * 8 + j; float v = 0.f;
            if (n < 1024) { if (k < 64) v = wup[(((size_t)l * 2 + (n >> 9)) * 64 + k) * 512 + (n & 511)]; }
            else if (n < 2048) { if (k >= 64 && k < 128) v = aup[(((size_t)l * 2 + ((n - 1024) >> 9)) * 64 + (k - 64)) * 512 + (n & 511)]; }
            else { if (k >= 128) v = gup[((size_t)l * 128 + (k - 128)) * 512 + (n - 2048)]; }
            f[j] = v; }
        v4u o; o.x = pk2(f[0], f[1]); o.y = pk2(f[2], f[3]); o.z = pk2(f[4], f[5]); o.w = pk2(f[6], f[7]);
        *(v4u*)(bl + ((size_t)l * NLORA + n) * KLORA + kc * 8) = o;
    }
}
__device__ __forceinline__ void norm_rows(Frame& F, const float* xl, const float* xc, const bool bf, const float* g, const float* modl, int sh_off, int sc_off, int nrows) {
    PHASE_BEGIN(F);
    const int gw = F.vcu * NWAVES + F.wave, NGW = F.G * NWAVES;
    u16* XN = (u16*)(F.ws + WS_XN);
    pg8::f32x4 gv[4];
#pragma unroll
    for (int j = 0; j < 4; ++j) gv[j] = *(const pg8::f32x4*)(g + 4 * F.lane + 256 * j);
    for (int r = gw; r < nrows; r += NGW) {
        const int s = (r < MLAT) ? (r >> 13) : 4;
        const float* xr = (r < MLAT) ? (xl + (size_t)r * D) : (xc + (size_t)(r - MLAT) * D);
        const u16* xl_or_xc16 = (r < MLAT) ? ((const u16*)xl + (size_t)r * D) : ((const u16*)xc + (size_t)(r - MLAT) * D);
        pg8::f32x4 v[4]; float ss = 0.f;
#pragma unroll
        for (int j = 0; j < 4; ++j) {
            if (bf) { const v2u xu = *(const v2u*)((const u16*)xl_or_xc16 + 4 * F.lane + 256 * j); v[j] = (pg8::f32x4){__uint_as_float(xu.x << 16), __uint_as_float(xu.x & 0xffff0000u), __uint_as_float(xu.y << 16), __uint_as_float(xu.y & 0xffff0000u)}; }
            else v[j] = *(const pg8::f32x4*)(xr + 4 * F.lane + 256 * j);
            ss += (v[j][0] * v[j][0] + v[j][1] * v[j][1]) + (v[j][2] * v[j][2] + v[j][3] * v[j][3]); }
        const float rstd = rsqrtf(wave_sum(ss) * (1.0f / D) + RMS_EPS);
        const float* shp = modl + s * NMOD + sh_off; const float* scp = modl + s * NMOD + sc_off;
#pragma unroll
        for (int j = 0; j < 4; ++j) {
            const pg8::f32x4 sh = *(const pg8::f32x4*)(shp + 4 * F.lane + 256 * j), sc = *(const pg8::f32x4*)(scp + 4 * F.lane + 256 * j);
            const pg8::f32x4 y = (v[j] * rstd) * gv[j];
            const pg8::f32x4 h = y * (sc + 1.0f) + sh;
            v2u o; o.x = pk2(h[0], h[1]); o.y = pk2(h[2], h[3]);
            *(v2u*)(XN + (size_t)r * D + 4 * F.lane + 256 * j) = o;
        }
    }
}
__device__ __forceinline__ void conv_branch(Frame& F, const float* cw, int nrows) {
    PHASE_BEGIN(F);
    const int gw = F.vcu * NWAVES + F.wave, NGW = F.G * NWAVES;
    const u16* Pc = (const u16*)(F.ws + WS_PC); u16* A2 = (u16*)(F.ws + WS_XN);
    const int c0 = 8 * F.lane;
    float w0[8], w1[8], w2[8];
    {
#pragma unroll
      for (int j = 0; j < 8; ++j) { w0[j] = cw[c0 + j]; w1[j] = cw[DC + c0 + j]; w2[j] = cw[2 * DC + c0 + j]; } }
    for (int r = gw; r < nrows; r += NGW) {
        int t, len; if (r < MLAT) { t = r & (T - 1); len = T; } else { t = (r - MLAT) & (TC - 1); len = TC; }
        const u16* p = Pc + (size_t)r * 1536 + c0;
        const v4u ucb = *(const v4u*)p, uu = *(const v4u*)(p + 512);
        v4u pu = {0u, 0u, 0u, 0u}, nu = pu;
        if (t > 0) pu = *(const v4u*)(p - 1536 + 512);
        if (t < len - 1) nu = *(const v4u*)(p + 1536 + 512);
        float cb[8], uc[8], up[8], un[8], o[8];
        unpk8_f16(ucb, cb); unpk8_f16(uu, uc); unpk8_f16(pu, up); unpk8_f16(nu, un);
#pragma unroll
        for (int j = 0; j < 8; ++j) o[j] = cb[j] * (w0[j] * up[j] + w1[j] * uc[j] + w2[j] * un[j]);
        v4u w; w.x = pk2(o[0], o[1]); w.y = pk2(o[2], o[3]); w.z = pk2(o[4], o[5]); w.w = pk2(o[6], o[7]);
        *(v4u*)(A2 + (size_t)r * D + c0) = w;
    }
}
__device__ __forceinline__ void rwkv_out(Frame& F, const float* lng, const float* lnb, const float* rkp, int nrows) {
    PHASE_BEGIN(F);
    const int gw = F.vcu * NWAVES + F.wave, NGW = F.G * NWAVES;
    const u16* Y = (const u16*)(F.ws + WS_PC); const u16* Prkv = (const u16*)(F.ws + WS_PRKV); const u16* GATE = (const u16*)(F.ws + WS_GATE);
    u16* A2 = (u16*)(F.ws + WS_XN);
    const int c0 = 8 * F.lane;
    float lg[8], lb[8], rk[8];
#pragma unroll
    for (int j = 0; j < 8; ++j) { lg[j] = lng[c0 + j]; lb[j] = lnb[c0 + j]; rk[j] = rkp[c0 + j]; }
    for (int r = gw; r < nrows; r += NGW) {
        const v4u uy0 = *(const v4u*)(Y + (size_t)r * 1024 + c0), uy1 = *(const v4u*)(Y + (size_t)r * 1024 + 512 + c0);
        const u16* p = Prkv + (size_t)r * 1536 + c0;
        const v4u ur = *(const v4u*)p, uk = *(const v4u*)(p + 512), uv = *(const v4u*)(p + 1024);
        const v4u ug = *(const v4u*)(GATE + (size_t)r * 512 + c0);
        float y0[8], y1[8], rr[8], kk[8], vv[8], gg[8], y[8], o[8];
        unpk8_f16(uy0, y0); unpk8_f16(uy1, y1); unpk8_f16(ur, rr); unpk8_f16(uk, kk); unpk8_f16(uv, vv); unpk8_f16(ug, gg);
        float s = 0.f, bs = 0.f;
#pragma unroll
        for (int j = 0; j < 8; ++j) { y[j] = y0[j] + y1[j]; s += y[j]; bs += rr[j] * kk[j] * rk[j]; }
        const float mu = group8_sum(s) * (1.0f / 64.0f); bs = group8_sum(bs);
        float q = 0.f;
#pragma unroll
        for (int j = 0; j < 8; ++j) { const float dd = y[j] - mu; q += dd * dd; }
        const float rstd = rsqrtf(group8_sum(q) * (1.0f / 64.0f) + GN_EPS);
#pragma unroll
        for (int j = 0; j < 8; ++j) o[j] = (((y[j] - mu) * rstd) * lg[j] + lb[j] + bs * vv[j]) * gg[j];
        v4u w; w.x = pk2(o[0], o[1]); w.y = pk2(o[2], o[3]); w.z = pk2(o[4], o[5]); w.w = pk2(o[6], o[7]);
        *(v4u*)(A2 + (size_t)r * D + 512 + c0) = w;
    }
}
namespace ck {
typedef float f32x16 __attribute__((ext_vector_type(16)));
typedef short bf16x8 __attribute__((ext_vector_type(8)));
constexpr int C = 64, PITCH = 144, SLOT = 64 * PITCH;
constexpr int NCHUNK = (TC + T) / C;
constexpr int NQ = 4, CPQ = NCHUNK / NQ;
static_assert(NCHUNK % NQ == 0, "quarters");
constexpr size_t WS_HZ = WS_ALORA;
constexpr size_t WS_GC = WS_ALORA + 4 * MiB;
static_assert(WS_GC + 256 * 8192 <= WS_DEC, "map");
enum { S_KK = 0, S_KT = 1, S_BT = 2, S_RT = 3, S_KKT = 4, S_KTT = 5, S_BTT = 6, S_VT = 7, S_AKK = 8, S_ARK = 9, S_ARB = 10, S_T = 11, S_TT = 12, S_LB = 13, S_AREA = 14 };
enum { S_X1T = S_KK, S_NW1T = S_KT, S_NU0T = S_BT, S_GIMG = S_KTT, S_PIMG = S_VT };
constexpr int AREA_OFF = S_AREA * SLOT;
constexpr int LP = 64;
constexpr int GC_OFF = AREA_OFF + 16384, SEG_OFF = S_LB * SLOT  , END_OFF = GC_OFF + 256;
static_assert(64 * LP * 4 <= 16384 && END_OFF <= LDSCTL_OFF && 8 * 64 * 4 <= SLOT, "chunk-scan LDS map");
#define CK_BAR() do { asm volatile("s_waitcnt lgkmcnt(0)" ::: "memory"); __builtin_amdgcn_s_barrier(); asm volatile("" ::: "memory"); } while (0)
typedef __bf16 bf2_t __attribute__((ext_vector_type(2)));
__device__ __forceinline__ unsigned cvtpk(float lo, float hi) { bf2_t v; v.x = (__bf16)lo; v.y = (__bf16)hi; return __builtin_bit_cast(unsigned, v); }
__device__ __forceinline__ LAS unsigned char* slot(LAS unsigned char* lds, int s) { return lds + s * SLOT; }
template <int KS> __device__ __forceinline__ void tile_mma(f32x16& acc, const LAS unsigned char* A, int arow0, const LAS unsigned char* B, int brow0, int lane, int kb = 0) {
    const int r = lane & 31, h = lane >> 5;
    const LAS unsigned char* pa = A + (arow0 + r) * PITCH + (kb + 8 * h) * 2; const LAS unsigned char* pb = B + (brow0 + r) * PITCH + (kb + 8 * h) * 2;
#pragma unroll
    for (int s = 0; s < KS; ++s) { const bf16x8 a = *(const LAS bf16x8*)(pa + 32 * s), b = *(const LAS bf16x8*)(pb + 32 * s); acc = __builtin_amdgcn_mfma_f32_32x32x16_bf16(a, b, acc, 0, 0, 0); }
}
__device__ __forceinline__ int acc_row(int i, int lane) { return (i & 3) + 8 * (i >> 2) + 4 * (lane >> 5); }
__device__ __forceinline__ f32x16 zero16() { float z; asm volatile("v_mov_b32 %0, 0" : "=v"(z)); f32x16 r; _Pragma("unroll") for (int i = 0; i < 16; ++i) r[i] = z; return r; }
__device__ __forceinline__ void st_rm(const f32x16& acc, LAS unsigned char* M, int row0, int col0, int lane, float sgn = 1.f) {
#pragma unroll
    for (int i = 0; i < 16; i += 2) {
        const unsigned p = cvtpk(sgn * acc[i], sgn * acc[i + 1]);
        LAS unsigned short* q = (LAS unsigned short*)(M + (row0 + acc_row(i, lane)) * PITCH + (col0 + (lane & 31)) * 2);
        q[0] = (unsigned short)(p & 0xffffu); q[PITCH / 2] = (unsigned short)(p >> 16);
    }
}
__device__ __forceinline__ void st_tr(const f32x16& acc, LAS unsigned char* M, int row0, int col0, int lane, float sgn = 1.f) {
#pragma unroll
    for (int g = 0; g < 4; ++g) {
        v2u w; w.x = cvtpk(sgn * acc[4 * g], sgn * acc[4 * g + 1]); w.y = cvtpk(sgn * acc[4 * g + 2], sgn * acc[4 * g + 3]);
        *(LAS v2u*)(M + (col0 + (lane & 31)) * PITCH + (row0 + 8 * g + 4 * (lane >> 5)) * 2) = w;
    }
}
__device__ __forceinline__ void st_rm_q10(const f32x16& acc, LAS unsigned char* M, int row0, int col0, int lane, float sgn = 1.f) {
    if ((lane & 31) < 16) {
#pragma unroll
        for (int i = 8; i < 16; i += 2) {
            const unsigned p = cvtpk(sgn * acc[i], sgn * acc[i + 1]);
            LAS unsigned short* q = (LAS unsigned short*)(M + (row0 + acc_row(i, lane)) * PITCH + (col0 + (lane & 31)) * 2);
            q[0] = (unsigned short)(p & 0xffffu); q[PITCH / 2] = (unsigned short)(p >> 16);
        }
    }
}
__device__ __forceinline__ void st_tr_q10(const f32x16& acc, LAS unsigned char* M, int row0, int col0, int lane, float sgn = 1.f) {
    if ((lane & 31) < 16) {
#pragma unroll
        for (int g = 2; g < 4; ++g) {
            v2u w; w.x = cvtpk(sgn * acc[4 * g], sgn * acc[4 * g + 1]); w.y = cvtpk(sgn * acc[4 * g + 2], sgn * acc[4 * g + 3]);
            *(LAS v2u*)(M + (col0 + (lane & 31)) * PITCH + (row0 + 8 * g + 4 * (lane >> 5)) * 2) = w;
        }
    }
}
__device__ __forceinline__ void st_img(const f32x16& acc, LAS unsigned char* img, int idx, int lane) {
#pragma unroll
    for (int s = 0; s < 2; ++s) {
        v4u w; w.x = cvtpk(acc[8 * s], acc[8 * s + 1]); w.y = cvtpk(acc[8 * s + 2], acc[8 * s + 3]); w.z = cvtpk(acc[8 * s + 4], acc[8 * s + 5]); w.w = cvtpk(acc[8 * s + 6], acc[8 * s + 7]);
        *(LAS v4u*)(img + ((idx * 2 + s) * 64 + lane) * 16) = w;
    }
}
__device__ __forceinline__ bf16x8 acc_frag(const f32x16& acc, int s) {
    v4u w; w.x = cvtpk(acc[8 * s], acc[8 * s + 1]); w.y = cvtpk(acc[8 * s + 2], acc[8 * s + 3]); w.z = cvtpk(acc[8 * s + 4], acc[8 * s + 5]); w.w = cvtpk(acc[8 * s + 6], acc[8 * s + 7]);
    return __builtin_bit_cast(bf16x8, w);
}
template <int P, int TIX> __device__ __forceinline__ void s1_tile(LAS unsigned char* lds, int lane) {
    constexpr int ti = (TIX == 0) ? 0 : 1, tj = (TIX == 2) ? 1 : 0;
    const LAS unsigned char* A = lds + ((P < 2) ? S_KK : S_RT) * SLOT; const LAS unsigned char* B = lds + ((P & 1) ? S_BT : S_KT) * SLOT;
    f32x16 acc = {};
    tile_mma<4>(acc, A, 32 * ti, B, 32 * tj, lane);
    if (TIX != 1) {
        const int x = (lane & 31) - 4 * (lane >> 5);
#pragma unroll
        for (int i = 0; i < 16; ++i) { const int ci = (i & 3) + 8 * (i >> 2); const bool keep = (P >= 2) ? (x <= ci) : (x < ci); acc[i] = keep ? acc[i] : 0.f; }
    }
    if (P == 1) {
        LAS float* Lf = (LAS float*)(lds + AREA_OFF) + (32 * ti + 4 * (lane >> 5)) * LP + 32 * tj + (lane & 31);
#pragma unroll
        for (int i = 0; i < 16; ++i) Lf[((i & 3) + 8 * (i >> 2)) * LP] = acc[i];
        if (TIX == 1) st_rm(acc, lds + S_LB * SLOT, 32, 0, lane);
        else st_rm_q10(acc, lds + S_LB * SLOT, 32 * ti, 32 * tj, lane);
    } else st_rm(acc, lds + ((P == 0) ? S_AKK : (P == 2) ? S_ARK : S_ARB) * SLOT, 32 * ti, 32 * tj, lane);
}
__device__ __forceinline__ void s3_tile(LAS unsigned char* lds, int q, int lane) {
    const int p = q >> 2, ti = (q >> 1) & 1, tj = q & 1;
    f32x16 acc = {};
    tile_mma<4>(acc, lds + (p ? S_X1T : S_KKT) * SLOT, 32 * ti, lds + S_T * SLOT, 32 * tj, lane);
    st_rm(acc, lds + (p ? S_NU0T : S_NW1T) * SLOT, 32 * ti, 32 * tj, lane, -1.f);
}
struct InRegs { v4u k, r, dec, a, v; };
__device__ __forceinline__ int scan_row(int b, int d, int p) {
    if (p < TC) { const int tc = d ? (TC - 1 - p) : p; return MLAT + b * TC + tc; }
    const int q = p - TC; const int tl = d ? (T - 1 - q) : q; return b * T + tl;
}
__device__ __forceinline__ void load_chunk(Frame& F, InRegs& R, int b, int h, int d, int chunk) {
    const int t = fresh_lane(), cg = F.wave;
    int ch = chunk; if (ch >= NCHUNK) ch = NCHUNK - 1;
    const int row = scan_row(b, d, ch * C + t);
    const u16* Prkv = (const u16*)(F.ws + WS_PRKV) + (size_t)row * 1536 + h * 64 + 8 * cg;
    R.r = *(const v4u*)(Prkv); R.k = *(const v4u*)(Prkv + 512); R.v = *(const v4u*)(Prkv + 1024);
    R.dec = *(const v4u*)((const u16*)(F.ws + WS_DEC) + (size_t)row * 1024 + d * 512 + h * 64 + 8 * cg);
    R.a = *(const v4u*)((const u16*)(F.ws + WS_AA) + (size_t)row * 1024 + d * 512 + h * 64 + 8 * cg);
}
}
__device__ __forceinline__ void scan_phase(Frame& F, const float* kkp, const float* kap) {
    using namespace ck;
    PHASE_BEGIN(F);
    LAS unsigned char* const lds = F.lds;
    const int wave = F.wave; int lane = F.lane, tid = F.tid;
    { unsigned z0; asm volatile("v_mov_b32 %0, 0" : "=v"(z0));
      for (int i = tid; i < 6 * SLOT / 16; i += NWAVES * 64) *(LAS v4u*)(lds + S_AKK * SLOT + i * 16) = (v4u){z0, z0, z0, z0}; }
    CK_BAR();
    for (int unit = F.vcu; unit < 64 * NQ; unit += F.G) {
        const int combo = unit >> 2, qq = unit & 3;
        const int b = combo >> 4, h = (combo >> 1) & 7, d = combo & 1;
        int t_ = lane; const int cg = wave;
        float kkw[8], kaw[8];
#pragma unroll
        for (int j = 0; j < 8; ++j) { kkw[j] = kkp[h * 64 + 8 * cg + j]; kaw[j] = kap[h * 64 + 8 * cg + j]; }
        InRegs R; load_chunk(F, R, b, h, d, qq * CPQ);
        InRegs R2 = R;
        f32x16 H0a = {}, H0b = {};
        if (wave == 2 || wave == 3) {
            const int l2 = fresh_lane();
#pragma unroll
            for (int i = 0; i < 16; ++i) { const float e = (acc_row(i, l2) == (l2 & 31)) ? 1.f : 0.f; if (wave == 2) H0a[i] = e; else H0b[i] = e; }
        }
        unsigned pend[16];
#define CK_YSTORE(cc_) do { const int ly = fresh_lane(); \
              \
            u16* Yg = (wave < 2) ? (u16*)(F.ws + WS_PC) + d * 512 + h * 64 + 32 * wave                         \
                                 : (u16*)(F.ws + WS_DEC) + d * 512 + h * 64 + 32 * (wave - 2);                  \
            const long st_ = d ? -1024 : 1024; \
            Yg += (long)scan_row(b, d, (cc_) * C) * 1024 + st_ * (ly & 31) + 4 * (ly >> 5); \
            _Pragma("unroll") for (int tt_ = 0; tt_ < 2; ++tt_) _Pragma("unroll") for (int g = 0; g < 4; ++g) \
                *(v2u*)(Yg + st_ * 32 * tt_ + 8 * g) = (v2u){pend[8 * tt_ + 2 * g], pend[8 * tt_ + 2 * g + 1]}; } while (0)
        for (int c = qq * CPQ; c < (qq + 1) * CPQ; ++c) {
            lane = fresh_lane(); tid = wave * 64 + lane; t_ = lane;
            if (DUPS & 64) asm volatile("" :: "v"(R2.k), "v"(R2.r), "v"(R2.dec), "v"(R2.a), "v"(R2.v));
            float w[8], a[8], k[8], r[8], v[8];
            unpk8_f16(R.dec, w); unpk8_f16(R.a, a); unpk8_f16(R.k, k); unpk8_f16(R.r, r); unpk8_f16(R.v, v);
            if (wave < 4 && c > qq * CPQ) CK_YSTORE(c - 1);
            typedef float f4 __attribute__((ext_vector_type(4)));
            LAS float* SS = (LAS float*)(lds + AREA_OFF);
            float g[8], gp[8], kk[8], ss = 0.f;
#pragma unroll
            for (int j = 0; j < 8; ++j) g[j] = w[j];
            asm volatile(
                "s_nop 1\n\t"
                "v_mul_f32_dpp %0, %0, %0 row_shr:1 row_mask:0xf bank_mask:0xf\n\t"
                "v_mul_f32_dpp %1, %1, %1 row_shr:1 row_mask:0xf bank_mask:0xf\n\t"
                "v_mul_f32_dpp %2, %2, %2 row_shr:1 row_mask:0xf bank_mask:0xf\n\t"
                "v_mul_f32_dpp %3, %3, %3 row_shr:1 row_mask:0xf bank_mask:0xf\n\t"
                "v_mul_f32_dpp %4, %4, %4 row_shr:1 row_mask:0xf bank_mask:0xf\n\t"
                "v_mul_f32_dpp %5, %5, %5 row_shr:1 row_mask:0xf bank_mask:0xf\n\t"
                "v_mul_f32_dpp %6, %6, %6 row_shr:1 row_mask:0xf bank_mask:0xf\n\t"
                "v_mul_f32_dpp %7, %7, %7 row_shr:1 row_mask:0xf bank_mask:0xf\n\t"
                "v_mul_f32_dpp %0, %0, %0 row_shr:2 row_mask:0xf bank_mask:0xf\n\t"
                "v_mul_f32_dpp %1, %1, %1 row_shr:2 row_mask:0xf bank_mask:0xf\n\t"
                "v_mul_f32_dpp %2, %2, %2 row_shr:2 row_mask:0xf bank_mask:0xf\n\t"
                "v_mul_f32_dpp %3, %3, %3 row_shr:2 row_mask:0xf bank_mask:0xf\n\t"
                "v_mul_f32_dpp %4, %4, %4 row_shr:2 row_mask:0xf bank_mask:0xf\n\t"
                "v_mul_f32_dpp %5, %5, %5 row_shr:2 row_mask:0xf bank_mask:0xf\n\t"
                "v_mul_f32_dpp %6, %6, %6 row_shr:2 row_mask:0xf bank_mask:0xf\n\t"
                "v_mul_f32_dpp %7, %7, %7 row_shr:2 row_mask:0xf bank_mask:0xf\n\t"
                "v_mul_f32_dpp %0, %0, %0 row_shr:4 row_mask:0xf bank_mask:0xf\n\t"
                "v_mul_f32_dpp %1, %1, %1 row_shr:4 row_mask:0xf bank_mask:0xf\n\t"
                "v_mul_f32_dpp %2, %2, %2 row_shr:4 row_mask:0xf bank_mask:0xf\n\t"
                "v_mul_f32_dpp %3, %3, %3 row_shr:4 row_mask:0xf bank_mask:0xf\n\t"
                "v_mul_f32_dpp %4, %4, %4 row_shr:4 row_mask:0xf bank_mask:0xf\n\t"
                "v_mul_f32_dpp %5, %5, %5 row_shr:4 row_mask:0xf bank_mask:0xf\n\t"
                "v_mul_f32_dpp %6, %6, %6 row_shr:4 row_mask:0xf bank_mask:0xf\n\t"
                "v_mul_f32_dpp %7, %7, %7 row_shr:4 row_mask:0xf bank_mask:0xf\n\t"
                "v_mul_f32_dpp %0, %0, %0 row_shr:8 row_mask:0xf bank_mask:0xf\n\t"
                "v_mul_f32_dpp %1, %1, %1 row_shr:8 row_mask:0xf bank_mask:0xf\n\t"
                "v_mul_f32_dpp %2, %2, %2 row_shr:8 row_mask:0xf bank_mask:0xf\n\t"
                "v_mul_f32_dpp %3, %3, %3 row_shr:8 row_mask:0xf bank_mask:0xf\n\t"
                "v_mul_f32_dpp %4, %4, %4 row_shr:8 row_mask:0xf bank_mask:0xf\n\t"
                "v_mul_f32_dpp %5, %5, %5 row_shr:8 row_mask:0xf bank_mask:0xf\n\t"
                "v_mul_f32_dpp %6, %6, %6 row_shr:8 row_mask:0xf bank_mask:0xf\n\t"
                "v_mul_f32_dpp %7, %7, %7 row_shr:8 row_mask:0xf bank_mask:0xf\n\t"
                "v_mul_f32_dpp %0, %0, %0 row_bcast:15 row_mask:0xa bank_mask:0xf\n\t"
                "v_mul_f32_dpp %1, %1, %1 row_bcast:15 row_mask:0xa bank_mask:0xf\n\t"
                "v_mul_f32_dpp %2, %2, %2 row_bcast:15 row_mask:0xa bank_mask:0xf\n\t"
                "v_mul_f32_dpp %3, %3, %3 row_bcast:15 row_mask:0xa bank_mask:0xf\n\t"
                "v_mul_f32_dpp %4, %4, %4 row_bcast:15 row_mask:0xa bank_mask:0xf\n\t"
                "v_mul_f32_dpp %5, %5, %5 row_bcast:15 row_mask:0xa bank_mask:0xf\n\t"
                "v_mul_f32_dpp %6, %6, %6 row_bcast:15 row_mask:0xa bank_mask:0xf\n\t"
                "v_mul_f32_dpp %7, %7, %7 row_bcast:15 row_mask:0xa bank_mask:0xf\n\t"
                "v_mul_f32_dpp %0, %0, %0 row_bcast:31 row_mask:0xc bank_mask:0xf\n\t"
                "v_mul_f32_dpp %1, %1, %1 row_bcast:31 row_mask:0xc bank_mask:0xf\n\t"
                "v_mul_f32_dpp %2, %2, %2 row_bcast:31 row_mask:0xc bank_mask:0xf\n\t"
                "v_mul_f32_dpp %3, %3, %3 row_bcast:31 row_mask:0xc bank_mask:0xf\n\t"
                "v_mul_f32_dpp %4, %4, %4 row_bcast:31 row_mask:0xc bank_mask:0xf\n\t"
                "v_mul_f32_dpp %5, %5, %5 row_bcast:31 row_mask:0xc bank_mask:0xf\n\t"
                "v_mul_f32_dpp %6, %6, %6 row_bcast:31 row_mask:0xc bank_mask:0xf\n\t"
                "v_mul_f32_dpp %7, %7, %7 row_bcast:31 row_mask:0xc bank_mask:0xf\n\t"
                : "+v"(g[0]), "+v"(g[1]), "+v"(g[2]), "+v"(g[3]), "+v"(g[4]), "+v"(g[5]), "+v"(g[6]), "+v"(g[7]));
#pragma unroll
            for (int j = 0; j < 8; ++j) {
                gp[j] = dpp1<0x138, 0xF>(g[j]);
                kk[j] = k[j] * kkw[j]; ss += kk[j] * kk[j];
            }
            SS[cg * 64 + t_] = ss;
            if (t_ == 63) { *(LAS f4*)((LAS float*)(lds + GC_OFF) + 8 * cg) = (f4){g[0], g[1], g[2], g[3]}; *(LAS f4*)((LAS float*)(lds + GC_OFF) + 8 * cg + 4) = (f4){g[4], g[5], g[6], g[7]}; }
            CK_BAR();
#pragma unroll 1
            for (int rp_ = 0; rp_ < ((DUPS & 2) ? 2 : 1); ++rp_) {
                float tot = 0.f;
#pragma unroll
                for (int q = 0; q < 8; ++q) tot += SS[q * 64 + t_];
                const float rn = rsqrtf(fmaxf(tot, 1e-24f));
                float Kk[8], Kt[8], Bt[8], Rt[8];
#pragma unroll
                for (int j = 0; j < 8; ++j) { const float kn = kk[j] * rn, rg = __builtin_amdgcn_rcpf(g[j]);
                    Kk[j] = kn * gp[j]; Kt[j] = (k[j] * (1.0f + (a[j] - 1.0f) * kaw[j])) * rg; Bt[j] = (kn * a[j]) * rg; Rt[j] = r[j] * g[j]; }
                const int ro = t_ * PITCH + 16 * cg;
                *(LAS v4u*)(lds + S_KK * SLOT + ro) = (v4u){cvtpk(Kk[0], Kk[1]), cvtpk(Kk[2], Kk[3]), cvtpk(Kk[4], Kk[5]), cvtpk(Kk[6], Kk[7])};
                *(LAS v4u*)(lds + S_KT * SLOT + ro) = (v4u){cvtpk(Kt[0], Kt[1]), cvtpk(Kt[2], Kt[3]), cvtpk(Kt[4], Kt[5]), cvtpk(Kt[6], Kt[7])};
                *(LAS v4u*)(lds + S_BT * SLOT + ro) = (v4u){cvtpk(Bt[0], Bt[1]), cvtpk(Bt[2], Bt[3]), cvtpk(Bt[4], Bt[5]), cvtpk(Bt[6], Bt[7])};
                *(LAS v4u*)(lds + S_RT * SLOT + ro) = (v4u){cvtpk(Rt[0], Rt[1]), cvtpk(Rt[2], Rt[3]), cvtpk(Rt[4], Rt[5]), cvtpk(Rt[6], Rt[7])};
#pragma unroll
                for (int j = 0; j < 8; j += 2) {
                    const unsigned pk = cvtpk(Kk[j], Kk[j + 1]), pt = cvtpk(Kt[j], Kt[j + 1]), pb = cvtpk(Bt[j], Bt[j + 1]), pv = cvtpk(v[j], v[j + 1]);
                    const int to = (8 * cg + j) * PITCH + 2 * t_;
                    *(LAS unsigned short*)(lds + S_KKT * SLOT + to) = (unsigned short)(pk & 0xffffu); *(LAS unsigned short*)(lds + S_KKT * SLOT + to + PITCH) = (unsigned short)(pk >> 16);
                    *(LAS unsigned short*)(lds + S_KTT * SLOT + to) = (unsigned short)(pt & 0xffffu); *(LAS unsigned short*)(lds + S_KTT * SLOT + to + PITCH) = (unsigned short)(pt >> 16);
                    *(LAS unsigned short*)(lds + S_BTT * SLOT + to) = (unsigned short)(pb & 0xffffu); *(LAS unsigned short*)(lds + S_BTT * SLOT + to + PITCH) = (unsigned short)(pb >> 16);
                    *(LAS unsigned short*)(lds + S_VT * SLOT + to) = (unsigned short)(pv & 0xffffu);  *(LAS unsigned short*)(lds + S_VT * SLOT + to + PITCH) = (unsigned short)(pv >> 16);
                }
            }
            CK_BAR();
            lane = fresh_lane();
            f32x16 accN0 = {}, accN1 = {}, accY0 = {}, accY1 = {};
            if (wave < 2) {
                const int vt = wave;
                tile_mma<4>(accN0, lds + S_KTT * SLOT, 0, lds + S_VT * SLOT, 32 * vt, lane);
                tile_mma<4>(accN1, lds + S_KTT * SLOT, 32, lds + S_VT * SLOT, 32 * vt, lane);
                CK_BAR();
                load_chunk(F, R, b, h, d, c + 1);
                if (DUPS & 64) load_chunk(F, R2, b, h, d, c + 1);
                tile_mma<4>(accY0, lds + S_VT * SLOT, 32 * vt, lds + S_ARK * SLOT, 0, lane);
                tile_mma<4>(accY1, lds + S_VT * SLOT, 32 * vt, lds + S_ARK * SLOT, 32, lane);
                CK_BAR();
                s3_tile(lds, wave, lane);
                CK_BAR();
                tile_mma<4>(accN0, lds + S_BTT * SLOT, 0, lds + S_NU0T * SLOT, 32 * vt, lane);
                tile_mma<4>(accN1, lds + S_BTT * SLOT, 32, lds + S_NU0T * SLOT, 32 * vt, lane);
                tile_mma<4>(accY0, lds + S_NU0T * SLOT, 32 * vt, lds + S_ARB * SLOT, 0, lane);
                tile_mma<4>(accY1, lds + S_NU0T * SLOT, 32 * vt, lds + S_ARB * SLOT, 32, lane);
                { const LAS float* gcp = (const LAS float*)(lds + GC_OFF);
#pragma unroll
                  for (int i = 0; i < 16; ++i) { accN0[i] *= gcp[acc_row(i, lane)]; accN1[i] *= gcp[32 + acc_row(i, lane)]; } }
                CK_BAR();
            } else {
                const int wi = wave - 2;
                switch (wi) {
                    case 0: s1_tile<0, 0>(lds, lane); s1_tile<2, 0>(lds, lane); break;
                    case 1: s1_tile<0, 1>(lds, lane); s1_tile<2, 1>(lds, lane); break;
                    case 2: s1_tile<0, 2>(lds, lane); s1_tile<2, 2>(lds, lane); break;
                    case 3: s1_tile<1, 0>(lds, lane); s1_tile<3, 0>(lds, lane); break;
                    case 4: s1_tile<1, 1>(lds, lane); s1_tile<3, 1>(lds, lane); break;
                    default: s1_tile<1, 2>(lds, lane); s1_tile<3, 2>(lds, lane); break;
                }
                CK_BAR();
                if (wave != 7) { load_chunk(F, R, b, h, d, c + 1); if (DUPS & 64) load_chunk(F, R2, b, h, d, c + 1); }
#pragma unroll 1
                for (int rp_ = 0; rp_ < ((DUPS & 8) ? 2 : 1); ++rp_)
                if (wave == 7) {
                    const int l7 = fresh_lane();
                    const int bq = l7 >> 4, j = l7 & 15;
                    const LAS float* Lf = (const LAS float*)(lds + AREA_OFF) + (16 * bq) * LP + 16 * bq;
                    float Tb[16];
#pragma unroll
                    for (int t4 = 0; t4 < 16; t4 += 4) {
                        f4 lr[4][4];
#pragma unroll
                        for (int u = 0; u < 4; ++u)
#pragma unroll
                            for (int m4 = 0; m4 < (t4 + u + 3) / 4; ++m4) lr[u][m4] = *(const LAS f4*)(Lf + (t4 + u) * LP + 4 * m4);
#pragma unroll
                        for (int u = 0; u < 4; ++u) {
                            const int t = t4 + u;
                            float acc = (j == t) ? 1.f : 0.f;
#pragma unroll
                            for (int m4 = 0; m4 < (t + 3) / 4; ++m4)
#pragma unroll
                                for (int e = 0; e < 4; ++e) if (4 * m4 + e < t) acc -= lr[u][m4][e] * Tb[4 * m4 + e];
                            asm volatile("" : "+v"(acc));
                            Tb[t] = acc;
                        }
                        asm volatile("" ::: "memory");
                    }
#pragma unroll
                    for (int t = 0; t < 16; t += 2) { const unsigned p = cvtpk(Tb[t], Tb[t + 1]);
                        LAS unsigned short* q = (LAS unsigned short*)(lds + S_T * SLOT + (16 * bq + t) * PITCH + (16 * bq + j) * 2); q[0] = (unsigned short)(p & 0xffffu); q[PITCH / 2] = (unsigned short)(p >> 16); }
#pragma unroll
                    for (int t8 = 0; t8 < 2; ++t8) *(LAS v4u*)(lds + S_TT * SLOT + (16 * bq + j) * PITCH + (16 * bq + 8 * t8) * 2) =
                        (v4u){cvtpk(Tb[8 * t8], Tb[8 * t8 + 1]), cvtpk(Tb[8 * t8 + 2], Tb[8 * t8 + 3]), cvtpk(Tb[8 * t8 + 4], Tb[8 * t8 + 5]), cvtpk(Tb[8 * t8 + 6], Tb[8 * t8 + 7])};
                    asm volatile("s_waitcnt lgkmcnt(0)" ::: "memory");
#pragma unroll
                    for (int B = 0; B < 2; ++B) {
                        f32x16 z1 = {};
                        tile_mma<1>(z1, lds + S_LB * SLOT, 32 * B, lds + S_TT * SLOT, 32 * B, lane, 32 * B);
                        st_tr_q10(z1, lds + S_TT * SLOT, 32 * B, 32 * B, lane);
                        asm volatile("s_waitcnt lgkmcnt(0)" ::: "memory");
                        f32x16 x = {};
                        tile_mma<1>(x, lds + S_T * SLOT, 32 * B, lds + S_TT * SLOT, 32 * B, lane, 32 * B + 16);
                        st_rm_q10(x, lds + S_T * SLOT, 32 * B, 32 * B, lane, -1.f);
                        if (B == 0) st_tr_q10(x, lds + S_TT * SLOT, 0, 0, lane, -1.f);
                    }
                    asm volatile("s_waitcnt lgkmcnt(0)" ::: "memory");
                    f32x16 z = {};
                    tile_mma<2>(z, lds + S_LB * SLOT, 32, lds + S_TT * SLOT, 0, lane, 0);
                    st_tr(z, lds + S_TT * SLOT, 32, 0, lane);
                    asm volatile("s_waitcnt lgkmcnt(0)" ::: "memory");
                    f32x16 tba = {};
                    tile_mma<2>(tba, lds + S_T * SLOT, 32, lds + S_TT * SLOT, 0, lane, 32);
                    st_rm(tba, lds + S_T * SLOT, 32, 0, lane, -1.f);
                } else if (wave < 6) {
                    const int vi = (wave - 2) >> 1, tj = (wave - 2) & 1;
                    f32x16 acc = {};
                    tile_mma<4>(acc, lds + S_VT * SLOT, 32 * vi, lds + S_AKK * SLOT, 32 * tj, lane);
                    st_rm(acc, lds + S_X1T * SLOT, 32 * vi, 32 * tj, lane);
                }
                CK_BAR();
                if (wave == 7) { load_chunk(F, R, b, h, d, c + 1); if (DUPS & 64) load_chunk(F, R2, b, h, d, c + 1); }
                s3_tile(lds, wave, lane);
                CK_BAR();
#pragma unroll 1
                for (int rp_ = 0; rp_ < ((DUPS & 32) ? 2 : 1); ++rp_)
                for (int q = wi; q < 8; q += 6) {
                    const int isphi = q >> 2, to = (q >> 1) & 1, tn = q & 1;
                    f32x16 acc = {};
                    if (isphi) {
#pragma unroll
                        for (int g = 0; g < 4; ++g) { const v2u u = *(const LAS v2u*)(lds + S_RT * SLOT + (32 * tn + (lane & 31)) * PITCH + (32 * to + 8 * g + 4 * (lane >> 5)) * 2);
                            acc[4 * g] = __uint_as_float(u.x << 16); acc[4 * g + 1] = __uint_as_float(u.x & 0xffff0000u); acc[4 * g + 2] = __uint_as_float(u.y << 16); acc[4 * g + 3] = __uint_as_float(u.y & 0xffff0000u); }
                        tile_mma<4>(acc, lds + S_NW1T * SLOT, 32 * to, lds + S_ARB * SLOT, 32 * tn, lane);
                        st_img(acc, lds + S_PIMG * SLOT, tn * 2 + to, lane);
                    } else {
                        tile_mma<4>(acc, lds + S_NW1T * SLOT, 32 * to, lds + S_BTT * SLOT, 32 * tn, lane);
                        const float gc = ((const LAS float*)(lds + GC_OFF))[32 * tn + (lane & 31)];
#pragma unroll
                        for (int i = 0; i < 16; ++i) { float x = acc[i]; if (to == tn && acc_row(i, lane) == (lane & 31)) x += 1.f; acc[i] = x * gc; }
                        st_img(acc, lds + S_GIMG * SLOT, tn * 2 + to, lane);
                    }
                }
                CK_BAR();
            }
            if (wave < 4) {
                lane = fresh_lane();
                bf16x8 hf[4]; hf[0] = acc_frag(H0a, 0); hf[1] = acc_frag(H0a, 1); hf[2] = acc_frag(H0b, 0); hf[3] = acc_frag(H0b, 1);
#pragma unroll
                for (int ks = 0; ks < 4; ++ks) {
                    const int to = ks >> 1, s2 = ks & 1;
                    const bf16x8 g0 = *(const LAS bf16x8*)(lds + S_GIMG * SLOT + (((0 * 2 + to) * 2 + s2) * 64 + lane) * 16), g1 = *(const LAS bf16x8*)(lds + S_GIMG * SLOT + (((1 * 2 + to) * 2 + s2) * 64 + lane) * 16);
                    const bf16x8 p0 = *(const LAS bf16x8*)(lds + S_PIMG * SLOT + (((0 * 2 + to) * 2 + s2) * 64 + lane) * 16), p1 = *(const LAS bf16x8*)(lds + S_PIMG * SLOT + (((1 * 2 + to) * 2 + s2) * 64 + lane) * 16);
                    accN0 = __builtin_amdgcn_mfma_f32_32x32x16_bf16(g0, hf[ks], accN0, 0, 0, 0); accN1 = __builtin_amdgcn_mfma_f32_32x32x16_bf16(g1, hf[ks], accN1, 0, 0, 0);
                    accY0 = __builtin_amdgcn_mfma_f32_32x32x16_bf16(hf[ks], p0, accY0, 0, 0, 0); accY1 = __builtin_amdgcn_mfma_f32_32x32x16_bf16(hf[ks], p1, accY1, 0, 0, 0);
                }
                H0a = accN0; H0b = accN1;
                if (wave >= 2) {
#pragma unroll
                    for (int q = 0; q < 8; ++q) { pend[q] = cvtpk(accY0[2 * q], accY0[2 * q + 1]); pend[8 + q] = cvtpk(accY1[2 * q], accY1[2 * q + 1]); }
                } else {
#pragma unroll
                    for (int q = 0; q < 8; ++q) { pend[q] = pk_f16(accY0[2 * q], accY0[2 * q + 1]); pend[8 + q] = pk_f16(accY1[2 * q], accY1[2 * q + 1]); }
                }
            }
        }
        if (wave < 4) CK_YSTORE((qq + 1) * CPQ - 1);
#undef CK_YSTORE
        if (wave < 2) {
            const int l3 = fresh_lane();
            float* hz = (float*)(F.ws + WS_HZ) + (size_t)(unit * 2 + wave) * 2048 + l3;
#pragma unroll
            for (int i = 0; i < 16; ++i) { hz[i * 64] = H0a[i]; hz[1024 + i * 64] = H0b[i]; }
        } else if (wave < 4) {
            const int l3 = fresh_lane();
            u16* gq = (u16*)(F.ws + WS_GC) + (size_t)unit * 4096 + 32 * (wave - 2) + (l3 & 31);
#pragma unroll
            for (int i = 0; i < 16; i += 2) {
                const unsigned pa = cvtpk(H0a[i], H0a[i + 1]), pb = cvtpk(H0b[i], H0b[i + 1]);
                const int r0 = acc_row(i, l3);
                gq[r0 * 64] = (u16)(pa & 0xffffu); gq[(r0 + 1) * 64] = (u16)(pa >> 16); gq[(32 + r0) * 64] = (u16)(pb & 0xffffu); gq[(33 + r0) * 64] = (u16)(pb >> 16);
            }
        }
        CK_BAR();
    }
}
__device__ __forceinline__ void scan_fix(Frame& F) {
    using namespace ck;
    PHASE_BEGIN(F);
    LAS unsigned char* const lds = F.lds;
    const int wave = F.wave;
    enum { X_G1 = 0, X_G2 = 1, X_S1T = 2, X_S2T = 3, X_S3T = 4 };
    for (int unit = F.vcu; unit < 64 * NQ; unit += F.G) {
        const int combo = unit >> 2, j = unit & 3;
        const int b = combo >> 4, h = (combo >> 1) & 7, d = combo & 1;
        int lane = fresh_lane(); const int tid = wave * 64 + lane;
#pragma unroll
        for (int i = 0; i < 2; ++i) {
            const int p = tid + 512 * i, mat = p >> 9, row = (p >> 3) & 63, cg = p & 7;
            const v4u x = *(const v4u*)((const u16*)(F.ws + WS_GC) + (size_t)(combo * 4 + 1 + mat) * 4096 + row * 64 + 8 * cg);
            *(LAS v4u*)(lds + (X_G1 + mat) * SLOT + row * PITCH + 16 * cg) = x;
        }
        const int kt = (wave >> 1) & 1, vt = wave & 1;
        if (wave < 4) {
            const float* hz = (const float*)(F.ws + WS_HZ) + (size_t)((combo * 4 + 0) * 2 + vt) * 2048 + kt * 1024 + lane;
            f32x16 acc;
#pragma unroll
            for (int i = 0; i < 16; ++i) acc[i] = hz[i * 64];
            st_tr(acc, lds + X_S1T * SLOT, 32 * kt, 32 * vt, lane);
        }
        CK_BAR();
#pragma unroll 1
        for (int q = 1; q < 3; ++q) {
            if (wave < 4) {
                lane = fresh_lane();
                const float* hz = (const float*)(F.ws + WS_HZ) + (size_t)((combo * 4 + q) * 2 + vt) * 2048 + kt * 1024 + lane;
                f32x16 acc;
#pragma unroll
                for (int i = 0; i < 16; ++i) acc[i] = hz[i * 64];
                tile_mma<4>(acc, lds + (X_G1 + q - 1) * SLOT, 32 * kt, lds + (X_S1T + q - 1) * SLOT, 32 * vt, lane);
                st_tr(acc, lds + (X_S1T + q) * SLOT, 32 * kt, 32 * vt, lane);
            }
            CK_BAR();
        }
        lane = fresh_lane();
        const int hw = wave >> 2, tt = (wave >> 1) & 1, vt2 = wave & 1, r = lane & 31, h5 = lane >> 5;
#define FX_LOAD(cc_, BO_, YO_) do { const int row_ = scan_row(b, d, (cc_) * C + 32 * tt + r); \
            const u16* om_ = (const u16*)(F.ws + WS_DEC) + (size_t)row_ * 1024 + d * 512 + h * 64 + 8 * h5; \
            _Pragma("unroll") for (int s = 0; s < 4; ++s) BO_[s] = __builtin_bit_cast(bf16x8, *(const v4u*)(om_ + 16 * s)); \
            const u16* yq_ = (const u16*)(F.ws + WS_PC) + (size_t)row_ * 1024 + d * 512 + h * 64 + 32 * vt2 + 4 * h5; \
            _Pragma("unroll") for (int g = 0; g < 4; ++g) YO_[g] = *(const v2u*)(yq_ + 8 * g); } while (0)
        bf16x8 bo[4], bn[4]; v2u yo[4], yn[4];
        int c = CPQ + j + 4 * hw;
        if (c < NCHUNK) FX_LOAD(c, bo, yo);
#pragma unroll 1
        for (; c < NCHUNK; c += 8) {
            const int q = c / CPQ;
            if (c + 8 < NCHUNK) FX_LOAD(c + 8, bn, yn);
            const int row = scan_row(b, d, c * C + 32 * tt + r);
            u16* yp = (u16*)(F.ws + WS_PC) + (size_t)row * 1024 + d * 512 + h * 64 + 32 * vt2 + 4 * h5;
            f32x16 acc = {};
            const LAS unsigned char* pa = lds + (X_S1T + q - 1) * SLOT + (32 * vt2 + r) * PITCH + 16 * h5;
#pragma unroll
            for (int s = 0; s < 4; ++s) { const bf16x8 a = *(const LAS bf16x8*)(pa + 32 * s); acc = __builtin_amdgcn_mfma_f32_32x32x16_bf16(a, bo[s], acc, 0, 0, 0); }
#pragma unroll
            for (int g = 0; g < 4; ++g) {
                float y0, y1, y2, y3; unpk_f16(yo[g].x, y0, y1); unpk_f16(yo[g].y, y2, y3);
                v2u w; w.x = pk_f16(y0 + acc[4 * g], y1 + acc[4 * g + 1]); w.y = pk_f16(y2 + acc[4 * g + 2], y3 + acc[4 * g + 3]);
                *(v2u*)(yp + 8 * g) = w;
            }
#pragma unroll
            for (int s = 0; s < 4; ++s) { bo[s] = bn[s]; yo[s] = yn[s]; }
        }
#undef FX_LOAD
        CK_BAR();
    }
}
constexpr int CV_R = 16;
__device__ __forceinline__ void ffn_conv(Frame& F, const float* cw, const float* cb, const bool with_ctx, const bool dry = false, const bool only_ctx = false) {
    PHASE_BEGIN(F);
    const int gw = F.vcu * NWAVES + F.wave, NGW = F.G * NWAVES;
    const u16* G = (const u16*)(F.ws + WS_GATEB); u16* V = (u16*)(F.ws + WS_VALB);
    constexpr int NLATI = NB * (128 / CV_R) * 6 * 64;
    const int nitem = NLATI + (with_ctx ? NB * 6 * TC : 0);
    for (int it = gw + (only_ctx ? NLATI : 0); it < nitem; it += NGW) {
        int gc, slice, r_lo, r_hi, nrow, ncol, rowbase;
        if (it < NLATI) { gc = it & 63; int t = it >> 6; slice = t % 6; t /= 6; const int seg = t % (128 / CV_R); const int b = t / (128 / CV_R); r_lo = seg * CV_R; r_hi = r_lo + CV_R; nrow = 128; ncol = 64; rowbase = b * T; }
        else { int t = it - NLATI; gc = t & (TC - 1); t >>= 8; slice = t % 6; const int b = t / 6; r_lo = 0; r_hi = 1; nrow = 1; ncol = TC; rowbase = MLAT + b * TC; }
        const int ch = slice * 64 + F.lane;
        if (ch >= FF / 8) continue;
        const int c0 = 8 * ch;
        typedef __fp16 hh2 __attribute__((ext_vector_type(2)));
        hh2 wt[9][4], bias[4];
#pragma unroll
        for (int q = 0; q < 9; ++q) { const pg8::f32x4 a = *(const pg8::f32x4*)(cw + (size_t)q * FF + c0), b4 = *(const pg8::f32x4*)(cw + (size_t)q * FF + c0 + 4);
            wt[q][0] = __builtin_amdgcn_cvt_pkrtz(a[0], a[1]); wt[q][1] = __builtin_amdgcn_cvt_pkrtz(a[2], a[3]); wt[q][2] = __builtin_amdgcn_cvt_pkrtz(b4[0], b4[1]); wt[q][3] = __builtin_amdgcn_cvt_pkrtz(b4[2], b4[3]); }
        { const pg8::f32x4 a = *(const pg8::f32x4*)(cb + c0), b4 = *(const pg8::f32x4*)(cb + c0 + 4);
          bias[0] = __builtin_amdgcn_cvt_pkrtz(a[0], a[1]); bias[1] = __builtin_amdgcn_cvt_pkrtz(a[2], a[3]); bias[2] = __builtin_amdgcn_cvt_pkrtz(b4[0], b4[1]); bias[3] = __builtin_amdgcn_cvt_pkrtz(b4[2], b4[3]); }
        const bool hasL = gc > 0, hasR = gc + 1 < ncol;
        hh2 P[4], Q[4];
#pragma unroll
        for (int e = 0; e < 4; ++e) { P[e] = (hh2){(__fp16)0.f, (__fp16)0.f}; Q[e] = bias[e]; }
#define CV_LOAD(rr_, L_, M_, R_, V_) do { const int rr = (rr_); L_ = (v4u){0u, 0u, 0u, 0u}; M_ = L_; R_ = L_; \
            if (rr >= 0 && rr <= r_hi && rr < nrow) { const u16* p_ = G + (size_t)(rowbase + rr * ncol + gc) * FF + c0; M_ = *(const v4u*)p_; if (hasL) L_ = *(const v4u*)(p_ - FF); if (hasR) R_ = *(const v4u*)(p_ + FF); } \
            if (rr - 1 >= r_lo && rr - 1 < r_hi) V_ = *(const v4u*)(V + (size_t)(rowbase + (rr - 1) * ncol + gc) * FF + c0); } while (0)
        v4u l0, m0, r0, v0 = {0u, 0u, 0u, 0u}, l1, m1, r1, v1 = v0, l2, m2, r2, v2 = v0;
        CV_LOAD(r_lo - 1, l0, m0, r0, v0); CV_LOAD(r_lo, l1, m1, r1, v1);
        for (int rho = r_lo - 1; rho <= r_hi; ++rho) {
            CV_LOAD(rho + 2, l2, m2, r2, v2);
            const unsigned la[4] = {l0.x, l0.y, l0.z, l0.w}, ma[4] = {m0.x, m0.y, m0.z, m0.w}, ra[4] = {r0.x, r0.y, r0.z, r0.w};
            hh2 N[4];
#pragma unroll
            for (int e = 0; e < 4; ++e) {
                const hh2 a = __builtin_bit_cast(hh2, la[e]), m = __builtin_bit_cast(hh2, ma[e]), c = __builtin_bit_cast(hh2, ra[e]);
                P[e] = P[e] + wt[6][e] * a + wt[7][e] * m + wt[8][e] * c;
                Q[e] = Q[e] + wt[3][e] * a + wt[4][e] * m + wt[5][e] * c;
                N[e] = bias[e] + wt[0][e] * a + wt[1][e] * m + wt[2][e] * c;
            }
            if (rho - 1 >= r_lo) {
                float v[8], o[8], p[8]; unpk8_f16(v0, v);
#pragma unroll
                for (int e = 0; e < 4; ++e) { p[2 * e] = (float)P[e].x; p[2 * e + 1] = (float)P[e].y; }
#pragma unroll
                for (int e = 0; e < 8; ++e) o[e] = siluf_(p[e]) * v[e];
                v4u w; w.x = pk2(o[0], o[1]); w.y = pk2(o[2], o[3]); w.z = pk2(o[4], o[5]); w.w = pk2(o[6], o[7]);
                if (!dry) ST_NT3((v4u*)(V + (size_t)(rowbase + (rho - 1) * ncol + gc) * FF + c0), w); else asm volatile("" :: "v"(w));
            }
#pragma unroll
            for (int e = 0; e < 4; ++e) { P[e] = Q[e]; Q[e] = N[e]; }
            l0 = l1; m0 = m1; r0 = r1; v0 = v1; l1 = l2; m1 = m2; r1 = r2; v1 = v2;
        }
#undef CV_LOAD
    }
}
__device__ __forceinline__ void final_norm(Frame& F, const float* fg) {
    PHASE_BEGIN(F);
    const int gw = F.vcu * NWAVES + F.wave, NGW = F.G * NWAVES;
    pg8::f32x4 gv[4];
#pragma unroll
    for (int j = 0; j < 4; ++j) gv[j] = *(const pg8::f32x4*)(fg + 4 * F.lane + 256 * j);
    for (int r = gw; r < MLAT; r += NGW) {
        float* xr = F.out + (size_t)r * D;
        const u16* xs = (const u16*)(F.ws + WS_XN) + (size_t)r * D;
        pg8::f32x4 v[4]; float ss = 0.f;
#pragma unroll
        for (int j = 0; j < 4; ++j) { const v2u xu = *(const v2u*)(xs + 4 * F.lane + 256 * j);
            v[j] = (pg8::f32x4){__uint_as_float(xu.x << 16), __uint_as_float(xu.x & 0xffff0000u), __uint_as_float(xu.y << 16), __uint_as_float(xu.y & 0xffff0000u)};
            ss += (v[j][0] * v[j][0] + v[j][1] * v[j][1]) + (v[j][2] * v[j][2] + v[j][3] * v[j][3]); }
        const float rstd = rsqrtf(wave_sum(ss) * (1.0f / D) + RMS_EPS);
#pragma unroll
        for (int j = 0; j < 4; ++j) { const pg8::f32x4 o = (v[j] * rstd) * gv[j];
#ifdef NT_FINAL
            __builtin_nontemporal_store(o, (pg8::f32x4*)(xr + 4 * F.lane + 256 * j));
#else
            *(pg8::f32x4*)(xr + 4 * F.lane + 256 * j) = o;
#endif
        }
    }
}

struct Args;

#ifndef CVP
#define CVP 0
#endif
struct OneUnit {
    pg8::Unit u;
    __device__ bool next(int i, pg8::Unit& o) const { if (i > 0) return false; o = u; return true; }
    __device__ __forceinline__ void a_ready(const pg8::Unit&) const {}
    __device__ __forceinline__ void done(const pg8::Unit&) const {}
};
struct EpiConv {
    static constexpr bool PERM = true, AFTER_DRAIN = true;
    EpiArgs a;
    __device__ __forceinline__ void operator()(const pg8::f32x4 (&)[2][2][4][2], const pg8::Unit&, int, int, int, int) const {}
    __device__ __forceinline__ void fused(const pg8::f32x4 (&acc)[2][2][4][2], const pg8::Unit& u, int wr, int wc, int, int, LAS unsigned char* lds, int wid, int) const {
        using pg8::f32x4;
        typedef __fp16 hh2 __attribute__((ext_vector_type(2)));
        const int l_ = fresh_lane(), fr = l_ & 15, fq = l_ >> 4;
        unsigned char* const ws_ = a.ws;
        const int row0 = u.pm * 256 + wr * 64 + fr;
        const bool ctx = u.pm >= MLAT / 256;
        const int bt = u.pm >> 5, gy0 = (u.pm & 31) * 4;
        const u16* const G = (const u16*)(ws_ + WS_GATEB);
        const float* const cw = inp(*a.ap, IN_FCW) + (size_t)a.l * 9 * FF;
        const float* const cb = inp(*a.ap, IN_FCB) + (size_t)a.l * FF;
        const int q16 = wc * 4 + fq;
#pragma unroll
        for (int bj = 0; bj < 2; ++bj) {
            const int cbase = u.pn * 256 + bj * 128;
#pragma unroll 1
            for (int rs_ = 0; rs_ < ((CVP & 1) ? 2 : 1); ++rs_)
#pragma unroll 1
            for (int i = wid; i < 96; i += NWAVES) {
                const int rowi = i * 4 + fq, sg = i >> 4, gy = gy0 - 1 + sg, gx = rowi & 63;
                const int chunk = fr ^ (rowi & 15);
                const bool have = ctx ? (sg >= 1 && sg <= 4) : (gy >= 0 && gy < 128);
                const int srow = ctx ? (MLAT + (u.pm - MLAT / 256) * TC + (sg - 1) * 64 + gx) : (bt * T + gy * 64 + gx);
                if (have)
                    __builtin_amdgcn_global_load_lds((const unsigned*)(G + (size_t)srow * FF + cbase + chunk * 8), (LAS unsigned*)(lds + 256 + i * 1024), 16, 0, 0);
            }
            const int c0 = cbase + q16 * 8;
            hh2 wt[9][4], bias[4];
#pragma unroll
            for (int q = 0; q < 9; ++q) { const f32x4 x = *(const f32x4*)(cw + (size_t)q * FF + c0), y = *(const f32x4*)(cw + (size_t)q * FF + c0 + 4);
                wt[q][0] = __builtin_amdgcn_cvt_pkrtz(x[0], x[1]); wt[q][1] = __builtin_amdgcn_cvt_pkrtz(x[2], x[3]); wt[q][2] = __builtin_amdgcn_cvt_pkrtz(y[0], y[1]); wt[q][3] = __builtin_amdgcn_cvt_pkrtz(y[2], y[3]); }
            { const f32x4 x = *(const f32x4*)(cb + c0), y = *(const f32x4*)(cb + c0 + 4);
              bias[0] = __builtin_amdgcn_cvt_pkrtz(x[0], x[1]); bias[1] = __builtin_amdgcn_cvt_pkrtz(x[2], x[3]); bias[2] = __builtin_amdgcn_cvt_pkrtz(y[0], y[1]); bias[3] = __builtin_amdgcn_cvt_pkrtz(y[2], y[3]); }
            const LAS unsigned char* bp[2][3];
#pragma unroll
            for (int dx = 0; dx < 3; ++dx) {
                const int sw = (q16 ^ ((fr + dx - 1) & 15)) << 4;
                bp[0][dx] = lds + 256 + (wr * 64 + fr + dx - 1) * 256 + sw; bp[1][dx] = bp[0][dx] + 2 * 64 * 256;
            }
            const unsigned mLa[2] = {(fr == 0 && (!ctx || wr == 0)) ? 0u : 0xffffffffu, (fr == 0 && !ctx) ? 0u : 0xffffffffu};
            const unsigned mRa[2] = {(fr == 15 && !ctx) ? 0u : 0xffffffffu, (fr == 15 && (!ctx || wr == 1)) ? 0u : 0xffffffffu};
            asm volatile("s_waitcnt vmcnt(0)" ::: "memory");
            __builtin_amdgcn_s_barrier();
            asm volatile("" ::: "memory");
#pragma unroll 1
            for (int rc_ = 0; rc_ < ((CVP & 2) ? 2 : 1); ++rc_)
#pragma unroll
            for (int ai = 0; ai < 2; ++ai)
#pragma unroll
                for (int m = 0; m < 4; ++m) {
                    hh2 P[4] = {bias[0], bias[1], bias[2], bias[3]};
#pragma unroll
                    for (int dy = 0; dy < 3; ++dy) {
                        const int gy = gy0 + wr + 2 * ai + dy - 1;
                        if (ctx ? (dy == 1) : (gy >= 0 && gy < 128)) {
#pragma unroll
                            for (int dx = 0; dx < 3; ++dx) {
                                v4u tp = *(const LAS v4u*)(bp[ai][dx] + (dy * 64 + 16 * m) * 256);
                                if (m == 0 && dx == 0) { const unsigned mk = mLa[ai]; tp.x &= mk; tp.y &= mk; tp.z &= mk; tp.w &= mk; }
                                if (m == 3 && dx == 2) { const unsigned mk = mRa[ai]; tp.x &= mk; tp.y &= mk; tp.z &= mk; tp.w &= mk; }
                                const unsigned ta[4] = {tp.x, tp.y, tp.z, tp.w};
#pragma unroll
                                for (int e = 0; e < 4; ++e) P[e] = P[e] + wt[3 * dy + dx][e] * __builtin_bit_cast(hh2, ta[e]);
                            }
                        }
                    }
                    const f32x4 v0 = acc[ai][bj][m][0], v1 = acc[ai][bj][m][1];
                    const float vv[8] = {v0[0], v0[1], v0[2], v0[3], v1[0], v1[1], v1[2], v1[3]};
                    float o[8];
#pragma unroll
                    for (int e = 0; e < 4; ++e) { o[2 * e] = siluf_((float)P[e].x) * vv[2 * e]; o[2 * e + 1] = siluf_((float)P[e].y) * vv[2 * e + 1]; }
                    v4u w; w.x = pk2(o[0], o[1]); w.y = pk2(o[2], o[3]); w.z = pk2(o[4], o[5]); w.w = pk2(o[6], o[7]);
#ifdef NT_A3
                    __builtin_nontemporal_store(w, (v4u*)((u16*)(ws_ + WS_VALB) + (size_t)(row0 + ai * 128 + m * 16) * FF + c0));
#else
                    *(v4u*)((u16*)(ws_ + WS_VALB) + (size_t)(row0 + ai * 128 + m * 16) * FF + c0) = w;
#endif
                    asm volatile("" ::: "memory");
                }
            asm volatile("s_waitcnt lgkmcnt(0)" ::: "memory");
            __builtin_amdgcn_s_barrier();
            asm volatile("" ::: "memory");
        }
    }
};
struct Args { const float* in[26]; float* out; unsigned char* ws; };
__device__ __forceinline__ const float* inp(const Args& a, int i) { asm volatile("" : "+s"(i)); return a.in[i]; }
struct RepeatOrder {
    int nM, nN, R, c;
    __device__ bool next(int i, pg8::Unit& u) const { if (i >= R) return false; u.pm = c % nM; u.pn = (c / 8) % nN; u.koff = 0; return true; }
    __device__ __forceinline__ void a_ready(const pg8::Unit&) const {}
    __device__ __forceinline__ void done(const pg8::Unit&) const {}
};
template <int MODE> __device__ __forceinline__ void run_gemm_rep(Frame& F, const u16* A, const u16* Bt, int Mr, int N, int K, int R, const EpiArgs& ea) {
    pg8::Gemm g{A, Bt, Mr, N, K, K}; RepeatOrder S{Mr / 256, N / 256, R, (int)blockIdx.x};
    Epi<MODE> E{ea};
    pg8::gemm_phase<Epi<MODE>, RepeatOrder, true, true>(F.lds + RING_OFF, g, S, E, F.wave);
}
template <int MODE> __device__ __forceinline__ void run_gemm_k(Frame& F, const u16* A, const u16* Bt, int Mr, int N, int K, int ld, const EpiArgs& ea) {
    pg8::Gemm g{A, Bt, Mr, N, K, ld}; pg8::StaticOrder S; S.init(Mr, N, F.G, (int)blockIdx.x);
    Epi<MODE> E{ea};
    pg8::gemm_phase<Epi<MODE>, pg8::StaticOrder, true, true>(F.lds + RING_OFF, g, S, E, F.wave);
}
template <int MODE, bool AL> __device__ __forceinline__ void run_gemm_al(Frame& F, const u16* A, const u16* Bt, int Mr, int N, int K, const EpiArgs& ea) {
    pg8::Gemm g{A, Bt, Mr, N, K, K}; pg8::StaticOrder S; S.init(Mr, N, F.G, (int)blockIdx.x);
    Epi<MODE> E{ea};
    pg8::gemm_phase<Epi<MODE>, pg8::StaticOrder, AL, true>(F.lds + RING_OFF, g, S, E, F.wave);
}
template <int MODE> __device__ __forceinline__ void run_gemm(Frame& F, const u16* A, const u16* Bt, int Mr, int N, int K, const EpiArgs& ea) {
    pg8::Gemm g{A, Bt, Mr, N, K, K}; pg8::StaticOrder S; S.init(Mr, N, F.G, (int)blockIdx.x);
    Epi<MODE> E{ea};
    pg8::gemm_phase<Epi<MODE>, pg8::StaticOrder, true, true>(F.lds + RING_OFF, g, S, E, F.wave);
}
__device__ __forceinline__ void run_gemm_conv(Frame& F, const u16* A, const u16* Bt, int Mr, int N, int K, const EpiArgs& ea) {
    pg8::Gemm g{A, Bt, Mr, N, K, K}; pg8::StaticOrder S; S.init(Mr, N, F.G, (int)blockIdx.x);
    EpiConv E{ea};
#pragma unroll 1
    for (int i = 0;; ++i) {
        OneUnit O; if (!S.next(i, O.u)) break;
        pg8::gemm_phase<EpiConv, OneUnit, false, true>(F.lds + RING_OFF, g, O, E, F.wave);
    }
}
__global__ void __launch_bounds__(NWAVES * 64, 2) mk_fwd(Args args) {
    extern __shared__ __attribute__((aligned(16))) unsigned char lds[];
    Frame F;
    F.lds = (LAS unsigned char*)lds;
    F.MISC = (volatile LAS unsigned*)(F.lds + MISC_OFF);
    F.tid = threadIdx.x; F.lane = F.tid & 63; F.wave = __builtin_amdgcn_readfirstlane(F.tid >> 6);
    F.G = gridDim.x; { const int bx = blockIdx.x; F.vcu = (F.G % 8 == 0) ? (bx % 8) * (F.G / 8) + bx / 8 : bx; }
    unsigned char* ws = args.ws; F.ws = ws;
    F.ctl = (gu32*)(ws + WS_CTL);
    F.out = args.out;
    for (int u = F.tid; u < (LDS_BYTES - LDSCTL_OFF) / 4; u += NWAVES * 64) ((LAS unsigned*)(F.lds + LDSCTL_OFF))[u] = 0u;
    __syncthreads();
    XcdBarrier bar = xcd_barrier_post((unsigned*)(F.ctl + CW_BAR), F.MISC + 8);
#ifdef DUPBAR
#define GRID_BAR() do { xcd_barrier(bar, F.wave); xcd_barrier(bar, F.wave); } while (0)
#else
#define GRID_BAR() xcd_barrier(bar, F.wave)
#endif

#if (PHM & 1)
        for (int rep_ = 0; rep_ < (((DUPM) & 1) ? 2 : 1); ++rep_) {
    p0_mod(F, inp(args, IN_C), inp(args, IN_CCTX), inp(args, IN_ADAW), inp(args, IN_ADAB));
        }
#endif
#if (PHM & 2)
        for (int rep_ = 0; rep_ < (((DUPM) & 2) ? 2 : 1); ++rep_) {
    p0_weights(F, inp(args, IN_WIN), inp(args, IN_WOUT), inp(args, IN_FUP), inp(args, IN_FDN), inp(args, IN_WUP), inp(args, IN_AUP), inp(args, IN_GUP));
        }
#endif
    GRID_BAR();

    float* xctx = (float*)(ws + WS_XCTX);
    const float* mod = (const float*)(ws + WS_MOD);
    for (int l = 0; l < NL; ++l) {
        const float* modl = mod + (size_t)l * 5 * NMOD;
        const float* xl = (l == 0) ? inp(args, IN_X) : F.out;
        const float* xc = (l == 0) ? inp(args, IN_CTX) : xctx;
        const int Mpost = (l == NL - 1) ? MLAT : M;
#if (PHM & 4)
        for (int rep_ = 0; rep_ < (((DUPM) & 4) ? 2 : 1); ++rep_) {
        norm_rows(F, xl, xc, l != 0, inp(args, IN_N1G) + l * D, modl, 0, 1024, M);
        }
#endif
        GRID_BAR();
#ifdef PROBE_G1
        { EpiArgs ea{ws, F.out, &args, l, 0, 0}; run_gemm<0>(F, (const u16*)(ws + WS_XN), (const u16*)(ws + WS_WIN) + (size_t)l * PROJ * D, M, PROJ, D, ea); }
#endif
#if (PHM & 8)
        for (int rep_ = 0; rep_ < (((DUPM) & 8) ? 2 : 1); ++rep_) {
        { EpiArgs ea{ws, F.out, &args, l, 0, 0};
          run_gemm<1>(F, (const u16*)(ws + WS_XN), (const u16*)(ws + WS_WIN) + (size_t)l * PROJ * D, M, PROJ, D, ea); }
        }
#endif
        GRID_BAR();
#if (PHM & 16)
        for (int rep_ = 0; rep_ < (((DUPM) & 16) ? 2 : 1); ++rep_) {
        conv_branch(F, inp(args, IN_CONVA) + (size_t)l * 3 * DC, Mpost);
        }
#endif
#if (PHM & 32)
        for (int rep_ = 0; rep_ < (((DUPM) & 32) ? 2 : 1); ++rep_) {
        { EpiArgs ea{ws, F.out, &args, l, 0, 0};
          run_gemm<2>(F, (const u16*)(ws + WS_ALORA), (const u16*)(ws + WS_BLORA) + (size_t)l * NLORA * KLORA, M, NLORA, KLORA, ea); }
        }
#endif
        GRID_BAR();
#if (PHM & 64)
        for (int rep_ = 0; rep_ < (((DUPM) & 64) ? 2 : 1); ++rep_) {
        scan_phase(F, inp(args, IN_KK) + l * DR, inp(args, IN_KA) + l * DR);
        }
#endif
        GRID_BAR();
#if (PHM & 64)
        scan_fix(F);
#endif
        GRID_BAR();
#if (PHM & 128)
        for (int rep_ = 0; rep_ < (((DUPM) & 128) ? 2 : 1); ++rep_) {
        rwkv_out(F, inp(args, IN_LNG) + l * DR, inp(args, IN_LNB) + l * DR, inp(args, IN_RK) + l * DR, Mpost);
        }
#endif
        GRID_BAR();
#ifdef PROBE_G24
        { EpiArgs ea{ws, F.out, &args, l, 0, 0}; run_gemm<0>(F, (const u16*)(ws + WS_XN), (const u16*)(ws + WS_WOUT) + (size_t)l * D * D, PROBE_G24 ? MLAT : Mpost, D, D, ea); }
#endif
#if (PHM & 256)
        for (int rep_ = 0; rep_ < (((DUPM) & 256) ? 2 : 1); ++rep_) {
        { EpiArgs ea{ws, F.out, &args, l, l == 0 ? 1 : 0, 2048};
          run_gemm<3>(F, (const u16*)(ws + WS_XN), (const u16*)(ws + WS_WOUT) + (size_t)l * D * D, Mpost, D, D, ea); }
        }
#endif
        GRID_BAR();
#if (PHM & 512)
        for (int rep_ = 0; rep_ < (((DUPM) & 512) ? 2 : 1); ++rep_) {
        norm_rows(F, F.out, xctx, true, inp(args, IN_N2G) + l * D, modl, 3072, 4096, Mpost);
        }
#endif
        GRID_BAR();
#ifdef PROBE_G3R
        { EpiArgs ea{ws, F.out, &args, l, 0, 0}; run_gemm_rep<0>(F, (const u16*)(ws + WS_XN), (const u16*)(ws + WS_WUP) + (size_t)l * 2 * FF * D, Mpost, 2 * FF, D, (l == 0) ? 12 : 11, ea); }
#endif
#ifdef PROBE_G3K
        { EpiArgs ea{ws, F.out, &args, l, 0, 0}; int kk_ = PROBE_G3K; asm volatile("" : "+s"(kk_)); int ld_ = PROBE_G3LD; asm volatile("" : "+s"(ld_)); run_gemm_k<0>(F, (const u16*)(ws + WS_XN), (const u16*)(ws + WS_WUP) + (size_t)l * 2 * FF * D, Mpost, 2 * FF, kk_, ld_, ea); }
#endif
#ifdef PROBE_G3B
        { EpiArgs ea{ws, F.out, &args, l, 0, 0}; run_gemm_al<0, false>(F, (const u16*)(ws + WS_XN), (const u16*)(ws + WS_WUP) + (size_t)l * 2 * FF * D, Mpost, 2 * FF, D, ea); }
#endif
#ifdef PROBE_G3
        { EpiArgs ea{ws, F.out, &args, l, 0, 0}; run_gemm<0>(F, (const u16*)(ws + WS_XN), (const u16*)(ws + WS_WUP) + (size_t)l * 2 * FF * D, Mpost, 2 * FF, D, ea); }
#endif
#if (PHM & 1024)
        for (int rep_ = 0; rep_ < (((DUPM) & 1024) ? 2 : 1); ++rep_)
        { EpiArgs ea{ws, F.out, &args, l, 0, 0};
          run_gemm<4>(F, (const u16*)(ws + WS_XN), (const u16*)(ws + WS_WUP) + (size_t)l * 2 * FF * D, Mpost, FF, D, ea); }
        GRID_BAR();
        for (int rep_ = 0; rep_ < (((DUPM) & 2048) ? 2 : 1); ++rep_)
        { EpiArgs ea{ws, F.out, &args, l, 0, 0};
          run_gemm_conv(F, (const u16*)(ws + WS_XN), (const u16*)(ws + WS_WUP) + ((size_t)l * 2 * FF + FF) * D, Mpost, FF, D, ea); }
#endif
        GRID_BAR();
#ifdef PROBE_G24
        { EpiArgs ea{ws, F.out, &args, l, 0, 0}; run_gemm<0>(F, (const u16*)(ws + WS_VALB), (const u16*)(ws + WS_WDN) + (size_t)l * D * FF, PROBE_G24 ? MLAT : Mpost, D, FF, ea); }
#endif
#if (PHM & 4096)
        for (int rep_ = 0; rep_ < (((DUPM) & 4096) ? 2 : 1); ++rep_) {
        { EpiArgs ea{ws, F.out, &args, l, 0, 5120};
          run_gemm<3>(F, (const u16*)(ws + WS_VALB), (const u16*)(ws + WS_WDN) + (size_t)l * D * FF, Mpost, D, FF, ea); }
        }
#endif
        GRID_BAR();
    }
#if (PHM & 8192)
        for (int rep_ = 0; rep_ < (((DUPM) & 8192) ? 2 : 1); ++rep_) {
    final_norm(F, inp(args, IN_FG));
        }
#endif
}

extern "C" void kernel_launch(void* const* d_in, const int* in_sizes, int n_in, void* d_out, int out_size, void* d_ws, size_t ws_size, hipStream_t stream) {
    static int grid = 0;
    if (grid == 0) {
        if (n_in != 26 || out_size != MLAT * D || ws_size < WS_END) { fprintf(stderr, "kernel_launch: unexpected shapes n_in %d out %d ws %zu\n", n_in, out_size, ws_size); grid = -1; return; }
        int dev = 0, cus = 0, per_cu = 0;
        if (hipGetDevice(&dev) != hipSuccess || hipDeviceGetAttribute(&cus, hipDeviceAttributeMultiprocessorCount, dev) != hipSuccess) { grid = -1; return; }
        if (hipFuncSetAttribute((const void*)mk_fwd, hipFuncAttributeMaxDynamicSharedMemorySize, LDS_BYTES) != hipSuccess) { fprintf(stderr, "kernel_launch: hipFuncSetAttribute failed\n"); grid = -1; return; }
        if (hipOccupancyMaxActiveBlocksPerMultiprocessor(&per_cu, (const void*)mk_fwd, NWAVES * 64, LDS_BYTES) != hipSuccess || per_cu < 1) fprintf(stderr, "kernel_launch: occupancy query says %d\n", per_cu);
        (void)hipGetLastError();
        grid = cus;
    }
    if (grid < 0) return;
    if (hipMemsetAsync((char*)d_ws + WS_CTL, 0, CTL_ZERO_BYTES, stream) != hipSuccess) { fprintf(stderr, "kernel_launch: memset failed\n"); return; }
    Args a{};
    for (int i = 0; i < 26; ++i) a.in[i] = (const float*)d_in[i];
    a.out = (float*)d_out; a.ws = (unsigned char*)d_ws;
    hipLaunchKernelGGL(mk_fwd, dim3(grid), dim3(NWAVES * 64), LDS_BYTES, stream, a);
    const hipError_t le = hipPeekAtLastError();
    if (le != hipSuccess) fprintf(stderr, "kernel_launch: launch failed: %s\n", hipGetErrorName(le));
}
```

```cpp
#define LASTNT 7
#include <hip/hip_runtime.h>
#include <cstdio>
#include <cstdint>
__device__ __forceinline__ int fresh_lane() { int z; asm volatile("v_mov_b32 %0, 0" : "=v"(z)); return (int)__builtin_amdgcn_mbcnt_hi(~0u, __builtin_amdgcn_mbcnt_lo(~0u, (unsigned)z)); }
namespace pg8 {
#define PG8_LAS __attribute__((address_space(3)))
typedef unsigned short bf16_t;
typedef short bf16x8 __attribute__((ext_vector_type(8)));
typedef float f32x4 __attribute__((ext_vector_type(4)));
typedef unsigned u32x4 __attribute__((ext_vector_type(4)));
constexpr int BM = 256, BK = 64, HALF = 128, HTB = HALF * BK * 2  , STAGE_BYTES = 8 * HTB, NXCD = 8, WGM = 8;

__host__ __device__ __forceinline__ int lds_byte(int r, int c) { const int st = (r >> 4) * 2 + (c >> 5), rr = r & 15, cc = c & 31, ob = rr * 64 + cc * 2; return st * 1024 + (ob ^ (((ob >> 9) & 1) << 5)); }
__host__ __device__ __forceinline__ void stage_rc(int b, int& R, int& C) { const int st = b / 1024, sb = b % 1024, swz = sb ^ (((sb >> 9) & 1) << 5); R = (st >> 1) * 16 + swz / 64; C = (st & 1) * 32 + (swz % 64) / 2; }
__host__ __device__ __forceinline__ int perm32(int rho) { const int n = rho >> 4, i = rho & 15; return 8 * (i >> 2) + 4 * n + (i & 3); }

struct Unit { int pm, pn, koff, last; };
struct Gemm { const bf16_t* A; const bf16_t* Bt; int M, N, K, ld; };

struct StaticOrder {
    int nM, nN, nwg, G, c;
    __host__ __device__ void init(int M, int N, int G_, int c_) { nM = M / BM; nN = N / BM; nwg = nM * nN; G = G_; c = c_; }
    __host__ __device__ bool next(int i, Unit& u) const {
        const long L = (long)i * G + c; if (L >= nwg) return false;
        int wgid = (int)L; { const int q = nwg / NXCD, r = nwg % NXCD, xcd = wgid % NXCD, off = wgid / NXCD; wgid = (xcd < r ? xcd * (q + 1) : r * (q + 1) + (xcd - r) * q) + off; }
        const int nig = WGM * nN, gid = wgid / nig, fm = gid * WGM, gsz = (nM - fm) < WGM ? (nM - fm) : WGM;
        u.pm = fm + ((wgid % nig) % gsz); u.pn = (wgid % nig) / gsz; u.koff = 0; u.last = (L + G >= nwg) ? 1 : 0; return true;
    }
    __device__ __forceinline__ void a_ready(const Unit&) const {}
    __device__ __forceinline__ void done(const Unit&) const {}
};
struct SplitOrder {
    int pm0, nN, nsplit, ksb, total, G, c;
    __host__ __device__ void init(int pm0_, int nM_, int nN_, int nsplit_, int kslice_elems, int G_, int c_) { pm0 = pm0_; nN = nN_; nsplit = nsplit_; ksb = kslice_elems * 2; total = nM_ * nN_ * nsplit_; G = G_; c = c_; }
    __host__ __device__ bool next(int i, Unit& u) const {
        const long L = (long)i * G + c; if (L >= total) return false;
        const int t = (int)L / nsplit, ks = (int)L % nsplit;
        u.pm = pm0 + t / nN; u.pn = t % nN; u.koff = ks * ksb; u.last = 0; return true;
    }
    __device__ __forceinline__ void a_ready(const Unit&) const {}
    __device__ __forceinline__ void done(const Unit&) const {}
};

template <class Epi, class Sched, bool ALIGN_EPI = false, bool SP2 = false>
__device__ __forceinline__ void gemm_phase(PG8_LAS unsigned char* lds, const Gemm g, const Sched& S, const Epi& E, const int wid_in) {
    const int wid = wid_in, lane = fresh_lane(), tid = wid * 64 + lane, wr = wid >> 2, wc = wid & 3, fr = lane & 15, fq = lane >> 4;
    const int K = g.K, nt = K / BK;
    unsigned voffA, voffB; int aoff, boff;
#define PG8_ADDR() do { const int l_ = fresh_lane(), t_ = wid * 64 + l_, fr_ = l_ & 15, fq_ = l_ >> 4; \
        { int R, C; stage_rc(t_ * 16, R, C); const int Rb = Epi::PERM ? ((R & ~31) + perm32(R & 31)) : R;     \
            voffA = (unsigned)(R * g.ld + C) * 2u; voffB = (unsigned)(Rb * g.ld + C) * 2u; } \
        aoff = lds_byte(wr * 64 + fr_, fq_ * 8); boff = lds_byte(wc * 32 + fr_, fq_ * 8); } while (0)
    PG8_ADDR();
    const size_t kstep = (size_t)(BK * 2);
    const size_t hstep = (size_t)HALF * g.ld * 2;
    const size_t qstep = hstep / 2;
    const size_t tstep = 2 * hstep;
    const unsigned ldsw = (unsigned)wid * 1024u;
#define PG8_SA(b, h) (((b) * 2 + (h)) * HTB)
#define PG8_SB(b, h) ((4 + (b) * 2 + (h)) * HTB)
#define PG8_STAGE(bufoff, gbase, voff) do { _Pragma("unroll") for (int _i = 0; _i < 2; ++_i) \
        __builtin_amdgcn_global_load_lds((const unsigned*)((const char*)(gbase) + (size_t)_i * qstep + (voff)), (PG8_LAS unsigned*)(lds + (bufoff) + ldsw + _i * 8192), 16, 0, 0); } while (0)
#define PG8_LDA(dst, b, h) do { _Pragma("unroll") for (int m = 0; m < 4; ++m) _Pragma("unroll") for (int k = 0; k < 2; ++k) dst[m][k] = *(const PG8_LAS bf16x8*)(lds + PG8_SA(b, h) + aoff + m * 2048 + k * 1024); } while (0)
#define PG8_LDB(dst, b, h) do { _Pragma("unroll") for (int n = 0; n < 2; ++n) _Pragma("unroll") for (int k = 0; k < 2; ++k) dst[n][k] = *(const PG8_LAS bf16x8*)(lds + PG8_SB(b, h) + boff + n * 2048 + k * 1024); } while (0)
#define PG8_MMA(ai, bj, At, Bt) do { __builtin_amdgcn_s_setprio(1); _Pragma("unroll") for (int m = 0; m < 4; ++m) _Pragma("unroll") for (int n = 0; n < 2; ++n) _Pragma("unroll") for (int k = 0; k < 2; ++k) \
        acc[ai][bj][m][n] = __builtin_amdgcn_mfma_f32_16x16x32_bf16(Bt[n][k], At[m][k], acc[ai][bj][m][n], 0, 0, 0); __builtin_amdgcn_s_setprio(0); } while (0)
#define PG8_WAIT_V(n) asm volatile("s_waitcnt vmcnt(" #n ")" ::: "memory")
#define PG8_WAIT_L(n) asm volatile("s_waitcnt lgkmcnt(" #n ")" ::: "memory")
#define PG8_BAR __builtin_amdgcn_s_barrier()
#define PG8_SCHED __builtin_amdgcn_sched_barrier(0)
    Unit cur, nxt; int ui = 0;
    if (!S.next(0, cur)) return;
    f32x4 acc[2][2][4][2];
#pragma unroll
    for (int a = 0; a < 2; ++a)
#pragma unroll
        for (int b = 0; b < 2; ++b)
#pragma unroll
            for (int m = 0; m < 4; ++m)
#pragma unroll
                for (int n = 0; n < 2; ++n) acc[a][b][m][n] = (f32x4){0.f, 0.f, 0.f, 0.f};
    bf16x8 At[4][2], B0[2][2], B1[2][2];
    const char* cA = (const char*)g.A + (size_t)cur.pm * tstep + cur.koff; const char* cB = (const char*)g.Bt + (size_t)cur.pn * tstep + cur.koff;
    S.a_ready(cur);
    if constexpr (SP2) {
        PG8_STAGE(PG8_SB(0, 0), cB, voffB); PG8_STAGE(PG8_SB(0, 1), cB + hstep, voffB); PG8_STAGE(PG8_SA(0, 0), cA, voffA); PG8_STAGE(PG8_SA(0, 1), cA + hstep, voffA);
        if (wr == 1) PG8_BAR;
        PG8_WAIT_V(2); PG8_BAR;
        PG8_STAGE(PG8_SB(1, 0), cB + kstep, voffB); PG8_STAGE(PG8_SA(1, 0), cA + kstep, voffA); PG8_STAGE(PG8_SB(1, 1), cB + hstep + kstep, voffB);
        PG8_WAIT_V(6); PG8_BAR;
    } else {
        PG8_STAGE(PG8_SB(0, 0), cB, voffB); PG8_STAGE(PG8_SA(0, 0), cA, voffA); PG8_STAGE(PG8_SB(0, 1), cB + hstep, voffB); PG8_STAGE(PG8_SA(0, 1), cA + hstep, voffA);
        if (wr == 1) PG8_BAR;
        PG8_WAIT_V(4); PG8_BAR;
        PG8_STAGE(PG8_SB(1, 0), cB + kstep, voffB); PG8_STAGE(PG8_SA(1, 0), cA + kstep, voffA); PG8_STAGE(PG8_SB(1, 1), cB + hstep + kstep, voffB);
        PG8_WAIT_V(6); PG8_BAR;
    }
    for (;;) {
        const bool has_next = S.next(ui + 1, nxt);
        const char* nA = has_next ? (const char*)g.A + (size_t)nxt.pm * tstep + nxt.koff : cA; const char* nB = has_next ? (const char*)g.Bt + (size_t)nxt.pn * tstep + nxt.koff : cB;
        for (int t = 0; t < nt; t += 2) {
            const bool last = (t == nt - 2);
            const char* a1 = cA + (size_t)(t + 1) * kstep;
            const char* a2 = last ? nA : cA + (size_t)(t + 2) * kstep; const char* b2 = last ? nB : cB + (size_t)(t + 2) * kstep;
            const char* a3 = a2 + kstep; const char* b3 = b2 + kstep;
            if (last && has_next) S.a_ready(nxt);
            if constexpr (SP2) {
            PG8_LDB(B0, 0, 0); PG8_LDB(B1, 0, 1); PG8_SCHED; PG8_LDA(At, 0, 0); PG8_STAGE(PG8_SA(1, 1), a1 + hstep, voffA);
            PG8_WAIT_V(8); PG8_WAIT_L(0); PG8_BAR; PG8_MMA(0, 0, At, B0); PG8_MMA(0, 1, At, B1); PG8_BAR; PG8_SCHED;
            PG8_LDA(At, 0, 1); PG8_STAGE(PG8_SB(0, 0), b2, voffB); PG8_STAGE(PG8_SB(0, 1), b2 + hstep, voffB); PG8_STAGE(PG8_SA(0, 0), a2, voffA);
            PG8_WAIT_V(8); PG8_WAIT_L(0); PG8_BAR; PG8_MMA(1, 0, At, B0); PG8_MMA(1, 1, At, B1); PG8_BAR; PG8_SCHED;
            PG8_LDB(B0, 1, 0); PG8_LDB(B1, 1, 1); PG8_SCHED; PG8_LDA(At, 1, 0); PG8_STAGE(PG8_SA(0, 1), a2 + hstep, voffA);
            PG8_WAIT_V(8); PG8_WAIT_L(0); PG8_BAR; PG8_MMA(0, 0, At, B0); PG8_MMA(0, 1, At, B1); PG8_BAR; PG8_SCHED;
            PG8_LDA(At, 1, 1); PG8_STAGE(PG8_SB(1, 0), b3, voffB); PG8_STAGE(PG8_SB(1, 1), b3 + hstep, voffB); PG8_STAGE(PG8_SA(1, 0), a3, voffA);
            PG8_WAIT_V(8); PG8_WAIT_L(0); PG8_BAR; PG8_MMA(1, 0, At, B0); PG8_MMA(1, 1, At, B1); PG8_BAR; PG8_SCHED;
            } else {
            PG8_LDB(B0, 0, 0); PG8_SCHED; PG8_LDA(At, 0, 0); PG8_STAGE(PG8_SA(1, 1), a1 + hstep, voffA);
            PG8_WAIT_L(8); PG8_BAR; PG8_WAIT_L(0); PG8_MMA(0, 0, At, B0); PG8_BAR; PG8_SCHED;
            PG8_LDB(B1, 0, 1); PG8_STAGE(PG8_SB(0, 0), b2, voffB);
            PG8_BAR; PG8_WAIT_L(0); PG8_MMA(0, 1, At, B1); PG8_BAR;
            PG8_LDA(At, 0, 1); PG8_STAGE(PG8_SA(0, 0), a2, voffA);
            PG8_BAR; PG8_WAIT_L(0); PG8_MMA(1, 0, At, B0); PG8_BAR; PG8_SCHED;
            PG8_STAGE(PG8_SB(0, 1), b2 + hstep, voffB);
            PG8_WAIT_V(6); PG8_BAR; PG8_MMA(1, 1, At, B1); PG8_BAR;
            PG8_LDB(B0, 1, 0); PG8_SCHED; PG8_LDA(At, 1, 0); PG8_STAGE(PG8_SA(0, 1), a2 + hstep, voffA);
            PG8_WAIT_L(8); PG8_BAR; PG8_WAIT_L(0); PG8_MMA(0, 0, At, B0); PG8_BAR; PG8_SCHED;
            PG8_LDB(B1, 1, 1); PG8_STAGE(PG8_SB(1, 0), b3, voffB);
            PG8_BAR; PG8_WAIT_L(0); PG8_MMA(0, 1, At, B1); PG8_BAR;
            PG8_LDA(At, 1, 1); PG8_STAGE(PG8_SA(1, 0), a3, voffA);
            PG8_BAR; PG8_WAIT_L(0); PG8_MMA(1, 0, At, B0); PG8_BAR; PG8_SCHED;
            PG8_STAGE(PG8_SB(1, 1), b3 + hstep, voffB);
            PG8_WAIT_V(6); PG8_BAR; PG8_MMA(1, 1, At, B1); PG8_BAR;
            }
        }
        if constexpr (ALIGN_EPI) { if (wr == 0) PG8_BAR; }
        if constexpr (!Epi::AFTER_DRAIN) { const int el = fresh_lane(); E(acc, cur, wr, wc, el & 15, el >> 4); S.done(cur); PG8_ADDR(); }
        if (!has_next) break;
#pragma unroll
        for (int a = 0; a < 2; ++a)
#pragma unroll
            for (int b = 0; b < 2; ++b)
#pragma unroll
                for (int m = 0; m < 4; ++m)
#pragma unroll
                    for (int n = 0; n < 2; ++n) acc[a][b][m][n] = (f32x4){0.f, 0.f, 0.f, 0.f};
        cur = nxt; cA = nA; cB = nB; ++ui;
        if constexpr (ALIGN_EPI) { if (wr == 1) PG8_BAR; }
    }
    PG8_WAIT_V(0);
    if constexpr (!ALIGN_EPI) { if (wr == 0) PG8_BAR; }
    PG8_BAR;
    if constexpr (Epi::AFTER_DRAIN) { E.fused(acc, cur, wr, wc, fr, fq, lds, wid, lane); S.done(cur); }
#undef PG8_ADDR
#undef PG8_SA
#undef PG8_SB
#undef PG8_STAGE
#undef PG8_LDA
#undef PG8_LDB
#undef PG8_MMA
#undef PG8_WAIT_V
#undef PG8_WAIT_L
#undef PG8_BAR
#undef PG8_SCHED
}
}
#define GAS __attribute__((address_space(1)))
#define LAS __attribute__((address_space(3)))
typedef unsigned short bf16;
typedef unsigned v4u __attribute__((ext_vector_type(4)));
typedef float f32x4 __attribute__((ext_vector_type(4)));
typedef short bf16x8 __attribute__((ext_vector_type(8)));
typedef GAS unsigned gu32;
typedef GAS unsigned long long gu64;
#define RLX_AGENT __ATOMIC_RELAXED, __HIP_MEMORY_SCOPE_AGENT
#define LDS_WAIT() asm volatile("s_waitcnt lgkmcnt(0)" ::: "memory")
#define VM_WAIT() asm volatile("s_waitcnt vmcnt(0)" ::: "memory")
__device__ __forceinline__ unsigned long long rt() { return __builtin_amdgcn_s_memrealtime(); }
__device__ __forceinline__ unsigned f2bf(float f) { unsigned u = __builtin_bit_cast(unsigned, f); return (u + 0x7fffu + ((u >> 16) & 1u)) >> 16; }
typedef __bf16 bf2v_t __attribute__((ext_vector_type(2)));
__device__ __forceinline__ unsigned pk2(float lo, float hi) { bf2v_t v; v.x = (__bf16)lo; v.y = (__bf16)hi; return __builtin_bit_cast(unsigned, v); }

#define XB_TMO      128
#define XB_XCNT(j)  (256  + 64 * (j))
#define XB_XSUB(j)  (1280 + 64 * (j))
#define XB_XGEN(j)  (2304 + 64 * (j))
#define XB_TOP      3328
#define XB_TOPGEN   3392
#define XCD_BAR_WORDS 3456
#define XB_SPIN_CAP (1u << 18)

__device__ __forceinline__ unsigned xb_ld(unsigned* p)              { return __hip_atomic_load(p, __ATOMIC_RELAXED, __HIP_MEMORY_SCOPE_AGENT); }
__device__ __forceinline__ unsigned xb_add(unsigned* p, unsigned v) { return __hip_atomic_fetch_add(p, v, __ATOMIC_RELAXED, __HIP_MEMORY_SCOPE_AGENT); }
__device__ __forceinline__ unsigned xb_xcc_id() { return (unsigned)__builtin_amdgcn_s_getreg((3 << 11) | 20) & 0xFu; }
#define XB_SPIN(cond, bar) do { unsigned _sp = 0; while (cond) { __builtin_amdgcn_s_sleep(1); \
    if ((++_sp & 255u) == 0u) { if (xb_ld(&(bar)[XB_TMO])) break; if (_sp > XB_SPIN_CAP) { atomicAdd(&(bar)[XB_TMO], 1u); break; } } } } while (0)

struct XcdBarrier {
    unsigned* bar; unsigned x;
    volatile LAS unsigned* st;
};

__device__ __forceinline__ XcdBarrier xcd_barrier_post(unsigned* bar, volatile LAS unsigned* st) {
    XcdBarrier b; b.bar = bar; b.x = xb_xcc_id(); b.st = st;
    if (threadIdx.x == 0) (void)xb_add(&bar[XB_XCNT(b.x)], 1u);
    return b;
}
__device__ __forceinline__ void xcd_barrier_complete(unsigned* bar, unsigned x, unsigned& nloc, unsigned& nx) {
    const unsigned G = gridDim.x * gridDim.y * gridDim.z;
    unsigned sum, cnt, mine, sp = 0u;
    for (;;) {
        sum = 0u; cnt = 0u; mine = 0u;
#pragma unroll
        for (unsigned j = 0; j < 16; ++j) { const unsigned c = xb_ld(&bar[XB_XCNT(j)]); sum += c; cnt += (c > 0u) ? 1u : 0u; mine = (j == x) ? c : mine; }
        if (sum == G) break;
        __builtin_amdgcn_s_sleep(1);
        if ((++sp & 255u) == 0u) { if (xb_ld(&bar[XB_TMO])) break; if (sp > XB_SPIN_CAP) { atomicAdd(&bar[XB_TMO], 1u); break; } }
    }
    nloc = mine > 0u ? mine : 1u; nx = cnt > 0u ? cnt : 1u;
}

__device__ __forceinline__ void xcd_barrier(const XcdBarrier& b, const int wave) {
    asm volatile("s_waitcnt vmcnt(0)" ::: "memory");
    __syncthreads();
    if (wave == 0 && fresh_lane() == 0) {
        unsigned* bar = b.bar; asm volatile("" : "+s"(bar)); const unsigned bx_ = xb_xcc_id();
        __builtin_amdgcn_s_waitcnt(0);
        unsigned nloc = b.st[0], nx = b.st[1];
        if (nloc == 0u) { xcd_barrier_complete(bar, bx_, nloc, nx); b.st[0] = nloc; b.st[1] = nx; }
        const unsigned old = xb_add(&bar[XB_XSUB(bx_)], 1u);
        const unsigned gen = old / nloc;
        if (old + 1u == (gen + 1u) * nloc) {
            __builtin_amdgcn_fence(__ATOMIC_RELEASE, "agent");
            asm volatile("s_waitcnt vmcnt(0)" ::: "memory");
            const unsigned og = xb_add(&bar[XB_TOP], 1u);
            const unsigned tg = og / nx;
            if (og + 1u == (tg + 1u) * nx) xb_add(&bar[XB_TOPGEN], 1u);
            else XB_SPIN(xb_ld(&bar[XB_TOPGEN]) == tg, bar);
            __builtin_amdgcn_fence(__ATOMIC_ACQUIRE, "agent");
            xb_add(&bar[XB_XGEN(bx_)], 1u);
            asm volatile("s_waitcnt vmcnt(0)" ::: "memory");
        } else {
            XB_SPIN(xb_ld(&bar[XB_XGEN(bx_)]) == gen, bar);
            __builtin_amdgcn_fence(__ATOMIC_ACQUIRE, "agent");
            asm volatile("s_waitcnt vmcnt(0)" ::: "memory");
        }
    }
    __syncthreads();
}


#ifndef PHM
#define PHM 0xFFFF
#endif
#ifndef DUPM
#define DUPM 0
#endif
#ifndef DUPS
#define DUPS 0
#endif
constexpr int NWAVES = 8;
constexpr int D = 1024, NB = 4, T = 8192, TC = 256, NL = 2;
constexpr int DC = 512, DR = 512, HS = 64, FF = 2816, PROJ = 3328, NMOD = 6144;
constexpr int MLAT = NB * T, MCTX = NB * TC, M = MLAT + MCTX;
constexpr int NLORA = 2560, KLORA = 256;
constexpr float RMS_EPS = 1e-6f, GN_EPS = 64e-5f, DECAY_SCALE = 0.6065306597126334f;

typedef unsigned short u16;
typedef unsigned v4u __attribute__((ext_vector_type(4)));
typedef unsigned v2u __attribute__((ext_vector_type(2)));
typedef _Float16 h2 __attribute__((ext_vector_type(2)));

constexpr size_t MiB = 1u << 20;
constexpr size_t WS_CTL = 0, CTL_ZERO_BYTES = 1 * MiB;
constexpr size_t WS_MOD = 1 * MiB;
constexpr size_t WS_XCTX = 2 * MiB;
constexpr size_t WS_WIN = 6 * MiB;
constexpr size_t WS_WOUT = 19 * MiB;
constexpr size_t WS_WUP = 23 * MiB;
constexpr size_t WS_WDN = 45 * MiB;
constexpr size_t WS_BLORA = 56 * MiB;
constexpr size_t WS_XN = 60 * MiB;
constexpr size_t WS_PC = 126 * MiB;
constexpr size_t WS_PRKV = 225 * MiB;
constexpr size_t WS_ALORA = 324 * MiB;
constexpr size_t WS_DEC = 341 * MiB;
constexpr size_t WS_AA = 407 * MiB;
constexpr size_t WS_GATE = 473 * MiB;
constexpr size_t WS_GATEB = 126 * MiB;
constexpr size_t WS_VALB = 308 * MiB;
constexpr size_t WS_END = 506 * MiB;
static_assert(WS_XN + (size_t)M * D * 2 <= WS_PC, "map");
static_assert(WS_PC + (size_t)M * 1536 * 2 <= WS_PRKV, "map");
static_assert(WS_PRKV + (size_t)M * 1536 * 2 <= WS_ALORA, "map");
static_assert(WS_ALORA + (size_t)M * 256 * 2 <= WS_DEC, "map");
static_assert(WS_DEC + (size_t)M * 1024 * 2 <= WS_AA, "map");
static_assert(WS_AA + (size_t)M * 1024 * 2 <= WS_GATE, "map");
static_assert(WS_GATE + (size_t)M * 512 * 2 <= WS_END, "map");
static_assert(WS_GATEB + (size_t)M * FF * 2 <= WS_VALB, "map");
static_assert(WS_VALB + (size_t)M * FF * 2 <= WS_END, "map");
static_assert(WS_BLORA + (size_t)NL * NLORA * KLORA * 2 <= WS_XN, "map");
constexpr int CW_BAR = 4096;

constexpr int RING_OFF = 0, RING_BYTES = 131072;
constexpr int LDS_BYTES = 147456;
constexpr int LDSCTL_OFF = LDS_BYTES - 1024, MISC_OFF = LDSCTL_OFF + 320;

#ifndef LASTNT
#define LASTNT 0
#endif
#define ST16L(bit_, last_, ptr_, val_) do { if (((LASTNT) & (bit_)) && (last_)) __builtin_nontemporal_store((val_), (v4u*)(ptr_)); else *(v4u*)(ptr_) = (val_); } while (0)
#ifdef NT_M2
#define ST_NT2(ptr_, val_) __builtin_nontemporal_store((val_), (ptr_))
#else
#define ST_NT2(ptr_, val_) (*(ptr_) = (val_))
#endif
#ifdef NT_C
#define ST_NT3(ptr_, val_) __builtin_nontemporal_store((val_), (ptr_))
#else
#define ST_NT3(ptr_, val_) (*(ptr_) = (val_))
#endif
#ifndef NO_NT
#define ST_NT(ptr_, val_) __builtin_nontemporal_store((val_), (ptr_))
#else
#define ST_NT(ptr_, val_) (*(ptr_) = (val_))
#endif
__device__ __forceinline__ unsigned pk_bf16(float lo, float hi) { return pk2(lo, hi); }
__device__ __forceinline__ unsigned pk_f16(float lo, float hi) { h2 v; v.x = (_Float16)lo; v.y = (_Float16)hi; return __builtin_bit_cast(unsigned, v); }
__device__ __forceinline__ void unpk_f16(unsigned u, float& lo, float& hi) { const h2 v = __builtin_bit_cast(h2, u); lo = (float)v.x; hi = (float)v.y; }
__device__ __forceinline__ void unpk8_f16(const v4u u, float (&f)[8]) { unpk_f16(u.x, f[0], f[1]); unpk_f16(u.y, f[2], f[3]); unpk_f16(u.z, f[4], f[5]); unpk_f16(u.w, f[6], f[7]); }
__device__ __forceinline__ float sigmoidf_(float x) { return __builtin_amdgcn_rcpf(1.0f + __builtin_amdgcn_exp2f(-1.4426950408889634f * x)); }
__device__ __forceinline__ float siluf_(float x) { return x * __builtin_amdgcn_rcpf(1.0f + __builtin_amdgcn_exp2f(-1.4426950408889634f * x)); }
__device__ __forceinline__ float tanhf_(float x) { const float e = __builtin_amdgcn_exp2f(-2.8853900817779268f * fabsf(x)); const float t = (1.0f - e) * __builtin_amdgcn_rcpf(1.0f + e); return x < 0.f ? -t : t; }
template <int CTRL> __device__ __forceinline__ float dppf(float x) { return __builtin_bit_cast(float, __builtin_amdgcn_update_dpp(0, __builtin_bit_cast(int, x), CTRL, 0xF, 0xF, true)); }
template <int CTRL, int ROWMASK> __device__ __forceinline__ float dpp1(float x) { return __builtin_bit_cast(float, __builtin_amdgcn_update_dpp(0x3f800000, __builtin_bit_cast(int, x), CTRL, ROWMASK, 0xF, false)); }
__device__ __forceinline__ float allreduce16(float x) { x += dppf<0x121>(x); x += dppf<0x122>(x); x += dppf<0x124>(x); x += dppf<0x128>(x); return x; }
__device__ __forceinline__ float group8_sum(float v) { v += dppf<0xB1>(v); v += dppf<0x4E>(v); v += dppf<0x141>(v); return v; }
__device__ __forceinline__ float wave_sum(float v) {
    v = allreduce16(v);
    const int vi = __builtin_bit_cast(int, v);
    const float s0 = __builtin_bit_cast(float, __builtin_amdgcn_readlane(vi, 0)), s1 = __builtin_bit_cast(float, __builtin_amdgcn_readlane(vi, 16)), s2 = __builtin_bit_cast(float, __builtin_amdgcn_readlane(vi, 32)), s3 = __builtin_bit_cast(float, __builtin_amdgcn_readlane(vi, 48));
    return (s0 + s1) + (s2 + s3);
}

#define IN_X 0
#define IN_C 1
#define IN_CTX 2
#define IN_CCTX 3
#define IN_ADAW 4
#define IN_ADAB 5
#define IN_N1G 6
#define IN_N2G 7
#define IN_WIN 8
#define IN_CONVA 9
#define IN_W0 10
#define IN_WUP 11
#define IN_A0 12
#define IN_AUP 13
#define IN_KK 14
#define IN_KA 15
#define IN_RK 16
#define IN_GUP 17
#define IN_LNG 18
#define IN_LNB 19
#define IN_WOUT 20
#define IN_FUP 21
#define IN_FCW 22
#define IN_FCB 23
#define IN_FDN 24
#define IN_FG 25
struct Args;
__device__ __forceinline__ const float* inp(const Args& a, int i);
struct EpiArgs {
    unsigned char* ws; float* out; const Args* ap; int l; int in_is_input; int goff;
};
template <int MODE> struct Epi {
    static constexpr bool PERM = true, AFTER_DRAIN = false;
    EpiArgs a;
    __device__ __forceinline__ void operator()(const pg8::f32x4 (&acc)[2][2][4][2], const pg8::Unit& u, int wr, int wc, int fr, int fq) const {
        using pg8::f32x4;
        const int row0 = u.pm * 256 + wr * 64 + fr;
        const int colb = u.pn * 256 + wc * 32 + 8 * fq;
        unsigned char* const ws_ = a.ws;
        if constexpr (MODE == 0) {
#pragma unroll
            for (int ai = 0; ai < 2; ++ai)
#pragma unroll
                for (int bj = 0; bj < 2; ++bj)
#pragma unroll
                    for (int m = 0; m < 4; ++m) { asm volatile("" :: "v"(acc[ai][bj][m][0]), "v"(acc[ai][bj][m][1])); }
        } else if constexpr (MODE == 1) {
#pragma unroll
            for (int ai = 0; ai < 2; ++ai)
#pragma unroll
                for (int m = 0; m < 4; ++m) {
                    const size_t row = (size_t)(row0 + ai * 128 + m * 16);
                    if (u.pn >= 2 && u.pn < 6) {
                        const f32x4 c0v = acc[ai][0][m][0], c1v = acc[ai][0][m][1], x0v = acc[ai][1][m][0], x1v = acc[ai][1][m][1];
                        v4u w; w.x = pk_f16(c0v[0] * x0v[0], c0v[1] * x0v[1]); w.y = pk_f16(c0v[2] * x0v[2], c0v[3] * x0v[3]); w.z = pk_f16(c1v[0] * x1v[0], c1v[1] * x1v[1]); w.w = pk_f16(c1v[2] * x1v[2], c1v[3] * x1v[3]);
                        ST16L(1, u.last, (u16*)(ws_ + WS_PC) + row * 1536 + 512 + (u.pn - 2) * 128 + wc * 32 + 8 * fq, w);
                    } else
#pragma unroll
                    for (int bj = 0; bj < 2; ++bj) {
                        const f32x4 v0 = acc[ai][bj][m][0], v1 = acc[ai][bj][m][1];
                        const int col = colb + bj * 128;
                        v4u w;
                        if (u.pn < 12) {
                            w.x = pk_f16(v0[0], v0[1]); w.y = pk_f16(v0[2], v0[3]); w.z = pk_f16(v1[0], v1[1]); w.w = pk_f16(v1[2], v1[3]);
                            u16* dst = (u.pn < 6) ? ((u16*)(ws_ + WS_PC) + row * 1536 + col) : ((u16*)(ws_ + WS_PRKV) + row * 1536 + (col - 1536));
                            ST16L(1, u.last, dst, w);
                        } else {
                            const int cl = col - 3072;
                            float f[8] = {v0[0], v0[1], v0[2], v0[3], v1[0], v1[1], v1[2], v1[3]};
#pragma unroll
                            for (int j = 0; j < 8; ++j) f[j] = (cl < 64) ? tanhf_(f[j]) : ((cl < 128) ? f[j] : sigmoidf_(f[j]));
                            w.x = pk_bf16(f[0], f[1]); w.y = pk_bf16(f[2], f[3]); w.z = pk_bf16(f[4], f[5]); w.w = pk_bf16(f[6], f[7]);
                            *(v4u*)((u16*)(ws_ + WS_ALORA) + row * 256 + cl) = w;
                        }
                    }
                }
        } else if constexpr (MODE == 2) {
#pragma unroll
            for (int bj = 0; bj < 2; ++bj) {
                const int col = colb + bj * 128;
                float pv[8];
                if (u.pn < 8) { const float* pp = (u.pn < 4) ? (inp(*a.ap, IN_W0) + a.l * 1024 + col) : (inp(*a.ap, IN_A0) + a.l * 1024 + (col - 1024));
#pragma unroll
                    for (int j = 0; j < 8; ++j) pv[j] = pp[j]; }
#pragma unroll
                for (int ai = 0; ai < 2; ++ai)
#pragma unroll
                    for (int m = 0; m < 4; ++m) {
                        const size_t row = (size_t)(row0 + ai * 128 + m * 16);
                        const f32x4 v0 = acc[ai][bj][m][0], v1 = acc[ai][bj][m][1];
                        float f[8] = {v0[0], v0[1], v0[2], v0[3], v1[0], v1[1], v1[2], v1[3]};
                        u16* dst;
                        if (u.pn < 4) {
#pragma unroll
                            for (int j = 0; j < 8; ++j) f[j] = __builtin_amdgcn_exp2f((-DECAY_SCALE * 1.4426950408889634f) * sigmoidf_(pv[j] + f[j]));
                            dst = (u16*)(ws_ + WS_DEC) + row * 1024 + col;
                        } else if (u.pn < 8) {
#pragma unroll
                            for (int j = 0; j < 8; ++j) f[j] = sigmoidf_(pv[j] + f[j]);
                            dst = (u16*)(ws_ + WS_AA) + row * 1024 + (col - 1024);
                        } else dst = (u16*)(ws_ + WS_GATE) + row * 512 + (col - 2048);
                        v4u w; w.x = pk_f16(f[0], f[1]); w.y = pk_f16(f[2], f[3]); w.z = pk_f16(f[4], f[5]); w.w = pk_f16(f[6], f[7]);
                        ST16L(2, u.last, dst, w);
                        asm volatile("" ::: "memory");
                    }
            }
        } else if constexpr (MODE == 3) {
            const int s = (u.pm < 128) ? (u.pm >> 5) : 4;
            const bool lat = u.pm < 128;
            const bool fin = (a.l == NL - 1) && (a.goff == 5120);
            const float* modp = (const float*)(ws_ + WS_MOD) + (size_t)a.l * 5 * NMOD + a.goff;
            u16* const xb = lat ? (u16*)a.out : (u16*)(ws_ + WS_XCTX);
            u16* const ob = fin ? (u16*)(ws_ + WS_XN) : xb;
            const float* const ibase = lat ? inp(*a.ap, IN_X) : inp(*a.ap, IN_CTX);
#pragma unroll
            for (int bj = 0; bj < 2; ++bj) {
                const int col = colb + bj * 128;
                const f32x4 g0 = *(const f32x4*)(modp + s * NMOD + col), g1 = *(const f32x4*)(modp + s * NMOD + col + 4);
#pragma unroll
                for (int ai = 0; ai < 2; ++ai)
#pragma unroll
                    for (int m = 0; m < 4; ++m) {
                        const int row = row0 + ai * 128 + m * 16;
                        const size_t off = lat ? ((size_t)row * D + col) : ((size_t)(row - MLAT) * D + col);
                        f32x4 x0, x1;
                        if (a.in_is_input) { x0 = *(const f32x4*)(ibase + off); x1 = *(const f32x4*)(ibase + off + 4); }
                        else { const v4u xu = *(const v4u*)(xb + off);
                            x0 = (f32x4){__uint_as_float(xu.x << 16), __uint_as_float(xu.x & 0xffff0000u), __uint_as_float(xu.y << 16), __uint_as_float(xu.y & 0xffff0000u)};
                            x1 = (f32x4){__uint_as_float(xu.z << 16), __uint_as_float(xu.z & 0xffff0000u), __uint_as_float(xu.w << 16), __uint_as_float(xu.w & 0xffff0000u)}; }
                        const f32x4 y0 = x0 + g0 * acc[ai][bj][m][0], y1 = x1 + g1 * acc[ai][bj][m][1];
                        v4u w; w.x = pk2(y0[0], y0[1]); w.y = pk2(y0[2], y0[3]); w.z = pk2(y1[0], y1[1]); w.w = pk2(y1[2], y1[3]);
                        ST16L(4, u.last, ob + off, w);
                    }
            }
        } else {
#pragma unroll
            for (int ai = 0; ai < 2; ++ai)
#pragma unroll
                for (int m = 0; m < 4; ++m) {
                    const size_t row = (size_t)(row0 + ai * 128 + m * 16);
#pragma unroll
                    for (int bj = 0; bj < 2; ++bj) {
                        const f32x4 v0 = acc[ai][bj][m][0], v1 = acc[ai][bj][m][1];
                        const int col = colb + bj * 128;
                        v4u w; w.x = pk_f16(v0[0], v0[1]); w.y = pk_f16(v0[2], v0[3]); w.z = pk_f16(v1[0], v1[1]); w.w = pk_f16(v1[2], v1[3]);
                        u16* dst = (u.pn < 11) ? ((u16*)(ws_ + WS_GATEB) + row * FF + col) : ((u16*)(ws_ + WS_VALB) + row * FF + (col - FF));
                        ST_NT((v4u*)dst, w);
                    }
                }
        }
    }
};

struct Frame {
    LAS unsigned char* lds;
    volatile LAS unsigned* MISC;
    gu32* ctl;
    int tid, lane, wave, vcu, G;
    float* out;
    unsigned char* ws;
};
#define PHASE_BEGIN(F) do { (F).lane = fresh_lane(); (F).tid = (F).wave * 64 + (F).lane; } while (0)

__device__ __forceinline__ void p0_mod(Frame& F, const float* cvec, const float* cctx, const float* adaw, const float* adab) {
    PHASE_BEGIN(F);
    LAS float* sl = (LAS float*)(F.lds);
    LAS float* red = (LAS float*)(F.lds + 20480);
    float* mod = (float*)(F.ws + WS_MOD);
    const int nchunk = NL * (NMOD / 64);
    if ((int)blockIdx.x >= nchunk) return;
    for (int i = F.tid; i < 5 * 1024; i += NWAVES * 64) { const int s = i >> 10, k = i & 1023; const float c = (s < 4) ? cvec[s * 1024 + k] : cctx[k]; sl[i] = siluf_(c); }
    __syncthreads();
    for (int ci = blockIdx.x; ci < nchunk; ci += F.G) {
        const int l = ci / (NMOD / 64), n = (ci % (NMOD / 64)) * 64 + F.lane;
        const float* w = adaw + (size_t)l * D * NMOD + n;
        float acc[5] = {0.f, 0.f, 0.f, 0.f, 0.f};
        const int k0 = F.wave * 128;
#pragma unroll 8
        for (int k = k0; k < k0 + 128; ++k) { const float wv = w[(size_t)k * NMOD];
#pragma unroll
            for (int s = 0; s < 5; ++s) acc[s] += sl[s * 1024 + k] * wv; }
#pragma unroll
        for (int s = 0; s < 5; ++s) red[(F.wave * 5 + s) * 64 + F.lane] = acc[s];
        __syncthreads();
        if (F.tid < 320) { const int s = F.tid >> 6, ln = F.tid & 63; float t = 0.f;
#pragma unroll
            for (int w8 = 0; w8 < 8; ++w8) t += red[(w8 * 5 + s) * 64 + ln];
            const int nn = (ci % (NMOD / 64)) * 64 + ln;
            mod[((size_t)l * 5 + s) * NMOD + nn] = t + adab[l * NMOD + nn]; }
        __syncthreads();
    }
}
__device__ __forceinline__ void p0_transpose_item(const float* W, int K, int N, u16* WT, LAS float* scr, int item, int lane, const bool perm_in = false) {
    const int nblk = N / 32, kb = item / nblk, nb = item % nblk, k0 = 64 * kb, n0 = 32 * nb;
    int d0 = n0;
    if (perm_in && n0 >= 512 && n0 < 1536) { const int isx = n0 >= 1024, c = n0 - (isx ? 1024 : 512); d0 = 512 + 256 * (c >> 7) + 128 * isx + (c & 127); }
#pragma unroll 8
    for (int i = 0; i < 32; ++i) { const int kk = 2 * i + (lane >> 5); scr[kk * 33 + (lane & 31)] = W[(size_t)(k0 + kk) * N + n0 + (lane & 31)]; }
    LDS_WAIT(); asm volatile("" ::: "memory");
    const int c = lane & 7;
#pragma unroll
    for (int j = 0; j < 4; ++j) { const int n = (lane >> 3) + 8 * j; const LAS float* s = scr + (8 * c) * 33 + n;
        v4u o; o.x = pk2(s[0 * 33], s[1 * 33]); o.y = pk2(s[2 * 33], s[3 * 33]); o.z = pk2(s[4 * 33], s[5 * 33]); o.w = pk2(s[6 * 33], s[7 * 33]);
        *(GAS v4u*)(WT + (size_t)(d0 + n) * K + k0 + 8 * c) = o; }
    LDS_WAIT(); asm volatile("" ::: "memory");
}
__device__ __forceinline__ void p0_weights(Frame& F, const float* win, const float* wout, const float* fup, const float* fdn, const float* wup, const float* aup, const float* gup) {
    PHASE_BEGIN(F);
    LAS float* scr = (LAS float*)(F.lds + 32768 + F.wave * 8704);
    const int gw = F.vcu * NWAVES + F.wave, NGW = F.G * NWAVES;
    constexpr int I_IN = (D / 64) * (PROJ / 32), I_OUT = (D / 64) * (D / 32), I_UP = (D / 64) * (2 * FF / 32), I_DN = (FF / 64) * (D / 32);
    constexpr int PER_L = I_IN + I_OUT + I_UP + I_DN;
    for (int it = gw; it < NL * PER_L; it += NGW) {
        const int l = it / PER_L; int r = it % PER_L;
        if (r < I_IN) { p0_transpose_item(win + (size_t)l * D * PROJ, D, PROJ, (u16*)(F.ws + WS_WIN) + (size_t)l * PROJ * D, scr, r, F.lane, true); continue; } r -= I_IN;
        if (r < I_OUT) { p0_transpose_item(wout + (size_t)l * D * D, D, D, (u16*)(F.ws + WS_WOUT) + (size_t)l * D * D, scr, r, F.lane); continue; } r -= I_OUT;
        if (r < I_UP) { p0_transpose_item(fup + (size_t)l * D * 2 * FF, D, 2 * FF, (u16*)(F.ws + WS_WUP) + (size_t)l * 2 * FF * D, scr, r, F.lane); continue; } r -= I_UP;
        p0_transpose_item(fdn + (size_t)l * FF * D, FF, D, (u16*)(F.ws + WS_WDN) + (size_t)l * D * FF, scr, r, F.lane);
    }
    const int gt = F.vcu * NWAVES * 64 + F.tid, NGT = F.G * NWAVES * 64;
    u16* bl = (u16*)(F.ws + WS_BLORA);
    for (int e = gt; e < NL * NLORA * (KLORA / 8); e += NGT) {
        const int kc = e % (KLORA / 8), n = (e / (KLORA / 8)) % NLORA, l = e / ((KLORA / 8) * NLORA);
        float f[8];
#pragma unroll
        for (int j = 0; j < 8; ++j) { const int k = kc * 8 + j; float v = 0.f;
            if (n < 1024) { if (k < 64) v = wup[(((size_t)l * 2 + (n >> 9)) * 64 + k) * 512 + (n & 511)]; }
            else if (n < 2048) { if (k >= 64 && k < 128) v = aup[(((size_t)l * 2 + ((n - 1024) >> 9)) * 64 + (k - 64)) * 512 + (n & 511)]; }
            else { if (k >= 128) v = gup[((size_t)l * 128 + (k - 128)) * 512 + (n - 2048)]; }
            f[j] = v; }
        v4u o; o.x = pk2(f[0], f[1]); o.y = pk2(f[2], f[3]); o.z = pk2(f[4], f[5]); o.w = pk2(f[6], f[7]);
        *(v4u*)(bl + ((size_t)l * NLORA + n) * KLORA + kc * 8) = o;
    }
}
__device__ __forceinline__ void norm_rows(Frame& F, const float* xl, const float* xc, const bool bf, const float* g, const float* modl, int sh_off, int sc_off, int nrows) {
    PHASE_BEGIN(F);
    const int gw = F.vcu * NWAVES + F.wave, NGW = F.G * NWAVES;
    u16* XN = (u16*)(F.ws + WS_XN);
    pg8::f32x4 gv[4];
#pragma unroll
    for (int j = 0; j < 4; ++j) gv[j] = *(const pg8::f32x4*)(g + 4 * F.lane + 256 * j);
    for (int r = gw; r < nrows; r += NGW) {
        const int s = (r < MLAT) ? (r >> 13) : 4;
        const float* xr = (r < MLAT) ? (xl + (size_t)r * D) : (xc + (size_t)(r - MLAT) * D);
        const u16* xl_or_xc16 = (r < MLAT) ? ((const u16*)xl + (size_t)r * D) : ((const u16*)xc + (size_t)(r - MLAT) * D);
        pg8::f32x4 v[4]; float ss = 0.f;
#pragma unroll
        for (int j = 0; j < 4; ++j) {
            if (bf) { const v2u xu = *(const v2u*)((const u16*)xl_or_xc16 + 4 * F.lane + 256 * j); v[j] = (pg8::f32x4){__uint_as_float(xu.x << 16), __uint_as_float(xu.x & 0xffff0000u), __uint_as_float(xu.y << 16), __uint_as_float(xu.y & 0xffff0000u)}; }
            else v[j] = *(const pg8::f32x4*)(xr + 4 * F.lane + 256 * j);
            ss += (v[j][0] * v[j][0] + v[j][1] * v[j][1]) + (v[j][2] * v[j][2] + v[j][3] * v[j][3]); }
        const float rstd = rsqrtf(wave_sum(ss) * (1.0f / D) + RMS_EPS);
        const float* shp = modl + s * NMOD + sh_off; const float* scp = modl + s * NMOD + sc_off;
#pragma unroll
        for (int j = 0; j < 4; ++j) {
            const pg8::f32x4 sh = *(const pg8::f32x4*)(shp + 4 * F.lane + 256 * j), sc = *(const pg8::f32x4*)(scp + 4 * F.lane + 256 * j);
            const pg8::f32x4 y = (v[j] * rstd) * gv[j];
            const pg8::f32x4 h = y * (sc + 1.0f) + sh;
            v2u o; o.x = pk2(h[0], h[1]); o.y = pk2(h[2], h[3]);
            *(v2u*)(XN + (size_t)r * D + 4 * F.lane + 256 * j) = o;
        }
    }
}
__device__ __forceinline__ void conv_branch(Frame& F, const float* cw, int nrows) {
    PHASE_BEGIN(F);
    const int gw = F.vcu * NWAVES + F.wave, NGW = F.G * NWAVES;
    const u16* Pc = (const u16*)(F.ws + WS_PC); u16* A2 = (u16*)(F.ws + WS_XN);
    const int c0 = 8 * F.lane;
    float w0[8], w1[8], w2[8];
    {
#pragma unroll
      for (int j = 0; j < 8; ++j) { w0[j] = cw[c0 + j]; w1[j] = cw[DC + c0 + j]; w2[j] = cw[2 * DC + c0 + j]; } }
    for (int r = gw; r < nrows; r += NGW) {
        int t, len; if (r < MLAT) { t = r & (T - 1); len = T; } else { t = (r - MLAT) & (TC - 1); len = TC; }
        const u16* p = Pc + (size_t)r * 1536 + c0;
        const v4u ucb = *(const v4u*)p, uu = *(const v4u*)(p + 512);
        v4u pu = {0u, 0u, 0u, 0u}, nu = pu;
        if (t > 0) pu = *(const v4u*)(p - 1536 + 512);
        if (t < len - 1) nu = *(const v4u*)(p + 1536 + 512);
        float cb[8], uc[8], up[8], un[8], o[8];
        unpk8_f16(ucb, cb); unpk8_f16(uu, uc); unpk8_f16(pu, up); unpk8_f16(nu, un);
#pragma unroll
        for (int j = 0; j < 8; ++j) o[j] = cb[j] * (w0[j] * up[j] + w1[j] * uc[j] + w2[j] * un[j]);
        v4u w; w.x = pk2(o[0], o[1]); w.y = pk2(o[2], o[3]); w.z = pk2(o[4], o[5]); w.w = pk2(o[6], o[7]);
        *(v4u*)(A2 + (size_t)r * D + c0) = w;
    }
}
__device__ __forceinline__ void rwkv_out(Frame& F, const float* lng, const float* lnb, const float* rkp, int nrows) {
    PHASE_BEGIN(F);
    const int gw = F.vcu * NWAVES + F.wave, NGW = F.G * NWAVES;
    const u16* Y = (const u16*)(F.ws + WS_PC); const u16* Prkv = (const u16*)(F.ws + WS_PRKV); const u16* GATE = (const u16*)(F.ws + WS_GATE);
    u16* A2 = (u16*)(F.ws + WS_XN);
    const int c0 = 8 * F.lane;
    float lg[8], lb[8], rk[8];
#pragma unroll
    for (int j = 0; j < 8; ++j) { lg[j] = lng[c0 + j]; lb[j] = lnb[c0 + j]; rk[j] = rkp[c0 + j]; }
    for (int r = gw; r < nrows; r += NGW) {
        const v4u uy0 = *(const v4u*)(Y + (size_t)r * 1024 + c0), uy1 = *(const v4u*)(Y + (size_t)r * 1024 + 512 + c0);
        const u16* p = Prkv + (size_t)r * 1536 + c0;
        const v4u ur = *(const v4u*)p, uk = *(const v4u*)(p + 512), uv = *(const v4u*)(p + 1024);
        const v4u ug = *(const v4u*)(GATE + (size_t)r * 512 + c0);
        float y0[8], y1[8], rr[8], kk[8], vv[8], gg[8], y[8], o[8];
        unpk8_f16(uy0, y0); unpk8_f16(uy1, y1); unpk8_f16(ur, rr); unpk8_f16(uk, kk); unpk8_f16(uv, vv); unpk8_f16(ug, gg);
        float s = 0.f, bs = 0.f;
#pragma unroll
        for (int j = 0; j < 8; ++j) { y[j] = y0[j] + y1[j]; s += y[j]; bs += rr[j] * kk[j] * rk[j]; }
        const float mu = group8_sum(s) * (1.0f / 64.0f); bs = group8_sum(bs);
        float q = 0.f;
#pragma unroll
        for (int j = 0; j < 8; ++j) { const float dd = y[j] - mu; q += dd * dd; }
        const float rstd = rsqrtf(group8_sum(q) * (1.0f / 64.0f) + GN_EPS);
#pragma unroll
        for (int j = 0; j < 8; ++j) o[j] = (((y[j] - mu) * rstd) * lg[j] + lb[j] + bs * vv[j]) * gg[j];
        v4u w; w.x = pk2(o[0], o[1]); w.y = pk2(o[2], o[3]); w.z = pk2(o[4], o[5]); w.w = pk2(o[6], o[7]);
        *(v4u*)(A2 + (size_t)r * D + 512 + c0) = w;
    }
}
namespace ck {
typedef float f32x16 __attribute__((ext_vector_type(16)));
typedef short bf16x8 __attribute__((ext_vector_type(8)));
constexpr int C = 64, PITCH = 144, SLOT = 64 * PITCH;
constexpr int NCHUNK = (TC + T) / C;
constexpr int NQ = 4, CPQ = NCHUNK / NQ;
static_assert(NCHUNK % NQ == 0, "quarters");
constexpr size_t WS_HZ = WS_ALORA;
constexpr size_t WS_GC = WS_ALORA + 4 * MiB;
static_assert(WS_GC + 256 * 8192 <= WS_DEC, "map");
enum { S_KK = 0, S_KT = 1, S_BT = 2, S_RT = 3, S_KKT = 4, S_KTT = 5, S_BTT = 6, S_VT = 7, S_AKK = 8, S_ARK = 9, S_ARB = 10, S_T = 11, S_TT = 12, S_LB = 13, S_AREA = 14 };
enum { S_X1T = S_KK, S_NW1T = S_KT, S_NU0T = S_BT, S_GIMG = S_KTT, S_PIMG = S_VT };
constexpr int AREA_OFF = S_AREA * SLOT;
constexpr int LP = 64;
constexpr int GC_OFF = AREA_OFF + 16384, SEG_OFF = S_LB * SLOT  , END_OFF = GC_OFF + 256;
static_assert(64 * LP * 4 <= 16384 && END_OFF <= LDSCTL_OFF && 8 * 64 * 4 <= SLOT, "chunk-scan LDS map");
#define CK_BAR() do { asm volatile("s_waitcnt lgkmcnt(0)" ::: "memory"); __builtin_amdgcn_s_barrier(); asm volatile("" ::: "memory"); } while (0)
typedef __bf16 bf2_t __attribute__((ext_vector_type(2)));
__device__ __forceinline__ unsigned cvtpk(float lo, float hi) { bf2_t v; v.x = (__bf16)lo; v.y = (__bf16)hi; return __builtin_bit_cast(unsigned, v); }
__device__ __forceinline__ LAS unsigned char* slot(LAS unsigned char* lds, int s) { return lds + s * SLOT; }
template <int KS> __device__ __forceinline__ void tile_mma(f32x16& acc, const LAS unsigned char* A, int arow0, const LAS unsigned char* B, int brow0, int lane, int kb = 0) {
    const int r = lane & 31, h = lane >> 5;
    const LAS unsigned char* pa = A + (arow0 + r) * PITCH + (kb + 8 * h) * 2; const LAS unsigned char* pb = B + (brow0 + r) * PITCH + (kb + 8 * h) * 2;
#pragma unroll
    for (int s = 0; s < KS; ++s) { const bf16x8 a = *(const LAS bf16x8*)(pa + 32 * s), b = *(const LAS bf16x8*)(pb + 32 * s); acc = __builtin_amdgcn_mfma_f32_32x32x16_bf16(a, b, acc, 0, 0, 0); }
}
__device__ __forceinline__ int acc_row(int i, int lane) { return (i & 3) + 8 * (i >> 2) + 4 * (lane >> 5); }
__device__ __forceinline__ f32x16 zero16() { float z; asm volatile("v_mov_b32 %0, 0" : "=v"(z)); f32x16 r; _Pragma("unroll") for (int i = 0; i < 16; ++i) r[i] = z; return r; }
__device__ __forceinline__ void st_rm(const f32x16& acc, LAS unsigned char* M, int row0, int col0, int lane, float sgn = 1.f) {
#pragma unroll
    for (int i = 0; i < 16; i += 2) {
        const unsigned p = cvtpk(sgn * acc[i], sgn * acc[i + 1]);
        LAS unsigned short* q = (LAS unsigned short*)(M + (row0 + acc_row(i, lane)) * PITCH + (col0 + (lane & 31)) * 2);
        q[0] = (unsigned short)(p & 0xffffu); q[PITCH / 2] = (unsigned short)(p >> 16);
    }
}
__device__ __forceinline__ void st_tr(const f32x16& acc, LAS unsigned char* M, int row0, int col0, int lane, float sgn = 1.f) {
#pragma unroll
    for (int g = 0; g < 4; ++g) {
        v2u w; w.x = cvtpk(sgn * acc[4 * g], sgn * acc[4 * g + 1]); w.y = cvtpk(sgn * acc[4 * g + 2], sgn * acc[4 * g + 3]);
        *(LAS v2u*)(M + (col0 + (lane & 31)) * PITCH + (row0 + 8 * g + 4 * (lane >> 5)) * 2) = w;
    }
}
__device__ __forceinline__ void st_rm_q10(const f32x16& acc, LAS unsigned char* M, int row0, int col0, int lane, float sgn = 1.f) {
    if ((lane & 31) < 16) {
#pragma unroll
        for (int i = 8; i < 16; i += 2) {
            const unsigned p = cvtpk(sgn * acc[i], sgn * acc[i + 1]);
            LAS unsigned short* q = (LAS unsigned short*)(M + (row0 + acc_row(i, lane)) * PITCH + (col0 + (lane & 31)) * 2);
            q[0] = (unsigned short)(p & 0xffffu); q[PITCH / 2] = (unsigned short)(p >> 16);
        }
    }
}
__device__ __forceinline__ void st_tr_q10(const f32x16& acc, LAS unsigned char* M, int row0, int col0, int lane, float sgn = 1.f) {
    if ((lane & 31) < 16) {
#pragma unroll
        for (int g = 2; g < 4; ++g) {
            v2u w; w.x = cvtpk(sgn * acc[4 * g], sgn * acc[4 * g + 1]); w.y = cvtpk(sgn * acc[4 * g + 2], sgn * acc[4 * g + 3]);
            *(LAS v2u*)(M + (col0 + (lane & 31)) * PITCH + (row0 + 8 * g + 4 * (lane >> 5)) * 2) = w;
        }
    }
}
__device__ __forceinline__ void st_img(const f32x16& acc, LAS unsigned char* img, int idx, int lane) {
#pragma unroll
    for (int s = 0; s < 2; ++s) {
        v4u w; w.x = cvtpk(acc[8 * s], acc[8 * s + 1]); w.y = cvtpk(acc[8 * s + 2], acc[8 * s + 3]); w.z = cvtpk(acc[8 * s + 4], acc[8 * s + 5]); w.w = cvtpk(acc[8 * s + 6], acc[8 * s + 7]);
        *(LAS v4u*)(img + ((idx * 2 + s) * 64 + lane) * 16) = w;
    }
}
__device__ __forceinline__ bf16x8 acc_frag(const f32x16& acc, int s) {
    v4u w; w.x = cvtpk(acc[8 * s], acc[8 * s + 1]); w.y = cvtpk(acc[8 * s + 2], acc[8 * s + 3]); w.z = cvtpk(acc[8 * s + 4], acc[8 * s + 5]); w.w = cvtpk(acc[8 * s + 6], acc[8 * s + 7]);
    return __builtin_bit_cast(bf16x8, w);
}
template <int P, int TIX> __device__ __forceinline__ void s1_tile(LAS unsigned char* lds, int lane) {
    constexpr int ti = (TIX == 0) ? 0 : 1, tj = (TIX == 2) ? 1 : 0;
    const LAS unsigned char* A = lds + ((P < 2) ? S_KK : S_RT) * SLOT; const LAS unsigned char* B = lds + ((P & 1) ? S_BT : S_KT) * SLOT;
    f32x16 acc = {};
    tile_mma<4>(acc, A, 32 * ti, B, 32 * tj, lane);
    if (TIX != 1) {
        const int x = (lane & 31) - 4 * (lane >> 5);
#pragma unroll
        for (int i = 0; i < 16; ++i) { const int ci = (i & 3) + 8 * (i >> 2); const bool keep = (P >= 2) ? (x <= ci) : (x < ci); acc[i] = keep ? acc[i] : 0.f; }
    }
    if (P == 1) {
        LAS float* Lf = (LAS float*)(lds + AREA_OFF) + (32 * ti + 4 * (lane >> 5)) * LP + 32 * tj + (lane & 31);
#pragma unroll
        for (int i = 0; i < 16; ++i) Lf[((i & 3) + 8 * (i >> 2)) * LP] = acc[i];
        if (TIX == 1) st_rm(acc, lds + S_LB * SLOT, 32, 0, lane);
        else st_rm_q10(acc, lds + S_LB * SLOT, 32 * ti, 32 * tj, lane);
    } else st_rm(acc, lds + ((P == 0) ? S_AKK : (P == 2) ? S_ARK : S_ARB) * SLOT, 32 * ti, 32 * tj, lane);
}
__device__ __forceinline__ void s3_tile(LAS unsigned char* lds, int q, int lane) {
    const int p = q >> 2, ti = (q >> 1) & 1, tj = q & 1;
    f32x16 acc = {};
    tile_mma<4>(acc, lds + (p ? S_X1T : S_KKT) * SLOT, 32 * ti, lds + S_T * SLOT, 32 * tj, lane);
    st_rm(acc, lds + (p ? S_NU0T : S_NW1T) * SLOT, 32 * ti, 32 * tj, lane, -1.f);
}
struct InRegs { v4u k, r, dec, a, v; };
__device__ __forceinline__ int scan_row(int b, int d, int p) {
    if (p < TC) { const int tc = d ? (TC - 1 - p) : p; return MLAT + b * TC + tc; }
    const int q = p - TC; const int tl = d ? (T - 1 - q) : q; return b * T + tl;
}
__device__ __forceinline__ void load_chunk(Frame& F, InRegs& R, int b, int h, int d, int chunk) {
    const int t = fresh_lane(), cg = F.wave;
    int ch = chunk; if (ch >= NCHUNK) ch = NCHUNK - 1;
    const int row = scan_row(b, d, ch * C + t);
    const u16* Prkv = (const u16*)(F.ws + WS_PRKV) + (size_t)row * 1536 + h * 64 + 8 * cg;
    R.r = *(const v4u*)(Prkv); R.k = *(const v4u*)(Prkv + 512); R.v = *(const v4u*)(Prkv + 1024);
    R.dec = *(const v4u*)((const u16*)(F.ws + WS_DEC) + (size_t)row * 1024 + d * 512 + h * 64 + 8 * cg);
    R.a = *(const v4u*)((const u16*)(F.ws + WS_AA) + (size_t)row * 1024 + d * 512 + h * 64 + 8 * cg);
}
}
__device__ __forceinline__ void scan_phase(Frame& F, const float* kkp, const float* kap) {
    using namespace ck;
    PHASE_BEGIN(F);
    LAS unsigned char* const lds = F.lds;
    const int wave = F.wave; int lane = F.lane, tid = F.tid;
    { unsigned z0; asm volatile("v_mov_b32 %0, 0" : "=v"(z0));
      for (int i = tid; i < 6 * SLOT / 16; i += NWAVES * 64) *(LAS v4u*)(lds + S_AKK * SLOT + i * 16) = (v4u){z0, z0, z0, z0}; }
    CK_BAR();
    for (int unit = F.vcu; unit < 64 * NQ; unit += F.G) {
        const int combo = unit >> 2, qq = unit & 3;
        const int b = combo >> 4, h = (combo >> 1) & 7, d = combo & 1;
        int t_ = lane; const int cg = wave;
        float kkw[8], kaw[8];
#pragma unroll
        for (int j = 0; j < 8; ++j) { kkw[j] = kkp[h * 64 + 8 * cg + j]; kaw[j] = kap[h * 64 + 8 * cg + j]; }
        InRegs R; load_chunk(F, R, b, h, d, qq * CPQ);
        InRegs R2 = R;
        f32x16 H0a = {}, H0b = {};
        if (wave == 2 || wave == 3) {
            const int l2 = fresh_lane();
#pragma unroll
            for (int i = 0; i < 16; ++i) { const float e = (acc_row(i, l2) == (l2 & 31)) ? 1.f : 0.f; if (wave == 2) H0a[i] = e; else H0b[i] = e; }
        }
        unsigned pend[16];
#define CK_YSTORE(cc_) do { const int ly = fresh_lane(); \
              \
            u16* Yg = (wave < 2) ? (u16*)(F.ws + WS_PC) + d * 512 + h * 64 + 32 * wave                         \
                                 : (u16*)(F.ws + WS_DEC) + d * 512 + h * 64 + 32 * (wave - 2);                  \
            const long st_ = d ? -1024 : 1024; \
            Yg += (long)scan_row(b, d, (cc_) * C) * 1024 + st_ * (ly & 31) + 4 * (ly >> 5); \
            _Pragma("unroll") for (int tt_ = 0; tt_ < 2; ++tt_) _Pragma("unroll") for (int g = 0; g < 4; ++g) \
                *(v2u*)(Yg + st_ * 32 * tt_ + 8 * g) = (v2u){pend[8 * tt_ + 2 * g], pend[8 * tt_ + 2 * g + 1]}; } while (0)
        for (int c = qq * CPQ; c < (qq + 1) * CPQ; ++c) {
            lane = fresh_lane(); tid = wave * 64 + lane; t_ = lane;
            if (DUPS & 64) asm volatile("" :: "v"(R2.k), "v"(R2.r), "v"(R2.dec), "v"(R2.a), "v"(R2.v));
            float w[8], a[8], k[8], r[8], v[8];
            unpk8_f16(R.dec, w); unpk8_f16(R.a, a); unpk8_f16(R.k, k); unpk8_f16(R.r, r); unpk8_f16(R.v, v);
            if (wave < 4 && c > qq * CPQ) CK_YSTORE(c - 1);
            typedef float f4 __attribute__((ext_vector_type(4)));
            LAS float* SS = (LAS float*)(lds + AREA_OFF);
            float g[8], gp[8], kk[8], ss = 0.f;
#pragma unroll
            for (int j = 0; j < 8; ++j) {
                float x = w[j];
                x *= dpp1<0x111, 0xF>(x); x *= dpp1<0x112, 0xF>(x); x *= dpp1<0x114, 0xF>(x); x *= dpp1<0x118, 0xF>(x);
                x *= dpp1<0x142, 0xA>(x);
                x *= dpp1<0x143, 0xC>(x);
                g[j] = x; gp[j] = dpp1<0x138, 0xF>(x);
                kk[j] = k[j] * kkw[j]; ss += kk[j] * kk[j];
            }
            SS[cg * 64 + t_] = ss;
            if (t_ == 63) { *(LAS f4*)((LAS float*)(lds + GC_OFF) + 8 * cg) = (f4){g[0], g[1], g[2], g[3]}; *(LAS f4*)((LAS float*)(lds + GC_OFF) + 8 * cg + 4) = (f4){g[4], g[5], g[6], g[7]}; }
            CK_BAR();
#pragma unroll 1
            for (int rp_ = 0; rp_ < ((DUPS & 2) ? 2 : 1); ++rp_) {
                float tot = 0.f;
#pragma unroll
                for (int q = 0; q < 8; ++q) tot += SS[q * 64 + t_];
                const float rn = rsqrtf(fmaxf(tot, 1e-24f));
                float Kk[8], Kt[8], Bt[8], Rt[8];
#pragma unroll
                for (int j = 0; j < 8; ++j) { const float kn = kk[j] * rn, rg = __builtin_amdgcn_rcpf(g[j]);
                    Kk[j] = kn * gp[j]; Kt[j] = (k[j] * (1.0f + (a[j] - 1.0f) * kaw[j])) * rg; Bt[j] = (kn * a[j]) * rg; Rt[j] = r[j] * g[j]; }
                const int ro = t_ * PITCH + 16 * cg;
                *(LAS v4u*)(lds + S_KK * SLOT + ro) = (v4u){cvtpk(Kk[0], Kk[1]), cvtpk(Kk[2], Kk[3]), cvtpk(Kk[4], Kk[5]), cvtpk(Kk[6], Kk[7])};
                *(LAS v4u*)(lds + S_KT * SLOT + ro) = (v4u){cvtpk(Kt[0], Kt[1]), cvtpk(Kt[2], Kt[3]), cvtpk(Kt[4], Kt[5]), cvtpk(Kt[6], Kt[7])};
                *(LAS v4u*)(lds + S_BT * SLOT + ro) = (v4u){cvtpk(Bt[0], Bt[1]), cvtpk(Bt[2], Bt[3]), cvtpk(Bt[4], Bt[5]), cvtpk(Bt[6], Bt[7])};
                *(LAS v4u*)(lds + S_RT * SLOT + ro) = (v4u){cvtpk(Rt[0], Rt[1]), cvtpk(Rt[2], Rt[3]), cvtpk(Rt[4], Rt[5]), cvtpk(Rt[6], Rt[7])};
#pragma unroll
                for (int j = 0; j < 8; j += 2) {
                    const unsigned pk = cvtpk(Kk[j], Kk[j + 1]), pt = cvtpk(Kt[j], Kt[j + 1]), pb = cvtpk(Bt[j], Bt[j + 1]), pv = cvtpk(v[j], v[j + 1]);
                    const int to = (8 * cg + j) * PITCH + 2 * t_;
                    *(LAS unsigned short*)(lds + S_KKT * SLOT + to) = (unsigned short)(pk & 0xffffu); *(LAS unsigned short*)(lds + S_KKT * SLOT + to + PITCH) = (unsigned short)(pk >> 16);
                    *(LAS unsigned short*)(lds + S_KTT * SLOT + to) = (unsigned short)(pt & 0xffffu); *(LAS unsigned short*)(lds + S_KTT * SLOT + to + PITCH) = (unsigned short)(pt >> 16);
                    *(LAS unsigned short*)(lds + S_BTT * SLOT + to) = (unsigned short)(pb & 0xffffu); *(LAS unsigned short*)(lds + S_BTT * SLOT + to + PITCH) = (unsigned short)(pb >> 16);
                    *(LAS unsigned short*)(lds + S_VT * SLOT + to) = (unsigned short)(pv & 0xffffu);  *(LAS unsigned short*)(lds + S_VT * SLOT + to + PITCH) = (unsigned short)(pv >> 16);
                }
            }
            CK_BAR();
            lane = fresh_lane();
            f32x16 accN0 = {}, accN1 = {}, accY0 = {}, accY1 = {};
            if (wave < 2) {
                const int vt = wave;
                tile_mma<4>(accN0, lds + S_KTT * SLOT, 0, lds + S_VT * SLOT, 32 * vt, lane);
                tile_mma<4>(accN1, lds + S_KTT * SLOT, 32, lds + S_VT * SLOT, 32 * vt, lane);
                CK_BAR();
                load_chunk(F, R, b, h, d, c + 1);
                if (DUPS & 64) load_chunk(F, R2, b, h, d, c + 1);
                tile_mma<4>(accY0, lds + S_VT * SLOT, 32 * vt, lds + S_ARK * SLOT, 0, lane);
                tile_mma<4>(accY1, lds + S_VT * SLOT, 32 * vt, lds + S_ARK * SLOT, 32, lane);
                CK_BAR();
                s3_tile(lds, wave, lane);
                CK_BAR();
                tile_mma<4>(accN0, lds + S_BTT * SLOT, 0, lds + S_NU0T * SLOT, 32 * vt, lane);
                tile_mma<4>(accN1, lds + S_BTT * SLOT, 32, lds + S_NU0T * SLOT, 32 * vt, lane);
                tile_mma<4>(accY0, lds + S_NU0T * SLOT, 32 * vt, lds + S_ARB * SLOT, 0, lane);
                tile_mma<4>(accY1, lds + S_NU0T * SLOT, 32 * vt, lds + S_ARB * SLOT, 32, lane);
                { const LAS float* gcp = (const LAS float*)(lds + GC_OFF);
#pragma unroll
                  for (int i = 0; i < 16; ++i) { accN0[i] *= gcp[acc_row(i, lane)]; accN1[i] *= gcp[32 + acc_row(i, lane)]; } }
                CK_BAR();
            } else {
                const int wi = wave - 2;
                switch (wi) {
                    case 0: s1_tile<0, 0>(lds, lane); s1_tile<2, 0>(lds, lane); break;
                    case 1: s1_tile<0, 1>(lds, lane); s1_tile<2, 1>(lds, lane); break;
                    case 2: s1_tile<0, 2>(lds, lane); s1_tile<2, 2>(lds, lane); break;
                    case 3: s1_tile<1, 0>(lds, lane); s1_tile<3, 0>(lds, lane); break;
                    case 4: s1_tile<1, 1>(lds, lane); s1_tile<3, 1>(lds, lane); break;
                    default: s1_tile<1, 2>(lds, lane); s1_tile<3, 2>(lds, lane); break;
                }
                CK_BAR();
                if (wave != 7) { load_chunk(F, R, b, h, d, c + 1); if (DUPS & 64) load_chunk(F, R2, b, h, d, c + 1); }
#pragma unroll 1
                for (int rp_ = 0; rp_ < ((DUPS & 8) ? 2 : 1); ++rp_)
                if (wave == 7) {
                    const int l7 = fresh_lane();
                    const int bq = l7 >> 4, j = l7 & 15;
                    const LAS float* Lf = (const LAS float*)(lds + AREA_OFF) + (16 * bq) * LP + 16 * bq;
                    float Tb[16];
#pragma unroll
                    for (int t4 = 0; t4 < 16; t4 += 4) {
                        f4 lr[4][4];
#pragma unroll
                        for (int u = 0; u < 4; ++u)
#pragma unroll
                            for (int m4 = 0; m4 < (t4 + u + 3) / 4; ++m4) lr[u][m4] = *(const LAS f4*)(Lf + (t4 + u) * LP + 4 * m4);
#pragma unroll
                        for (int u = 0; u < 4; ++u) {
                            const int t = t4 + u;
                            float acc = (j == t) ? 1.f : 0.f;
#pragma unroll
                            for (int m4 = 0; m4 < (t + 3) / 4; ++m4)
#pragma unroll
                                for (int e = 0; e < 4; ++e) if (4 * m4 + e < t) acc -= lr[u][m4][e] * Tb[4 * m4 + e];
                            asm volatile("" : "+v"(acc));
                            Tb[t] = acc;
                        }
                        asm volatile("" ::: "memory");
                    }
#pragma unroll
                    for (int t = 0; t < 16; t += 2) { const unsigned p = cvtpk(Tb[t], Tb[t + 1]);
                        LAS unsigned short* q = (LAS unsigned short*)(lds + S_T * SLOT + (16 * bq + t) * PITCH + (16 * bq + j) * 2); q[0] = (unsigned short)(p & 0xffffu); q[PITCH / 2] = (unsigned short)(p >> 16); }
#pragma unroll
                    for (int t8 = 0; t8 < 2; ++t8) *(LAS v4u*)(lds + S_TT * SLOT + (16 * bq + j) * PITCH + (16 * bq + 8 * t8) * 2) =
                        (v4u){cvtpk(Tb[8 * t8], Tb[8 * t8 + 1]), cvtpk(Tb[8 * t8 + 2], Tb[8 * t8 + 3]), cvtpk(Tb[8 * t8 + 4], Tb[8 * t8 + 5]), cvtpk(Tb[8 * t8 + 6], Tb[8 * t8 + 7])};
                    asm volatile("s_waitcnt lgkmcnt(0)" ::: "memory");
#pragma unroll
                    for (int B = 0; B < 2; ++B) {
                        f32x16 z1 = {};
                        tile_mma<1>(z1, lds + S_LB * SLOT, 32 * B, lds + S_TT * SLOT, 32 * B, lane, 32 * B);
                        st_tr_q10(z1, lds + S_TT * SLOT, 32 * B, 32 * B, lane);
                        asm volatile("s_waitcnt lgkmcnt(0)" ::: "memory");
                        f32x16 x = {};
                        tile_mma<1>(x, lds + S_T * SLOT, 32 * B, lds + S_TT * SLOT, 32 * B, lane, 32 * B + 16);
                        st_rm_q10(x, lds + S_T * SLOT, 32 * B, 32 * B, lane, -1.f);
                        if (B == 0) st_tr_q10(x, lds + S_TT * SLOT, 0, 0, lane, -1.f);
                    }
                    asm volatile("s_waitcnt lgkmcnt(0)" ::: "memory");
                    f32x16 z = {};
                    tile_mma<2>(z, lds + S_LB * SLOT, 32, lds + S_TT * SLOT, 0, lane, 0);
                    st_tr(z, lds + S_TT * SLOT, 32, 0, lane);
                    asm volatile("s_waitcnt lgkmcnt(0)" ::: "memory");
                    f32x16 tba = {};
                    tile_mma<2>(tba, lds + S_T * SLOT, 32, lds + S_TT * SLOT, 0, lane, 32);
                    st_rm(tba, lds + S_T * SLOT, 32, 0, lane, -1.f);
                } else if (wave < 6) {
                    const int vi = (wave - 2) >> 1, tj = (wave - 2) & 1;
                    f32x16 acc = {};
                    tile_mma<4>(acc, lds + S_VT * SLOT, 32 * vi, lds + S_AKK * SLOT, 32 * tj, lane);
                    st_rm(acc, lds + S_X1T * SLOT, 32 * vi, 32 * tj, lane);
                }
                CK_BAR();
                if (wave == 7) { load_chunk(F, R, b, h, d, c + 1); if (DUPS & 64) load_chunk(F, R2, b, h, d, c + 1); }
                s3_tile(lds, wave, lane);
                CK_BAR();
#pragma unroll 1
                for (int rp_ = 0; rp_ < ((DUPS & 32) ? 2 : 1); ++rp_)
                for (int q = wi; q < 8; q += 6) {
                    const int isphi = q >> 2, to = (q >> 1) & 1, tn = q & 1;
                    f32x16 acc = {};
                    if (isphi) {
#pragma unroll
                        for (int g = 0; g < 4; ++g) { const v2u u = *(const LAS v2u*)(lds + S_RT * SLOT + (32 * tn + (lane & 31)) * PITCH + (32 * to + 8 * g + 4 * (lane >> 5)) * 2);
                            acc[4 * g] = __uint_as_float(u.x << 16); acc[4 * g + 1] = __uint_as_float(u.x & 0xffff0000u); acc[4 * g + 2] = __uint_as_float(u.y << 16); acc[4 * g + 3] = __uint_as_float(u.y & 0xffff0000u); }
                        tile_mma<4>(acc, lds + S_NW1T * SLOT, 32 * to, lds + S_ARB * SLOT, 32 * tn, lane);
                        st_img(acc, lds + S_PIMG * SLOT, tn * 2 + to, lane);
                    } else {
                        tile_mma<4>(acc, lds + S_NW1T * SLOT, 32 * to, lds + S_BTT * SLOT, 32 * tn, lane);
                        const float gc = ((const LAS float*)(lds + GC_OFF))[32 * tn + (lane & 31)];
#pragma unroll
                        for (int i = 0; i < 16; ++i) { float x = acc[i]; if (to == tn && acc_row(i, lane) == (lane & 31)) x += 1.f; acc[i] = x * gc; }
                        st_img(acc, lds + S_GIMG * SLOT, tn * 2 + to, lane);
                    }
                }
                CK_BAR();
            }
            if (wave < 4) {
                lane = fresh_lane();
                bf16x8 hf[4]; hf[0] = acc_frag(H0a, 0); hf[1] = acc_frag(H0a, 1); hf[2] = acc_frag(H0b, 0); hf[3] = acc_frag(H0b, 1);
#pragma unroll
                for (int ks = 0; ks < 4; ++ks) {
                    const int to = ks >> 1, s2 = ks & 1;
                    const bf16x8 g0 = *(const LAS bf16x8*)(lds + S_GIMG * SLOT + (((0 * 2 + to) * 2 + s2) * 64 + lane) * 16), g1 = *(const LAS bf16x8*)(lds + S_GIMG * SLOT + (((1 * 2 + to) * 2 + s2) * 64 + lane) * 16);
                    const bf16x8 p0 = *(const LAS bf16x8*)(lds + S_PIMG * SLOT + (((0 * 2 + to) * 2 + s2) * 64 + lane) * 16), p1 = *(const LAS bf16x8*)(lds + S_PIMG * SLOT + (((1 * 2 + to) * 2 + s2) * 64 + lane) * 16);
                    accN0 = __builtin_amdgcn_mfma_f32_32x32x16_bf16(g0, hf[ks], accN0, 0, 0, 0); accN1 = __builtin_amdgcn_mfma_f32_32x32x16_bf16(g1, hf[ks], accN1, 0, 0, 0);
                    accY0 = __builtin_amdgcn_mfma_f32_32x32x16_bf16(hf[ks], p0, accY0, 0, 0, 0); accY1 = __builtin_amdgcn_mfma_f32_32x32x16_bf16(hf[ks], p1, accY1, 0, 0, 0);
                }
                H0a = accN0; H0b = accN1;
                if (wave >= 2) {
#pragma unroll
                    for (int q = 0; q < 8; ++q) { pend[q] = cvtpk(accY0[2 * q], accY0[2 * q + 1]); pend[8 + q] = cvtpk(accY1[2 * q], accY1[2 * q + 1]); }
                } else {
#pragma unroll
                    for (int q = 0; q < 8; ++q) { pend[q] = pk_f16(accY0[2 * q], accY0[2 * q + 1]); pend[8 + q] = pk_f16(accY1[2 * q], accY1[2 * q + 1]); }
                }
            }
        }
        if (wave < 4) CK_YSTORE((qq + 1) * CPQ - 1);
#undef CK_YSTORE
        if (wave < 2) {
            const int l3 = fresh_lane();
            float* hz = (float*)(F.ws + WS_HZ) + (size_t)(unit * 2 + wave) * 2048 + l3;
#pragma unroll
            for (int i = 0; i < 16; ++i) { hz[i * 64] = H0a[i]; hz[1024 + i * 64] = H0b[i]; }
        } else if (wave < 4) {
            const int l3 = fresh_lane();
            u16* gq = (u16*)(F.ws + WS_GC) + (size_t)unit * 4096 + 32 * (wave - 2) + (l3 & 31);
#pragma unroll
            for (int i = 0; i < 16; i += 2) {
                const unsigned pa = cvtpk(H0a[i], H0a[i + 1]), pb = cvtpk(H0b[i], H0b[i + 1]);
                const int r0 = acc_row(i, l3);
                gq[r0 * 64] = (u16)(pa & 0xffffu); gq[(r0 + 1) * 64] = (u16)(pa >> 16); gq[(32 + r0) * 64] = (u16)(pb & 0xffffu); gq[(33 + r0) * 64] = (u16)(pb >> 16);
            }
        }
        CK_BAR();
    }
}
__device__ __forceinline__ void scan_fix(Frame& F) {
    using namespace ck;
    PHASE_BEGIN(F);
    LAS unsigned char* const lds = F.lds;
    const int wave = F.wave;
    enum { X_G1 = 0, X_G2 = 1, X_S1T = 2, X_S2T = 3, X_S3T = 4 };
    for (int unit = F.vcu; unit < 64 * NQ; unit += F.G) {
        const int combo = unit >> 2, j = unit & 3;
        const int b = combo >> 4, h = (combo >> 1) & 7, d = combo & 1;
        int lane = fresh_lane(); const int tid = wave * 64 + lane;
#pragma unroll
        for (int i = 0; i < 2; ++i) {
            const int p = tid + 512 * i, mat = p >> 9, row = (p >> 3) & 63, cg = p & 7;
            const v4u x = *(const v4u*)((const u16*)(F.ws + WS_GC) + (size_t)(combo * 4 + 1 + mat) * 4096 + row * 64 + 8 * cg);
            *(LAS v4u*)(lds + (X_G1 + mat) * SLOT + row * PITCH + 16 * cg) = x;
        }
        const int kt = (wave >> 1) & 1, vt = wave & 1;
        if (wave < 4) {
            const float* hz = (const float*)(F.ws + WS_HZ) + (size_t)((combo * 4 + 0) * 2 + vt) * 2048 + kt * 1024 + lane;
            f32x16 acc;
#pragma unroll
            for (int i = 0; i < 16; ++i) acc[i] = hz[i * 64];
            st_tr(acc, lds + X_S1T * SLOT, 32 * kt, 32 * vt, lane);
        }
        CK_BAR();
#pragma unroll 1
        for (int q = 1; q < 3; ++q) {
            if (wave < 4) {
                lane = fresh_lane();
                const float* hz = (const float*)(F.ws + WS_HZ) + (size_t)((combo * 4 + q) * 2 + vt) * 2048 + kt * 1024 + lane;
                f32x16 acc;
#pragma unroll
                for (int i = 0; i < 16; ++i) acc[i] = hz[i * 64];
                tile_mma<4>(acc, lds + (X_G1 + q - 1) * SLOT, 32 * kt, lds + (X_S1T + q - 1) * SLOT, 32 * vt, lane);
                st_tr(acc, lds + (X_S1T + q) * SLOT, 32 * kt, 32 * vt, lane);
            }
            CK_BAR();
        }
        lane = fresh_lane();
        const int hw = wave >> 2, tt = (wave >> 1) & 1, vt2 = wave & 1, r = lane & 31, h5 = lane >> 5;
#define FX_LOAD(cc_, BO_, YO_) do { const int row_ = scan_row(b, d, (cc_) * C + 32 * tt + r); \
            const u16* om_ = (const u16*)(F.ws + WS_DEC) + (size_t)row_ * 1024 + d * 512 + h * 64 + 8 * h5; \
            _Pragma("unroll") for (int s = 0; s < 4; ++s) BO_[s] = __builtin_bit_cast(bf16x8, *(const v4u*)(om_ + 16 * s)); \
            const u16* yq_ = (const u16*)(F.ws + WS_PC) + (size_t)row_ * 1024 + d * 512 + h * 64 + 32 * vt2 + 4 * h5; \
            _Pragma("unroll") for (int g = 0; g < 4; ++g) YO_[g] = *(const v2u*)(yq_ + 8 * g); } while (0)
        bf16x8 bo[4], bn[4]; v2u yo[4], yn[4];
        int c = CPQ + j + 4 * hw;
        if (c < NCHUNK) FX_LOAD(c, bo, yo);
#pragma unroll 1
        for (; c < NCHUNK; c += 8) {
            const int q = c / CPQ;
            if (c + 8 < NCHUNK) FX_LOAD(c + 8, bn, yn);
            const int row = scan_row(b, d, c * C + 32 * tt + r);
            u16* yp = (u16*)(F.ws + WS_PC) + (size_t)row * 1024 + d * 512 + h * 64 + 32 * vt2 + 4 * h5;
            f32x16 acc = {};
            const LAS unsigned char* pa = lds + (X_S1T + q - 1) * SLOT + (32 * vt2 + r) * PITCH + 16 * h5;
#pragma unroll
            for (int s = 0; s < 4; ++s) { const bf16x8 a = *(const LAS bf16x8*)(pa + 32 * s); acc = __builtin_amdgcn_mfma_f32_32x32x16_bf16(a, bo[s], acc, 0, 0, 0); }
#pragma unroll
            for (int g = 0; g < 4; ++g) {
                float y0, y1, y2, y3; unpk_f16(yo[g].x, y0, y1); unpk_f16(yo[g].y, y2, y3);
                v2u w; w.x = pk_f16(y0 + acc[4 * g], y1 + acc[4 * g + 1]); w.y = pk_f16(y2 + acc[4 * g + 2], y3 + acc[4 * g + 3]);
                *(v2u*)(yp + 8 * g) = w;
            }
#pragma unroll
            for (int s = 0; s < 4; ++s) { bo[s] = bn[s]; yo[s] = yn[s]; }
        }
#undef FX_LOAD
        CK_BAR();
    }
}
constexpr int CV_R = 16;
__device__ __forceinline__ void ffn_conv(Frame& F, const float* cw, const float* cb, const bool with_ctx, const bool dry = false, const bool only_ctx = false) {
    PHASE_BEGIN(F);
    const int gw = F.vcu * NWAVES + F.wave, NGW = F.G * NWAVES;
    const u16* G = (const u16*)(F.ws + WS_GATEB); u16* V = (u16*)(F.ws + WS_VALB);
    constexpr int NLATI = NB * (128 / CV_R) * 6 * 64;
    const int nitem = NLATI + (with_ctx ? NB * 6 * TC : 0);
    for (int it = gw + (only_ctx ? NLATI : 0); it < nitem; it += NGW) {
        int gc, slice, r_lo, r_hi, nrow, ncol, rowbase;
        if (it < NLATI) { gc = it & 63; int t = it >> 6; slice = t % 6; t /= 6; const int seg = t % (128 / CV_R); const int b = t / (128 / CV_R); r_lo = seg * CV_R; r_hi = r_lo + CV_R; nrow = 128; ncol = 64; rowbase = b * T; }
        else { int t = it - NLATI; gc = t & (TC - 1); t >>= 8; slice = t % 6; const int b = t / 6; r_lo = 0; r_hi = 1; nrow = 1; ncol = TC; rowbase = MLAT + b * TC; }
        const int ch = slice * 64 + F.lane;
        if (ch >= FF / 8) continue;
        const int c0 = 8 * ch;
        typedef __fp16 hh2 __attribute__((ext_vector_type(2)));
        hh2 wt[9][4], bias[4];
#pragma unroll
        for (int q = 0; q < 9; ++q) { const pg8::f32x4 a = *(const pg8::f32x4*)(cw + (size_t)q * FF + c0), b4 = *(const pg8::f32x4*)(cw + (size_t)q * FF + c0 + 4);
            wt[q][0] = __builtin_amdgcn_cvt_pkrtz(a[0], a[1]); wt[q][1] = __builtin_amdgcn_cvt_pkrtz(a[2], a[3]); wt[q][2] = __builtin_amdgcn_cvt_pkrtz(b4[0], b4[1]); wt[q][3] = __builtin_amdgcn_cvt_pkrtz(b4[2], b4[3]); }
        { const pg8::f32x4 a = *(const pg8::f32x4*)(cb + c0), b4 = *(const pg8::f32x4*)(cb + c0 + 4);
          bias[0] = __builtin_amdgcn_cvt_pkrtz(a[0], a[1]); bias[1] = __builtin_amdgcn_cvt_pkrtz(a[2], a[3]); bias[2] = __builtin_amdgcn_cvt_pkrtz(b4[0], b4[1]); bias[3] = __builtin_amdgcn_cvt_pkrtz(b4[2], b4[3]); }
        const bool hasL = gc > 0, hasR = gc + 1 < ncol;
        hh2 P[4], Q[4];
#pragma unroll
        for (int e = 0; e < 4; ++e) { P[e] = (hh2){(__fp16)0.f, (__fp16)0.f}; Q[e] = bias[e]; }
#define CV_LOAD(rr_, L_, M_, R_, V_) do { const int rr = (rr_); L_ = (v4u){0u, 0u, 0u, 0u}; M_ = L_; R_ = L_; \
            if (rr >= 0 && rr <= r_hi && rr < nrow) { const u16* p_ = G + (size_t)(rowbase + rr * ncol + gc) * FF + c0; M_ = *(const v4u*)p_; if (hasL) L_ = *(const v4u*)(p_ - FF); if (hasR) R_ = *(const v4u*)(p_ + FF); } \
            if (rr - 1 >= r_lo && rr - 1 < r_hi) V_ = *(const v4u*)(V + (size_t)(rowbase + (rr - 1) * ncol + gc) * FF + c0); } while (0)
        v4u l0, m0, r0, v0 = {0u, 0u, 0u, 0u}, l1, m1, r1, v1 = v0, l2, m2, r2, v2 = v0;
        CV_LOAD(r_lo - 1, l0, m0, r0, v0); CV_LOAD(r_lo, l1, m1, r1, v1);
        for (int rho = r_lo - 1; rho <= r_hi; ++rho) {
            CV_LOAD(rho + 2, l2, m2, r2, v2);
            const unsigned la[4] = {l0.x, l0.y, l0.z, l0.w}, ma[4] = {m0.x, m0.y, m0.z, m0.w}, ra[4] = {r0.x, r0.y, r0.z, r0.w};
            hh2 N[4];
#pragma unroll
            for (int e = 0; e < 4; ++e) {
                const hh2 a = __builtin_bit_cast(hh2, la[e]), m = __builtin_bit_cast(hh2, ma[e]), c = __builtin_bit_cast(hh2, ra[e]);
                P[e] = P[e] + wt[6][e] * a + wt[7][e] * m + wt[8][e] * c;
                Q[e] = Q[e] + wt[3][e] * a + wt[4][e] * m + wt[5][e] * c;
                N[e] = bias[e] + wt[0][e] * a + wt[1][e] * m + wt[2][e] * c;
            }
            if (rho - 1 >= r_lo) {
                float v[8], o[8], p[8]; unpk8_f16(v0, v);
#pragma unroll
                for (int e = 0; e < 4; ++e) { p[2 * e] = (float)P[e].x; p[2 * e + 1] = (float)P[e].y; }
#pragma unroll
                for (int e = 0; e < 8; ++e) o[e] = siluf_(p[e]) * v[e];
                v4u w; w.x = pk2(o[0], o[1]); w.y = pk2(o[2], o[3]); w.z = pk2(o[4], o[5]); w.w = pk2(o[6], o[7]);
                if (!dry) ST_NT3((v4u*)(V + (size_t)(rowbase + (rho - 1) * ncol + gc) * FF + c0), w); else asm volatile("" :: "v"(w));
            }
#pragma unroll
            for (int e = 0; e < 4; ++e) { P[e] = Q[e]; Q[e] = N[e]; }
            l0 = l1; m0 = m1; r0 = r1; v0 = v1; l1 = l2; m1 = m2; r1 = r2; v1 = v2;
        }
#undef CV_LOAD
    }
}
__device__ __forceinline__ void final_norm(Frame& F, const float* fg) {
    PHASE_BEGIN(F);
    const int gw = F.vcu * NWAVES + F.wave, NGW = F.G * NWAVES;
    pg8::f32x4 gv[4];
#pragma unroll
    for (int j = 0; j < 4; ++j) gv[j] = *(const pg8::f32x4*)(fg + 4 * F.lane + 256 * j);
    for (int r = gw; r < MLAT; r += NGW) {
        float* xr = F.out + (size_t)r * D;
        const u16* xs = (const u16*)(F.ws + WS_XN) + (size_t)r * D;
        pg8::f32x4 v[4]; float ss = 0.f;
#pragma unroll
        for (int j = 0; j < 4; ++j) { const v2u xu = *(const v2u*)(xs + 4 * F.lane + 256 * j);
            v[j] = (pg8::f32x4){__uint_as_float(xu.x << 16), __uint_as_float(xu.x & 0xffff0000u), __uint_as_float(xu.y << 16), __uint_as_float(xu.y & 0xffff0000u)};
            ss += (v[j][0] * v[j][0] + v[j][1] * v[j][1]) + (v[j][2] * v[j][2] + v[j][3] * v[j][3]); }
        const float rstd = rsqrtf(wave_sum(ss) * (1.0f / D) + RMS_EPS);
#pragma unroll
        for (int j = 0; j < 4; ++j) { const pg8::f32x4 o = (v[j] * rstd) * gv[j];
#ifdef NT_FINAL
            __builtin_nontemporal_store(o, (pg8::f32x4*)(xr + 4 * F.lane + 256 * j));
#else
            *(pg8::f32x4*)(xr + 4 * F.lane + 256 * j) = o;
#endif
        }
    }
}

struct Args;

#ifndef CVP
#define CVP 0
#endif
#ifndef CV_AUX
#define CV_AUX 0
#endif
struct OneUnit {
    pg8::Unit u;
    __device__ bool next(int i, pg8::Unit& o) const { if (i > 0) return false; o = u; return true; }
    __device__ __forceinline__ void a_ready(const pg8::Unit&) const {}
    __device__ __forceinline__ void done(const pg8::Unit&) const {}
};
struct EpiConv {
    static constexpr bool PERM = true, AFTER_DRAIN = true;
    EpiArgs a;
    __device__ __forceinline__ void operator()(const pg8::f32x4 (&)[2][2][4][2], const pg8::Unit&, int, int, int, int) const {}
    __device__ __forceinline__ void fused(const pg8::f32x4 (&acc)[2][2][4][2], const pg8::Unit& u, int wr, int wc, int, int, LAS unsigned char* lds, int wid, int) const {
        using pg8::f32x4;
        typedef __fp16 hh2 __attribute__((ext_vector_type(2)));
        const int l_ = fresh_lane(), fr = l_ & 15, fq = l_ >> 4;
        unsigned char* const ws_ = a.ws;
        const int row0 = u.pm * 256 + wr * 64 + fr;
        const bool ctx = u.pm >= MLAT / 256;
        const int bt = u.pm >> 5, gy0 = (u.pm & 31) * 4;
        const u16* const G = (const u16*)(ws_ + WS_GATEB);
        const float* const cw = inp(*a.ap, IN_FCW) + (size_t)a.l * 9 * FF;
        const float* const cb = inp(*a.ap, IN_FCB) + (size_t)a.l * FF;
        const int q16 = wc * 4 + fq;
#pragma unroll
        for (int bj = 0; bj < 2; ++bj) {
            const int cbase = u.pn * 256 + bj * 128;
#pragma unroll 1
            for (int rs_ = 0; rs_ < ((CVP & 1) ? 2 : 1); ++rs_)
#pragma unroll 1
            for (int i = wid; i < 96; i += NWAVES) {
                const int rowi = i * 4 + fq, sg = i >> 4, gy = gy0 - 1 + sg, gx = rowi & 63;
                const int chunk = fr ^ (rowi & 15);
                const bool have = ctx ? (sg >= 1 && sg <= 4) : (gy >= 0 && gy < 128);
                const int srow = ctx ? (MLAT + (u.pm - MLAT / 256) * TC + (sg - 1) * 64 + gx) : (bt * T + gy * 64 + gx);
                if (have)
                    __builtin_amdgcn_global_load_lds((const unsigned*)(G + (size_t)srow * FF + cbase + chunk * 8), (LAS unsigned*)(lds + 256 + i * 1024), 16, 0, CV_AUX);
            }
            const int c0 = cbase + q16 * 8;
            hh2 wt[9][4], bias[4];
#pragma unroll
            for (int q = 0; q < 9; ++q) { const f32x4 x = *(const f32x4*)(cw + (size_t)q * FF + c0), y = *(const f32x4*)(cw + (size_t)q * FF + c0 + 4);
                wt[q][0] = __builtin_amdgcn_cvt_pkrtz(x[0], x[1]); wt[q][1] = __builtin_amdgcn_cvt_pkrtz(x[2], x[3]); wt[q][2] = __builtin_amdgcn_cvt_pkrtz(y[0], y[1]); wt[q][3] = __builtin_amdgcn_cvt_pkrtz(y[2], y[3]); }
            { const f32x4 x = *(const f32x4*)(cb + c0), y = *(const f32x4*)(cb + c0 + 4);
              bias[0] = __builtin_amdgcn_cvt_pkrtz(x[0], x[1]); bias[1] = __builtin_amdgcn_cvt_pkrtz(x[2], x[3]); bias[2] = __builtin_amdgcn_cvt_pkrtz(y[0], y[1]); bias[3] = __builtin_amdgcn_cvt_pkrtz(y[2], y[3]); }
            const LAS unsigned char* bp[2][3];
#pragma unroll
            for (int dx = 0; dx < 3; ++dx) {
                const int sw = (q16 ^ ((fr + dx - 1) & 15)) << 4;
                bp[0][dx] = lds + 256 + (wr * 64 + fr + dx - 1) * 256 + sw; bp[1][dx] = bp[0][dx] + 2 * 64 * 256;
            }
            const unsigned mLa[2] = {(fr == 0 && (!ctx || wr == 0)) ? 0u : 0xffffffffu, (fr == 0 && !ctx) ? 0u : 0xffffffffu};
            const unsigned mRa[2] = {(fr == 15 && !ctx) ? 0u : 0xffffffffu, (fr == 15 && (!ctx || wr == 1)) ? 0u : 0xffffffffu};
            asm volatile("s_waitcnt vmcnt(0)" ::: "memory");
            __builtin_amdgcn_s_barrier();
            asm volatile("" ::: "memory");
#pragma unroll 1
            for (int rc_ = 0; rc_ < ((CVP & 2) ? 2 : 1); ++rc_)
#pragma unroll
            for (int ai = 0; ai < 2; ++ai)
#pragma unroll
                for (int m = 0; m < 4; ++m) {
                    hh2 P[4] = {bias[0], bias[1], bias[2], bias[3]};
#pragma unroll
                    for (int dy = 0; dy < 3; ++dy) {
                        const int gy = gy0 + wr + 2 * ai + dy - 1;
                        if (ctx ? (dy == 1) : (gy >= 0 && gy < 128)) {
#pragma unroll
                            for (int dx = 0; dx < 3; ++dx) {
                                v4u tp = *(const LAS v4u*)(bp[ai][dx] + (dy * 64 + 16 * m) * 256);
                                if (m == 0 && dx == 0) { const unsigned mk = mLa[ai]; tp.x &= mk; tp.y &= mk; tp.z &= mk; tp.w &= mk; }
                                if (m == 3 && dx == 2) { const unsigned mk = mRa[ai]; tp.x &= mk; tp.y &= mk; tp.z &= mk; tp.w &= mk; }
                                const unsigned ta[4] = {tp.x, tp.y, tp.z, tp.w};
#pragma unroll
                                for (int e = 0; e < 4; ++e) P[e] = P[e] + wt[3 * dy + dx][e] * __builtin_bit_cast(hh2, ta[e]);
                            }
                        }
                    }
                    const f32x4 v0 = acc[ai][bj][m][0], v1 = acc[ai][bj][m][1];
                    const float vv[8] = {v0[0], v0[1], v0[2], v0[3], v1[0], v1[1], v1[2], v1[3]};
                    float o[8];
#pragma unroll
                    for (int e = 0; e < 4; ++e) { o[2 * e] = siluf_((float)P[e].x) * vv[2 * e]; o[2 * e + 1] = siluf_((float)P[e].y) * vv[2 * e + 1]; }
                    v4u w; w.x = pk2(o[0], o[1]); w.y = pk2(o[2], o[3]); w.z = pk2(o[4], o[5]); w.w = pk2(o[6], o[7]);
#ifdef NT_A3
                    __builtin_nontemporal_store(w, (v4u*)((u16*)(ws_ + WS_VALB) + (size_t)(row0 + ai * 128 + m * 16) * FF + c0));
#else
                    *(v4u*)((u16*)(ws_ + WS_VALB) + (size_t)(row0 + ai * 128 + m * 16) * FF + c0) = w;
#endif
                    asm volatile("" ::: "memory");
                }
            asm volatile("s_waitcnt lgkmcnt(0)" ::: "memory");
            __builtin_amdgcn_s_barrier();
            asm volatile("" ::: "memory");
        }
    }
};
struct Args { const float* in[26]; float* out; unsigned char* ws; };
__device__ __forceinline__ const float* inp(const Args& a, int i) { asm volatile("" : "+s"(i)); return a.in[i]; }
struct RepeatOrder {
    int nM, nN, R, c;
    __device__ bool next(int i, pg8::Unit& u) const { if (i >= R) return false; u.pm = c % nM; u.pn = (c / 8) % nN; u.koff = 0; return true; }
    __device__ __forceinline__ void a_ready(const pg8::Unit&) const {}
    __device__ __forceinline__ void done(const pg8::Unit&) const {}
};
template <int MODE> __device__ __forceinline__ void run_gemm_rep(Frame& F, const u16* A, const u16* Bt, int Mr, int N, int K, int R, const EpiArgs& ea) {
    pg8::Gemm g{A, Bt, Mr, N, K, K}; RepeatOrder S{Mr / 256, N / 256, R, (int)blockIdx.x};
    Epi<MODE> E{ea};
    pg8::gemm_phase<Epi<MODE>, RepeatOrder, true, true>(F.lds + RING_OFF, g, S, E, F.wave);
}
template <int MODE> __device__ __forceinline__ void run_gemm_k(Frame& F, const u16* A, const u16* Bt, int Mr, int N, int K, int ld, const EpiArgs& ea) {
    pg8::Gemm g{A, Bt, Mr, N, K, ld}; pg8::StaticOrder S; S.init(Mr, N, F.G, (int)blockIdx.x);
    Epi<MODE> E{ea};
    pg8::gemm_phase<Epi<MODE>, pg8::StaticOrder, true, true>(F.lds + RING_OFF, g, S, E, F.wave);
}
template <int MODE, bool AL> __device__ __forceinline__ void run_gemm_al(Frame& F, const u16* A, const u16* Bt, int Mr, int N, int K, const EpiArgs& ea) {
    pg8::Gemm g{A, Bt, Mr, N, K, K}; pg8::StaticOrder S; S.init(Mr, N, F.G, (int)blockIdx.x);
    Epi<MODE> E{ea};
    pg8::gemm_phase<Epi<MODE>, pg8::StaticOrder, AL, true>(F.lds + RING_OFF, g, S, E, F.wave);
}
#ifndef GV_AL
#define GV_AL true
#endif
#ifndef GV_SP
#define GV_SP true
#endif
#ifndef GV_MODE
#define GV_MODE -1
#endif
template <int MODE> __device__ __forceinline__ void run_gemm(Frame& F, const u16* A, const u16* Bt, int Mr, int N, int K, const EpiArgs& ea) {
    pg8::Gemm g{A, Bt, Mr, N, K, K}; pg8::StaticOrder S; S.init(Mr, N, F.G, (int)blockIdx.x);
    Epi<MODE> E{ea};
    if constexpr (MODE == GV_MODE) pg8::gemm_phase<Epi<MODE>, pg8::StaticOrder, GV_AL, GV_SP>(F.lds + RING_OFF, g, S, E, F.wave);
    else pg8::gemm_phase<Epi<MODE>, pg8::StaticOrder, true, true>(F.lds + RING_OFF, g, S, E, F.wave);
}
__device__ __forceinline__ void run_gemm_conv(Frame& F, const u16* A, const u16* Bt, int Mr, int N, int K, const EpiArgs& ea) {
    pg8::Gemm g{A, Bt, Mr, N, K, K}; pg8::StaticOrder S; S.init(Mr, N, F.G, (int)blockIdx.x);
    EpiConv E{ea};
#pragma unroll 1
    for (int i = 0;; ++i) {
        OneUnit O; if (!S.next(i, O.u)) break;
        pg8::gemm_phase<EpiConv, OneUnit, false, true>(F.lds + RING_OFF, g, O, E, F.wave);
    }
}
__global__ void __launch_bounds__(NWAVES * 64, 2) mk_fwd(Args args) {
    extern __shared__ __attribute__((aligned(16))) unsigned char lds[];
    Frame F;
    F.lds = (LAS unsigned char*)lds;
    F.MISC = (volatile LAS unsigned*)(F.lds + MISC_OFF);
    F.tid = threadIdx.x; F.lane = F.tid & 63; F.wave = __builtin_amdgcn_readfirstlane(F.tid >> 6);
    F.G = gridDim.x; { const int bx = blockIdx.x; F.vcu = (F.G % 8 == 0) ? (bx % 8) * (F.G / 8) + bx / 8 : bx; }
    unsigned char* ws = args.ws; F.ws = ws;
    F.ctl = (gu32*)(ws + WS_CTL);
    F.out = args.out;
    for (int u = F.tid; u < (LDS_BYTES - LDSCTL_OFF) / 4; u += NWAVES * 64) ((LAS unsigned*)(F.lds + LDSCTL_OFF))[u] = 0u;
    __syncthreads();
    XcdBarrier bar = xcd_barrier_post((unsigned*)(F.ctl + CW_BAR), F.MISC + 8);
#ifdef DUPBAR
#define GRID_BAR() do { xcd_barrier(bar, F.wave); xcd_barrier(bar, F.wave); } while (0)
#else
#define GRID_BAR() xcd_barrier(bar, F.wave)
#endif

#if (PHM & 1)
        for (int rep_ = 0; rep_ < (((DUPM) & 1) ? 2 : 1); ++rep_) {
    p0_mod(F, inp(args, IN_C), inp(args, IN_CCTX), inp(args, IN_ADAW), inp(args, IN_ADAB));
        }
#endif
#if (PHM & 2)
        for (int rep_ = 0; rep_ < (((DUPM) & 2) ? 2 : 1); ++rep_) {
    p0_weights(F, inp(args, IN_WIN), inp(args, IN_WOUT), inp(args, IN_FUP), inp(args, IN_FDN), inp(args, IN_WUP), inp(args, IN_AUP), inp(args, IN_GUP));
        }
#endif
    GRID_BAR();

    float* xctx = (float*)(ws + WS_XCTX);
    const float* mod = (const float*)(ws + WS_MOD);
    for (int l = 0; l < NL; ++l) {
        const float* modl = mod + (size_t)l * 5 * NMOD;
        const float* xl = (l == 0) ? inp(args, IN_X) : F.out;
        const float* xc = (l == 0) ? inp(args, IN_CTX) : xctx;
        const int Mpost = (l == NL - 1) ? MLAT : M;
#if (PHM & 4)
        for (int rep_ = 0; rep_ < (((DUPM) & 4) ? 2 : 1); ++rep_) {
        norm_rows(F, xl, xc, l != 0, inp(args, IN_N1G) + l * D, modl, 0, 1024, M);
        }
#endif
        GRID_BAR();
#ifdef PROBE_G1
        { EpiArgs ea{ws, F.out, &args, l, 0, 0}; run_gemm<0>(F, (const u16*)(ws + WS_XN), (const u16*)(ws + WS_WIN) + (size_t)l * PROJ * D, M, PROJ, D, ea); }
#endif
#if (PHM & 8)
        for (int rep_ = 0; rep_ < (((DUPM) & 8) ? 2 : 1); ++rep_) {
        { EpiArgs ea{ws, F.out, &args, l, 0, 0};
          run_gemm<1>(F, (const u16*)(ws + WS_XN), (const u16*)(ws + WS_WIN) + (size_t)l * PROJ * D, M, PROJ, D, ea); }
        }
#endif
        GRID_BAR();
#if (PHM & 16)
        for (int rep_ = 0; rep_ < (((DUPM) & 16) ? 2 : 1); ++rep_) {
        conv_branch(F, inp(args, IN_CONVA) + (size_t)l * 3 * DC, Mpost);
        }
#endif
#if (PHM & 32)
        for (int rep_ = 0; rep_ < (((DUPM) & 32) ? 2 : 1); ++rep_) {
        { EpiArgs ea{ws, F.out, &args, l, 0, 0};
          run_gemm<2>(F, (const u16*)(ws + WS_ALORA), (const u16*)(ws + WS_BLORA) + (size_t)l * NLORA * KLORA, M, NLORA, KLORA, ea); }
        }
#endif
        GRID_BAR();
#if (PHM & 64)
        for (int rep_ = 0; rep_ < (((DUPM) & 64) ? 2 : 1); ++rep_) {
        scan_phase(F, inp(args, IN_KK) + l * DR, inp(args, IN_KA) + l * DR);
        }
#endif
        GRID_BAR();
#if (PHM & 64)
        scan_fix(F);
#endif
        GRID_BAR();
#if (PHM & 128)
        for (int rep_ = 0; rep_ < (((DUPM) & 128) ? 2 : 1); ++rep_) {
        rwkv_out(F, inp(args, IN_LNG) + l * DR, inp(args, IN_LNB) + l * DR, inp(args, IN_RK) + l * DR, Mpost);
        }
#endif
        GRID_BAR();
#ifdef PROBE_G24
        { EpiArgs ea{ws, F.out, &args, l, 0, 0}; run_gemm<0>(F, (const u16*)(ws + WS_XN), (const u16*)(ws + WS_WOUT) + (size_t)l * D * D, PROBE_G24 ? MLAT : Mpost, D, D, ea); }
#endif
#if (PHM & 256)
        for (int rep_ = 0; rep_ < (((DUPM) & 256) ? 2 : 1); ++rep_) {
        { EpiArgs ea{ws, F.out, &args, l, l == 0 ? 1 : 0, 2048};
          run_gemm<3>(F, (const u16*)(ws + WS_XN), (const u16*)(ws + WS_WOUT) + (size_t)l * D * D, Mpost, D, D, ea); }
        }
#endif
        GRID_BAR();
#if (PHM & 512)
        for (int rep_ = 0; rep_ < (((DUPM) & 512) ? 2 : 1); ++rep_) {
        norm_rows(F, F.out, xctx, true, inp(args, IN_N2G) + l * D, modl, 3072, 4096, Mpost);
        }
#endif
        GRID_BAR();
#ifdef PROBE_G3R
        { EpiArgs ea{ws, F.out, &args, l, 0, 0}; run_gemm_rep<0>(F, (const u16*)(ws + WS_XN), (const u16*)(ws + WS_WUP) + (size_t)l * 2 * FF * D, Mpost, 2 * FF, D, (l == 0) ? 12 : 11, ea); }
#endif
#ifdef PROBE_G3K
        { EpiArgs ea{ws, F.out, &args, l, 0, 0}; int kk_ = PROBE_G3K; asm volatile("" : "+s"(kk_)); int ld_ = PROBE_G3LD; asm volatile("" : "+s"(ld_)); run_gemm_k<0>(F, (const u16*)(ws + WS_XN), (const u16*)(ws + WS_WUP) + (size_t)l * 2 * FF * D, Mpost, 2 * FF, kk_, ld_, ea); }
#endif
#ifdef PROBE_G3B
        { EpiArgs ea{ws, F.out, &args, l, 0, 0}; run_gemm_al<0, false>(F, (const u16*)(ws + WS_XN), (const u16*)(ws + WS_WUP) + (size_t)l * 2 * FF * D, Mpost, 2 * FF, D, ea); }
#endif
#ifdef PROBE_G3
        { EpiArgs ea{ws, F.out, &args, l, 0, 0}; run_gemm<0>(F, (const u16*)(ws + WS_XN), (const u16*)(ws + WS_WUP) + (size_t)l * 2 * FF * D, Mpost, 2 * FF, D, ea); }
#endif
#if (PHM & 1024)
        for (int rep_ = 0; rep_ < (((DUPM) & 1024) ? 2 : 1); ++rep_)
        { EpiArgs ea{ws, F.out, &args, l, 0, 0};
          run_gemm<4>(F, (const u16*)(ws + WS_XN), (const u16*)(ws + WS_WUP) + (size_t)l * 2 * FF * D, Mpost, FF, D, ea); }
        GRID_BAR();
        for (int rep_ = 0; rep_ < (((DUPM) & 2048) ? 2 : 1); ++rep_)
        { EpiArgs ea{ws, F.out, &args, l, 0, 0};
          run_gemm_conv(F, (const u16*)(ws + WS_XN), (const u16*)(ws + WS_WUP) + ((size_t)l * 2 * FF + FF) * D, Mpost, FF, D, ea); }
#endif
        GRID_BAR();
#ifdef PROBE_G24
        { EpiArgs ea{ws, F.out, &args, l, 0, 0}; run_gemm<0>(F, (const u16*)(ws + WS_VALB), (const u16*)(ws + WS_WDN) + (size_t)l * D * FF, PROBE_G24 ? MLAT : Mpost, D, FF, ea); }
#endif
#if (PHM & 4096)
        for (int rep_ = 0; rep_ < (((DUPM) & 4096) ? 2 : 1); ++rep_) {
        { EpiArgs ea{ws, F.out, &args, l, 0, 5120};
          run_gemm<3>(F, (const u16*)(ws + WS_VALB), (const u16*)(ws + WS_WDN) + (size_t)l * D * FF, Mpost, D, FF, ea); }
        }
#endif
        GRID_BAR();
    }
#if (PHM & 8192)
        for (int rep_ = 0; rep_ < (((DUPM) & 8192) ? 2 : 1); ++rep_) {
    final_norm(F, inp(args, IN_FG));
        }
#endif
}

extern "C" void kernel_launch(void* const* d_in, const int* in_sizes, int n_in, void* d_out, int out_size, void* d_ws, size_t ws_size, hipStream_t stream) {
    static int grid = 0;
    if (grid == 0) {
        if (n_in != 26 || out_size != MLAT * D || ws_size < WS_END) { fprintf(stderr, "kernel_launch: unexpected shapes n_in %d out %d ws %zu\n", n_in, out_size, ws_size); grid = -1; return; }
        int dev = 0, cus = 0, per_cu = 0;
        if (hipGetDevice(&dev) != hipSuccess || hipDeviceGetAttribute(&cus, hipDeviceAttributeMultiprocessorCount, dev) != hipSuccess) { grid = -1; return; }
        if (hipFuncSetAttribute((const void*)mk_fwd, hipFuncAttributeMaxDynamicSharedMemorySize, LDS_BYTES) != hipSuccess) { fprintf(stderr, "kernel_launch: hipFuncSetAttribute failed\n"); grid = -1; return; }
        if (hipOccupancyMaxActiveBlocksPerMultiprocessor(&per_cu, (const void*)mk_fwd, NWAVES * 64, LDS_BYTES) != hipSuccess || per_cu < 1) fprintf(stderr, "kernel_launch: occupancy query says %d\n", per_cu);
        (void)hipGetLastError();
        grid = cus;
    }
    if (grid < 0) return;
    if (hipMemsetAsync((char*)d_ws + WS_CTL, 0, CTL_ZERO_BYTES, stream) != hipSuccess) { fprintf(stderr, "kernel_launch: memset failed\n"); return; }
    Args a{};
    for (int i = 0; i < 26; ++i) a.in[i] = (const float*)d_in[i];
    a.out = (float*)d_out; a.ws = (unsigned char*)d_ws;
    hipLaunchKernelGGL(mk_fwd, dim3(grid), dim3(NWAVES * 64), LDS_BYTES, stream, a);
    const hipError_t le = hipPeekAtLastError();
    if (le != hipSuccess) fprintf(stderr, "kernel_launch: launch failed: %s\n", hipGetErrorName(le));
}
```

```cpp
#include <hip/hip_runtime.h>
#include <cstdio>
#include <cstdint>
__device__ __forceinline__ int fresh_lane() { int z; asm volatile("v_mov_b32 %0, 0" : "=v"(z)); return (int)__builtin_amdgcn_mbcnt_hi(~0u, __builtin_amdgcn_mbcnt_lo(~0u, (unsigned)z)); }
namespace pg8 {
#define PG8_LAS __attribute__((address_space(3)))
typedef unsigned short bf16_t;
typedef short bf16x8 __attribute__((ext_vector_type(8)));
typedef float f32x4 __attribute__((ext_vector_type(4)));
typedef unsigned u32x4 __attribute__((ext_vector_type(4)));
constexpr int BM = 256, BK = 64, HALF = 128, HTB = HALF * BK * 2  , STAGE_BYTES = 8 * HTB, NXCD = 8, WGM = 8;

__host__ __device__ __forceinline__ int lds_byte(int r, int c) { const int st = (r >> 4) * 2 + (c >> 5), rr = r & 15, cc = c & 31, ob = rr * 64 + cc * 2; return st * 1024 + (ob ^ (((ob >> 9) & 1) << 5)); }
__host__ __device__ __forceinline__ void stage_rc(int b, int& R, int& C) { const int st = b / 1024, sb = b % 1024, swz = sb ^ (((sb >> 9) & 1) << 5); R = (st >> 1) * 16 + swz / 64; C = (st & 1) * 32 + (swz % 64) / 2; }
__host__ __device__ __forceinline__ int perm32(int rho) { const int n = rho >> 4, i = rho & 15; return 8 * (i >> 2) + 4 * n + (i & 3); }

struct Unit { int pm, pn, koff, last; };
struct Gemm { const bf16_t* A; const bf16_t* Bt; int M, N, K, ld; };

struct StaticOrder {
    int nM, nN, nwg, G, c;
    __host__ __device__ void init(int M, int N, int G_, int c_) { nM = M / BM; nN = N / BM; nwg = nM * nN; G = G_; c = c_; }
    __host__ __device__ bool next(int i, Unit& u) const {
        const long L = (long)i * G + c; if (L >= nwg) return false;
        int wgid = (int)L; { const int q = nwg / NXCD, r = nwg % NXCD, xcd = wgid % NXCD, off = wgid / NXCD; wgid = (xcd < r ? xcd * (q + 1) : r * (q + 1) + (xcd - r) * q) + off; }
        const int nig = WGM * nN, gid = wgid / nig, fm = gid * WGM, gsz = (nM - fm) < WGM ? (nM - fm) : WGM;
        u.pm = fm + ((wgid % nig) % gsz); u.pn = (wgid % nig) / gsz; u.koff = 0; u.last = (L + G >= nwg) ? 1 : 0; return true;
    }
    __device__ __forceinline__ void a_ready(const Unit&) const {}
    __device__ __forceinline__ void done(const Unit&) const {}
};
struct KBlockOrder {
    StaticOrder S; int pn_split, koff_hi;
    __host__ __device__ void init(int M, int N, int G_, int c_, int pn_split_, int koff_hi_) { S.init(M, N, G_, c_); pn_split = pn_split_; koff_hi = koff_hi_; }
    __host__ __device__ bool next(int i, Unit& u) const { if (!S.next(i, u)) return false; u.koff = (u.pn >= pn_split) ? koff_hi : 0; return true; }
    __device__ __forceinline__ void a_ready(const Unit&) const {}
    __device__ __forceinline__ void done(const Unit&) const {}
};
struct SplitOrder {
    int pm0, nN, nsplit, ksb, total, G, c;
    __host__ __device__ void init(int pm0_, int nM_, int nN_, int nsplit_, int kslice_elems, int G_, int c_) { pm0 = pm0_; nN = nN_; nsplit = nsplit_; ksb = kslice_elems * 2; total = nM_ * nN_ * nsplit_; G = G_; c = c_; }
    __host__ __device__ bool next(int i, Unit& u) const {
        const long L = (long)i * G + c; if (L >= total) return false;
        const int t = (int)L / nsplit, ks = (int)L % nsplit;
        u.pm = pm0 + t / nN; u.pn = t % nN; u.koff = ks * ksb; u.last = 0; return true;
    }
    __device__ __forceinline__ void a_ready(const Unit&) const {}
    __device__ __forceinline__ void done(const Unit&) const {}
};

template <class Epi, class Sched, bool ALIGN_EPI = false, bool SP2 = false>
__device__ __forceinline__ void gemm_phase(PG8_LAS unsigned char* lds, const Gemm g, const Sched& S, const Epi& E, const int wid_in) {
    const int wid = wid_in, lane = fresh_lane(), tid = wid * 64 + lane, wr = wid >> 2, wc = wid & 3, fr = lane & 15, fq = lane >> 4;
    const int K = g.K, nt = K / BK;
    unsigned voffA, voffB; int aoff, boff;
#define PG8_ADDR() do { const int l_ = fresh_lane(), t_ = wid * 64 + l_, fr_ = l_ & 15, fq_ = l_ >> 4; \
        { int R, C; stage_rc(t_ * 16, R, C); const int Rb = Epi::PERM ? ((R & ~31) + perm32(R & 31)) : R;     \
            voffA = (unsigned)(R * g.ld + C) * 2u; voffB = (unsigned)(Rb * g.ld + C) * 2u; } \
        aoff = lds_byte(wr * 64 + fr_, fq_ * 8); boff = lds_byte(wc * 32 + fr_, fq_ * 8); } while (0)
    PG8_ADDR();
    const size_t kstep = (size_t)(BK * 2);
    const size_t hstep = (size_t)HALF * g.ld * 2;
    const size_t qstep = hstep / 2;
    const size_t tstep = 2 * hstep;
    const unsigned ldsw = (unsigned)wid * 1024u;
#define PG8_SA(b, h) (((b) * 2 + (h)) * HTB)
#define PG8_SB(b, h) ((4 + (b) * 2 + (h)) * HTB)
#define PG8_STAGE(bufoff, gbase, voff) do { _Pragma("unroll") for (int _i = 0; _i < 2; ++_i) \
        __builtin_amdgcn_global_load_lds((const unsigned*)((const char*)(gbase) + (size_t)_i * qstep + (voff)), (PG8_LAS unsigned*)(lds + (bufoff) + ldsw + _i * 8192), 16, 0, 0); } while (0)
#define PG8_LDA(dst, b, h) do { _Pragma("unroll") for (int m = 0; m < 4; ++m) _Pragma("unroll") for (int k = 0; k < 2; ++k) dst[m][k] = *(const PG8_LAS bf16x8*)(lds + PG8_SA(b, h) + aoff + m * 2048 + k * 1024); } while (0)
#define PG8_LDB(dst, b, h) do { _Pragma("unroll") for (int n = 0; n < 2; ++n) _Pragma("unroll") for (int k = 0; k < 2; ++k) dst[n][k] = *(const PG8_LAS bf16x8*)(lds + PG8_SB(b, h) + boff + n * 2048 + k * 1024); } while (0)
#define PG8_MMA(ai, bj, At, Bt) do { __builtin_amdgcn_s_setprio(1); _Pragma("unroll") for (int m = 0; m < 4; ++m) _Pragma("unroll") for (int n = 0; n < 2; ++n) _Pragma("unroll") for (int k = 0; k < 2; ++k) \
        acc[ai][bj][m][n] = __builtin_amdgcn_mfma_f32_16x16x32_bf16(Bt[n][k], At[m][k], acc[ai][bj][m][n], 0, 0, 0); __builtin_amdgcn_s_setprio(0); } while (0)
#define PG8_WAIT_V(n) asm volatile("s_waitcnt vmcnt(" #n ")" ::: "memory")
#define PG8_WAIT_L(n) asm volatile("s_waitcnt lgkmcnt(" #n ")" ::: "memory")
#define PG8_BAR __builtin_amdgcn_s_barrier()
#define PG8_SCHED __builtin_amdgcn_sched_barrier(0)
    Unit cur, nxt; int ui = 0;
    if (!S.next(0, cur)) return;
    f32x4 acc[2][2][4][2];
#pragma unroll
    for (int a = 0; a < 2; ++a)
#pragma unroll
        for (int b = 0; b < 2; ++b)
#pragma unroll
            for (int m = 0; m < 4; ++m)
#pragma unroll
                for (int n = 0; n < 2; ++n) acc[a][b][m][n] = (f32x4){0.f, 0.f, 0.f, 0.f};
    bf16x8 At[4][2], B0[2][2], B1[2][2];
    const char* cA = (const char*)g.A + (size_t)cur.pm * tstep + cur.koff; const char* cB = (const char*)g.Bt + (size_t)cur.pn * tstep + cur.koff;
    S.a_ready(cur);
    if constexpr (SP2) {
        PG8_STAGE(PG8_SB(0, 0), cB, voffB); PG8_STAGE(PG8_SB(0, 1), cB + hstep, voffB); PG8_STAGE(PG8_SA(0, 0), cA, voffA); PG8_STAGE(PG8_SA(0, 1), cA + hstep, voffA);
        if (wr == 1) PG8_BAR;
        PG8_WAIT_V(2); PG8_BAR;
        PG8_STAGE(PG8_SB(1, 0), cB + kstep, voffB); PG8_STAGE(PG8_SA(1, 0), cA + kstep, voffA); PG8_STAGE(PG8_SB(1, 1), cB + hstep + kstep, voffB);
        PG8_WAIT_V(6); PG8_BAR;
    } else {
        PG8_STAGE(PG8_SB(0, 0), cB, voffB); PG8_STAGE(PG8_SA(0, 0), cA, voffA); PG8_STAGE(PG8_SB(0, 1), cB + hstep, voffB); PG8_STAGE(PG8_SA(0, 1), cA + hstep, voffA);
        if (wr == 1) PG8_BAR;
        PG8_WAIT_V(4); PG8_BAR;
        PG8_STAGE(PG8_SB(1, 0), cB + kstep, voffB); PG8_STAGE(PG8_SA(1, 0), cA + kstep, voffA); PG8_STAGE(PG8_SB(1, 1), cB + hstep + kstep, voffB);
        PG8_WAIT_V(6); PG8_BAR;
    }
    for (;;) {
        const bool has_next = S.next(ui + 1, nxt);
        const char* nA = has_next ? (const char*)g.A + (size_t)nxt.pm * tstep + nxt.koff : cA; const char* nB = has_next ? (const char*)g.Bt + (size_t)nxt.pn * tstep + nxt.koff : cB;
        for (int t = 0; t < nt; t += 2) {
            const bool last = (t == nt - 2);
            const char* a1 = cA + (size_t)(t + 1) * kstep;
            const char* a2 = last ? nA : cA + (size_t)(t + 2) * kstep; const char* b2 = last ? nB : cB + (size_t)(t + 2) * kstep;
            const char* a3 = a2 + kstep; const char* b3 = b2 + kstep;
            if (last && has_next) S.a_ready(nxt);
            if constexpr (SP2) {
            PG8_LDB(B0, 0, 0); PG8_LDB(B1, 0, 1); PG8_SCHED; PG8_LDA(At, 0, 0); PG8_STAGE(PG8_SA(1, 1), a1 + hstep, voffA);
            PG8_WAIT_V(8); PG8_WAIT_L(0); PG8_BAR; PG8_MMA(0, 0, At, B0); PG8_MMA(0, 1, At, B1); PG8_BAR; PG8_SCHED;
            PG8_LDA(At, 0, 1); PG8_STAGE(PG8_SB(0, 0), b2, voffB); PG8_STAGE(PG8_SB(0, 1), b2 + hstep, voffB); PG8_STAGE(PG8_SA(0, 0), a2, voffA);
            PG8_WAIT_V(8); PG8_WAIT_L(0); PG8_BAR; PG8_MMA(1, 0, At, B0); PG8_MMA(1, 1, At, B1); PG8_BAR; PG8_SCHED;
            PG8_LDB(B0, 1, 0); PG8_LDB(B1, 1, 1); PG8_SCHED; PG8_LDA(At, 1, 0); PG8_STAGE(PG8_SA(0, 1), a2 + hstep, voffA);
            PG8_WAIT_V(8); PG8_WAIT_L(0); PG8_BAR; PG8_MMA(0, 0, At, B0); PG8_MMA(0, 1, At, B1); PG8_BAR; PG8_SCHED;
            PG8_LDA(At, 1, 1); PG8_STAGE(PG8_SB(1, 0), b3, voffB); PG8_STAGE(PG8_SB(1, 1), b3 + hstep, voffB); PG8_STAGE(PG8_SA(1, 0), a3, voffA);
            PG8_WAIT_V(8); PG8_WAIT_L(0); PG8_BAR; PG8_MMA(1, 0, At, B0); PG8_MMA(1, 1, At, B1); PG8_BAR; PG8_SCHED;
            } else {
            PG8_LDB(B0, 0, 0); PG8_SCHED; PG8_LDA(At, 0, 0); PG8_STAGE(PG8_SA(1, 1), a1 + hstep, voffA);
            PG8_WAIT_L(8); PG8_BAR; PG8_WAIT_L(0); PG8_MMA(0, 0, At, B0); PG8_BAR; PG8_SCHED;
            PG8_LDB(B1, 0, 1); PG8_STAGE(PG8_SB(0, 0), b2, voffB);
            PG8_BAR; PG8_WAIT_L(0); PG8_MMA(0, 1, At, B1); PG8_BAR;
            PG8_LDA(At, 0, 1); PG8_STAGE(PG8_SA(0, 0), a2, voffA);
            PG8_BAR; PG8_WAIT_L(0); PG8_MMA(1, 0, At, B0); PG8_BAR; PG8_SCHED;
            PG8_STAGE(PG8_SB(0, 1), b2 + hstep, voffB);
            PG8_WAIT_V(6); PG8_BAR; PG8_MMA(1, 1, At, B1); PG8_BAR;
            PG8_LDB(B0, 1, 0); PG8_SCHED; PG8_LDA(At, 1, 0); PG8_STAGE(PG8_SA(0, 1), a2 + hstep, voffA);
            PG8_WAIT_L(8); PG8_BAR; PG8_WAIT_L(0); PG8_MMA(0, 0, At, B0); PG8_BAR; PG8_SCHED;
            PG8_LDB(B1, 1, 1); PG8_STAGE(PG8_SB(1, 0), b3, voffB);
            PG8_BAR; PG8_WAIT_L(0); PG8_MMA(0, 1, At, B1); PG8_BAR;
            PG8_LDA(At, 1, 1); PG8_STAGE(PG8_SA(1, 0), a3, voffA);
            PG8_BAR; PG8_WAIT_L(0); PG8_MMA(1, 0, At, B0); PG8_BAR; PG8_SCHED;
            PG8_STAGE(PG8_SB(1, 1), b3 + hstep, voffB);
            PG8_WAIT_V(6); PG8_BAR; PG8_MMA(1, 1, At, B1); PG8_BAR;
            }
        }
        if constexpr (ALIGN_EPI) { if (wr == 0) PG8_BAR; }
        if constexpr (!Epi::AFTER_DRAIN) { const int el = fresh_lane(); E(acc, cur, wr, wc, el & 15, el >> 4); S.done(cur); PG8_ADDR(); }
        if (!has_next) break;
#pragma unroll
        for (int a = 0; a < 2; ++a)
#pragma unroll
            for (int b = 0; b < 2; ++b)
#pragma unroll
                for (int m = 0; m < 4; ++m)
#pragma unroll
                    for (int n = 0; n < 2; ++n) acc[a][b][m][n] = (f32x4){0.f, 0.f, 0.f, 0.f};
        cur = nxt; cA = nA; cB = nB; ++ui;
        if constexpr (ALIGN_EPI) { if (wr == 1) PG8_BAR; }
    }
    PG8_WAIT_V(0);
    if constexpr (!ALIGN_EPI) { if (wr == 0) PG8_BAR; }
    PG8_BAR;
    if constexpr (Epi::AFTER_DRAIN) { E.fused(acc, cur, wr, wc, fr, fq, lds, wid, lane); S.done(cur); }
#undef PG8_ADDR
#undef PG8_SA
#undef PG8_SB
#undef PG8_STAGE
#undef PG8_LDA
#undef PG8_LDB
#undef PG8_MMA
#undef PG8_WAIT_V
#undef PG8_WAIT_L
#undef PG8_BAR
#undef PG8_SCHED
}
}
#define GAS __attribute__((address_space(1)))
#define LAS __attribute__((address_space(3)))
typedef unsigned short bf16;
typedef unsigned v4u __attribute__((ext_vector_type(4)));
typedef float f32x4 __attribute__((ext_vector_type(4)));
typedef short bf16x8 __attribute__((ext_vector_type(8)));
typedef GAS unsigned gu32;
typedef GAS unsigned long long gu64;
#define RLX_AGENT __ATOMIC_RELAXED, __HIP_MEMORY_SCOPE_AGENT
#define LDS_WAIT() asm volatile("s_waitcnt lgkmcnt(0)" ::: "memory")
#define VM_WAIT() asm volatile("s_waitcnt vmcnt(0)" ::: "memory")
__device__ __forceinline__ unsigned long long rt() { return __builtin_amdgcn_s_memrealtime(); }
__device__ __forceinline__ unsigned f2bf(float f) { unsigned u = __builtin_bit_cast(unsigned, f); return (u + 0x7fffu + ((u >> 16) & 1u)) >> 16; }
typedef __bf16 bf2v_t __attribute__((ext_vector_type(2)));
__device__ __forceinline__ unsigned pk2(float lo, float hi) { bf2v_t v; v.x = (__bf16)lo; v.y = (__bf16)hi; return __builtin_bit_cast(unsigned, v); }

#define XB_TMO      128
#define XB_XCNT(j)  (256  + 64 * (j))
#define XB_XSUB(j)  (1280 + 64 * (j))
#define XB_XGEN(j)  (2304 + 64 * (j))
#define XB_TOP      3328
#define XB_TOPGEN   3392
#define XCD_BAR_WORDS 3456
#define XB_SPIN_CAP (1u << 18)

__device__ __forceinline__ unsigned xb_ld(unsigned* p)              { return __hip_atomic_load(p, __ATOMIC_RELAXED, __HIP_MEMORY_SCOPE_AGENT); }
__device__ __forceinline__ unsigned xb_add(unsigned* p, unsigned v) { return __hip_atomic_fetch_add(p, v, __ATOMIC_RELAXED, __HIP_MEMORY_SCOPE_AGENT); }
__device__ __forceinline__ unsigned xb_xcc_id() { return (unsigned)__builtin_amdgcn_s_getreg((3 << 11) | 20) & 0xFu; }
#define XB_SPIN(cond, bar) do { unsigned _sp = 0; while (cond) { __builtin_amdgcn_s_sleep(1); \
    if ((++_sp & 255u) == 0u) { if (xb_ld(&(bar)[XB_TMO])) break; if (_sp > XB_SPIN_CAP) { atomicAdd(&(bar)[XB_TMO], 1u); break; } } } } while (0)

struct XcdBarrier {
    unsigned* bar; unsigned x;
    volatile LAS unsigned* st;
};

__device__ __forceinline__ XcdBarrier xcd_barrier_post(unsigned* bar, volatile LAS unsigned* st) {
    XcdBarrier b; b.bar = bar; b.x = xb_xcc_id(); b.st = st;
    if (threadIdx.x == 0) (void)xb_add(&bar[XB_XCNT(b.x)], 1u);
    return b;
}
__device__ __forceinline__ void xcd_barrier_complete(unsigned* bar, unsigned x, unsigned& nloc, unsigned& nx) {
    const unsigned G = gridDim.x * gridDim.y * gridDim.z;
    unsigned sum, cnt, mine, sp = 0u;
    for (;;) {
        sum = 0u; cnt = 0u; mine = 0u;
#pragma unroll
        for (unsigned j = 0; j < 16; ++j) { const unsigned c = xb_ld(&bar[XB_XCNT(j)]); sum += c; cnt += (c > 0u) ? 1u : 0u; mine = (j == x) ? c : mine; }
        if (sum == G) break;
        __builtin_amdgcn_s_sleep(1);
        if ((++sp & 255u) == 0u) { if (xb_ld(&bar[XB_TMO])) break; if (sp > XB_SPIN_CAP) { atomicAdd(&bar[XB_TMO], 1u); break; } }
    }
    nloc = mine > 0u ? mine : 1u; nx = cnt > 0u ? cnt : 1u;
}

__device__ __forceinline__ void xcd_barrier(const XcdBarrier& b, const int wave) {
    asm volatile("s_waitcnt vmcnt(0)" ::: "memory");
    __syncthreads();
    if (wave == 0 && fresh_lane() == 0) {
        unsigned* bar = b.bar; asm volatile("" : "+s"(bar)); const unsigned bx_ = xb_xcc_id();
        __builtin_amdgcn_s_waitcnt(0);
        unsigned nloc = b.st[0], nx = b.st[1];
        if (nloc == 0u) { xcd_barrier_complete(bar, bx_, nloc, nx); b.st[0] = nloc; b.st[1] = nx; }
        const unsigned old = xb_add(&bar[XB_XSUB(bx_)], 1u);
        const unsigned gen = old / nloc;
        if (old + 1u == (gen + 1u) * nloc) {
            __builtin_amdgcn_fence(__ATOMIC_RELEASE, "agent");
            asm volatile("s_waitcnt vmcnt(0)" ::: "memory");
            const unsigned og = xb_add(&bar[XB_TOP], 1u);
            const unsigned tg = og / nx;
            if (og + 1u == (tg + 1u) * nx) xb_add(&bar[XB_TOPGEN], 1u);
            else XB_SPIN(xb_ld(&bar[XB_TOPGEN]) == tg, bar);
            __builtin_amdgcn_fence(__ATOMIC_ACQUIRE, "agent");
            xb_add(&bar[XB_XGEN(bx_)], 1u);
            asm volatile("s_waitcnt vmcnt(0)" ::: "memory");
        } else {
            XB_SPIN(xb_ld(&bar[XB_XGEN(bx_)]) == gen, bar);
            __builtin_amdgcn_fence(__ATOMIC_ACQUIRE, "agent");
            asm volatile("s_waitcnt vmcnt(0)" ::: "memory");
        }
    }
    __syncthreads();
}


#ifndef PHM
#define PHM 0xFFFF
#endif
#ifndef DUPM
#define DUPM 0
#endif
#ifndef DUPS
#define DUPS 0
#endif
constexpr int NWAVES = 8;
constexpr int D = 1024, NB = 4, T = 8192, TC = 256, NL = 2;
constexpr int DC = 512, DR = 512, HS = 64, FF = 2816, PROJ = 3328, NMOD = 6144;
constexpr int MLAT = NB * T, MCTX = NB * TC, M = MLAT + MCTX;
constexpr int NLORA = 2560, KLORA = 256;
constexpr float RMS_EPS = 1e-6f, GN_EPS = 64e-5f, DECAY_SCALE = 0.6065306597126334f;

typedef unsigned short u16;
typedef unsigned v4u __attribute__((ext_vector_type(4)));
typedef unsigned v2u __attribute__((ext_vector_type(2)));
typedef _Float16 h2 __attribute__((ext_vector_type(2)));

constexpr size_t MiB = 1u << 20;
constexpr size_t WS_CTL = 0, CTL_ZERO_BYTES = 1 * MiB;
constexpr size_t WS_MOD = 1 * MiB;
constexpr size_t WS_XCTX = 2 * MiB;
constexpr size_t WS_WIN = 6 * MiB;
constexpr size_t WS_WOUT = 19 * MiB;
constexpr size_t WS_WUP = 23 * MiB;
constexpr size_t WS_WDN = 45 * MiB;
constexpr size_t WS_BLORA = 56 * MiB;
constexpr size_t WS_XN = 60 * MiB;
constexpr size_t WS_PC = 126 * MiB;
constexpr size_t WS_PRKV = 225 * MiB;
constexpr size_t WS_PART = WS_PRKV;
constexpr size_t WS_ALORA = 324 * MiB;
constexpr size_t WS_DEC = 341 * MiB;
constexpr size_t WS_AA = 407 * MiB;
constexpr size_t WS_GATE = 473 * MiB;
constexpr size_t WS_GATEB = 126 * MiB;
constexpr size_t WS_VALB = 308 * MiB;
constexpr size_t WS_END = 506 * MiB;
static_assert(WS_XN + (size_t)M * D * 2 <= WS_PC, "map");
static_assert(WS_PC + (size_t)M * 1536 * 2 <= WS_PRKV, "map");
static_assert(WS_PRKV + (size_t)M * 1536 * 2 <= WS_ALORA, "map");
static_assert(WS_ALORA + (size_t)M * 256 * 2 <= WS_DEC, "map");
static_assert(WS_DEC + (size_t)M * 1024 * 2 <= WS_AA, "map");
static_assert(WS_AA + (size_t)M * 1024 * 2 <= WS_GATE, "map");
static_assert(WS_GATE + (size_t)M * 512 * 2 <= WS_END, "map");
static_assert(WS_GATEB + (size_t)M * FF * 2 <= WS_VALB, "map");
static_assert(WS_VALB + (size_t)M * FF * 2 <= WS_END, "map");
static_assert(WS_BLORA + (size_t)NL * NLORA * KLORA * 2 <= WS_XN, "map");
constexpr int CW_BAR = 4096;

constexpr int RING_OFF = 0, RING_BYTES = 131072;
constexpr int LDS_BYTES = 147456;
constexpr int LDSCTL_OFF = LDS_BYTES - 1024, MISC_OFF = LDSCTL_OFF + 320;

#ifndef LASTNT
#define LASTNT 7
#endif
#define ST16L(bit_, last_, ptr_, val_) do { if (((LASTNT) & (bit_)) && (last_)) __builtin_nontemporal_store((val_), (v4u*)(ptr_)); else *(v4u*)(ptr_) = (val_); } while (0)
#ifdef NT_M2
#define ST_NT2(ptr_, val_) __builtin_nontemporal_store((val_), (ptr_))
#else
#define ST_NT2(ptr_, val_) (*(ptr_) = (val_))
#endif
#ifdef NT_C
#define ST_NT3(ptr_, val_) __builtin_nontemporal_store((val_), (ptr_))
#else
#define ST_NT3(ptr_, val_) (*(ptr_) = (val_))
#endif
#ifndef NO_NT
#define ST_NT(ptr_, val_) __builtin_nontemporal_store((val_), (ptr_))
#else
#define ST_NT(ptr_, val_) (*(ptr_) = (val_))
#endif
__device__ __forceinline__ unsigned pk_bf16(float lo, float hi) { return pk2(lo, hi); }
__device__ __forceinline__ unsigned pk_f16(float lo, float hi) { h2 v; v.x = (_Float16)lo; v.y = (_Float16)hi; return __builtin_bit_cast(unsigned, v); }
__device__ __forceinline__ void unpk_f16(unsigned u, float& lo, float& hi) { const h2 v = __builtin_bit_cast(h2, u); lo = (float)v.x; hi = (float)v.y; }
__device__ __forceinline__ void unpk8_f16(const v4u u, float (&f)[8]) { unpk_f16(u.x, f[0], f[1]); unpk_f16(u.y, f[2], f[3]); unpk_f16(u.z, f[4], f[5]); unpk_f16(u.w, f[6], f[7]); }
__device__ __forceinline__ float sigmoidf_(float x) { return __builtin_amdgcn_rcpf(1.0f + __builtin_amdgcn_exp2f(-1.4426950408889634f * x)); }
__device__ __forceinline__ float siluf_(float x) { return x * __builtin_amdgcn_rcpf(1.0f + __builtin_amdgcn_exp2f(-1.4426950408889634f * x)); }
__device__ __forceinline__ float tanhf_(float x) { const float e = __builtin_amdgcn_exp2f(-2.8853900817779268f * fabsf(x)); const float t = (1.0f - e) * __builtin_amdgcn_rcpf(1.0f + e); return x < 0.f ? -t : t; }
template <int CTRL> __device__ __forceinline__ float dppf(float x) { return __builtin_bit_cast(float, __builtin_amdgcn_update_dpp(0, __builtin_bit_cast(int, x), CTRL, 0xF, 0xF, true)); }
template <int CTRL, int ROWMASK> __device__ __forceinline__ float dpp1(float x) { return __builtin_bit_cast(float, __builtin_amdgcn_update_dpp(0x3f800000, __builtin_bit_cast(int, x), CTRL, ROWMASK, 0xF, false)); }
__device__ __forceinline__ float allreduce16(float x) { x += dppf<0x121>(x); x += dppf<0x122>(x); x += dppf<0x124>(x); x += dppf<0x128>(x); return x; }
__device__ __forceinline__ float group8_sum(float v) { v += dppf<0xB1>(v); v += dppf<0x4E>(v); v += dppf<0x141>(v); return v; }
__device__ __forceinline__ float wave_sum(float v) {
    v = allreduce16(v);
    const int vi = __builtin_bit_cast(int, v);
    const float s0 = __builtin_bit_cast(float, __builtin_amdgcn_readlane(vi, 0)), s1 = __builtin_bit_cast(float, __builtin_amdgcn_readlane(vi, 16)), s2 = __builtin_bit_cast(float, __builtin_amdgcn_readlane(vi, 32)), s3 = __builtin_bit_cast(float, __builtin_amdgcn_readlane(vi, 48));
    return (s0 + s1) + (s2 + s3);
}

#define IN_X 0
#define IN_C 1
#define IN_CTX 2
#define IN_CCTX 3
#define IN_ADAW 4
#define IN_ADAB 5
#define IN_N1G 6
#define IN_N2G 7
#define IN_WIN 8
#define IN_CONVA 9
#define IN_W0 10
#define IN_WUP 11
#define IN_A0 12
#define IN_AUP 13
#define IN_KK 14
#define IN_KA 15
#define IN_RK 16
#define IN_GUP 17
#define IN_LNG 18
#define IN_LNB 19
#define IN_WOUT 20
#define IN_FUP 21
#define IN_FCW 22
#define IN_FCB 23
#define IN_FDN 24
#define IN_FG 25
struct Args;
__device__ __forceinline__ const float* inp(const Args& a, int i);
struct EpiArgs {
    unsigned char* ws; float* out; const Args* ap; int l; int in_is_input; int goff;
};
template <int MODE> struct Epi {
    static constexpr bool PERM = true, AFTER_DRAIN = false;
    EpiArgs a;
    __device__ __forceinline__ void operator()(const pg8::f32x4 (&acc)[2][2][4][2], const pg8::Unit& u, int wr, int wc, int fr, int fq) const {
        using pg8::f32x4;
        const int row0 = u.pm * 256 + wr * 64 + fr;
        const int colb = u.pn * 256 + wc * 32 + 8 * fq;
        unsigned char* const ws_ = a.ws;
        if constexpr (MODE == 0) {
#pragma unroll
            for (int ai = 0; ai < 2; ++ai)
#pragma unroll
                for (int bj = 0; bj < 2; ++bj)
#pragma unroll
                    for (int m = 0; m < 4; ++m) { asm volatile("" :: "v"(acc[ai][bj][m][0]), "v"(acc[ai][bj][m][1])); }
        } else if constexpr (MODE == 1) {
#pragma unroll
            for (int ai = 0; ai < 2; ++ai)
#pragma unroll
                for (int m = 0; m < 4; ++m) {
                    const size_t row = (size_t)(row0 + ai * 128 + m * 16);
                    if (u.pn >= 2 && u.pn < 6) {
                        const f32x4 c0v = acc[ai][0][m][0], c1v = acc[ai][0][m][1], x0v = acc[ai][1][m][0], x1v = acc[ai][1][m][1];
                        v4u w; w.x = pk_f16(c0v[0] * x0v[0], c0v[1] * x0v[1]); w.y = pk_f16(c0v[2] * x0v[2], c0v[3] * x0v[3]); w.z = pk_f16(c1v[0] * x1v[0], c1v[1] * x1v[1]); w.w = pk_f16(c1v[2] * x1v[2], c1v[3] * x1v[3]);
                        ST16L(1, u.last, (u16*)(ws_ + WS_PC) + row * 1536 + 512 + (u.pn - 2) * 128 + wc * 32 + 8 * fq, w);
                    } else
#pragma unroll
                    for (int bj = 0; bj < 2; ++bj) {
                        const f32x4 v0 = acc[ai][bj][m][0], v1 = acc[ai][bj][m][1];
                        const int col = colb + bj * 128;
                        v4u w;
                        if (u.pn < 12) {
                            w.x = pk_f16(v0[0], v0[1]); w.y = pk_f16(v0[2], v0[3]); w.z = pk_f16(v1[0], v1[1]); w.w = pk_f16(v1[2], v1[3]);
                            u16* dst = (u.pn < 6) ? ((u16*)(ws_ + WS_PC) + row * 1536 + col) : ((u16*)(ws_ + WS_PRKV) + row * 1536 + (col - 1536));
                            ST16L(1, u.last, dst, w);
                        } else {
                            const int cl = col - 3072;
                            float f[8] = {v0[0], v0[1], v0[2], v0[3], v1[0], v1[1], v1[2], v1[3]};
#pragma unroll
                            for (int j = 0; j < 8; ++j) f[j] = (cl < 64) ? tanhf_(f[j]) : ((cl < 128) ? f[j] : sigmoidf_(f[j]));
                            w.x = pk_bf16(f[0], f[1]); w.y = pk_bf16(f[2], f[3]); w.z = pk_bf16(f[4], f[5]); w.w = pk_bf16(f[6], f[7]);
                            *(v4u*)((u16*)(ws_ + WS_ALORA) + row * 256 + cl) = w;
                        }
                    }
                }
        } else if constexpr (MODE == 2) {
#pragma unroll
            for (int bj = 0; bj < 2; ++bj) {
                const int col = colb + bj * 128;
                float pv[8];
                if (u.pn < 8) { const float* pp = (u.pn < 4) ? (inp(*a.ap, IN_W0) + a.l * 1024 + col) : (inp(*a.ap, IN_A0) + a.l * 1024 + (col - 1024));
#pragma unroll
                    for (int j = 0; j < 8; ++j) pv[j] = pp[j]; }
#pragma unroll
                for (int ai = 0; ai < 2; ++ai)
#pragma unroll
                    for (int m = 0; m < 4; ++m) {
                        const size_t row = (size_t)(row0 + ai * 128 + m * 16);
                        const f32x4 v0 = acc[ai][bj][m][0], v1 = acc[ai][bj][m][1];
                        float f[8] = {v0[0], v0[1], v0[2], v0[3], v1[0], v1[1], v1[2], v1[3]};
                        u16* dst;
                        if (u.pn < 4) {
#pragma unroll
                            for (int j = 0; j < 8; ++j) f[j] = __builtin_amdgcn_exp2f((-DECAY_SCALE * 1.4426950408889634f) * sigmoidf_(pv[j] + f[j]));
                            dst = (u16*)(ws_ + WS_DEC) + row * 1024 + col;
                        } else if (u.pn < 8) {
#pragma unroll
                            for (int j = 0; j < 8; ++j) f[j] = sigmoidf_(pv[j] + f[j]);
                            dst = (u16*)(ws_ + WS_AA) + row * 1024 + (col - 1024);
                        } else dst = (u16*)(ws_ + WS_GATE) + row * 512 + (col - 2048);
                        v4u w; w.x = pk_f16(f[0], f[1]); w.y = pk_f16(f[2], f[3]); w.z = pk_f16(f[4], f[5]); w.w = pk_f16(f[6], f[7]);
                        ST16L(2, u.last, dst, w);
                        asm volatile("" ::: "memory");
                    }
            }
        } else if constexpr (MODE == 3) {
            const int s = (u.pm < 128) ? (u.pm >> 5) : 4;
            const bool lat = u.pm < 128;
            const bool fin = (a.l == NL - 1) && (a.goff == 5120);
            const float* modp = (const float*)(ws_ + WS_MOD) + (size_t)a.l * 5 * NMOD + a.goff;
            u16* const xb = lat ? (u16*)a.out : (u16*)(ws_ + WS_XCTX);
            u16* const ob = fin ? (u16*)(ws_ + WS_XN) : xb;
            const float* const ibase = lat ? inp(*a.ap, IN_X) : inp(*a.ap, IN_CTX);
#pragma unroll
            for (int bj = 0; bj < 2; ++bj) {
                const int col = colb + bj * 128;
                const f32x4 g0 = *(const f32x4*)(modp + s * NMOD + col), g1 = *(const f32x4*)(modp + s * NMOD + col + 4);
#pragma unroll
                for (int ai = 0; ai < 2; ++ai)
#pragma unroll
                    for (int m = 0; m < 4; ++m) {
                        const int row = row0 + ai * 128 + m * 16;
                        const size_t off = lat ? ((size_t)row * D + col) : ((size_t)(row - MLAT) * D + col);
                        f32x4 x0, x1;
                        if (a.in_is_input) { x0 = *(const f32x4*)(ibase + off); x1 = *(const f32x4*)(ibase + off + 4); }
                        else { const v4u xu = *(const v4u*)(xb + off);
                            x0 = (f32x4){__uint_as_float(xu.x << 16), __uint_as_float(xu.x & 0xffff0000u), __uint_as_float(xu.y << 16), __uint_as_float(xu.y & 0xffff0000u)};
                            x1 = (f32x4){__uint_as_float(xu.z << 16), __uint_as_float(xu.z & 0xffff0000u), __uint_as_float(xu.w << 16), __uint_as_float(xu.w & 0xffff0000u)}; }
                        const f32x4 y0 = x0 + g0 * acc[ai][bj][m][0], y1 = x1 + g1 * acc[ai][bj][m][1];
                        v4u w; w.x = pk2(y0[0], y0[1]); w.y = pk2(y0[2], y0[3]); w.z = pk2(y1[0], y1[1]); w.w = pk2(y1[2], y1[3]);
                        ST16L(4, u.last, ob + off, w);
                    }
            }
        } else if constexpr (MODE == 5) {
            float* const part = (float*)(ws_ + WS_PART) + (size_t)u.last * ((size_t)MCTX * D);
#pragma unroll
            for (int bj = 0; bj < 2; ++bj) {
                const int col = colb + bj * 128;
#pragma unroll
                for (int ai = 0; ai < 2; ++ai)
#pragma unroll
                    for (int m = 0; m < 4; ++m) {
                        const size_t off = (size_t)(row0 + ai * 128 + m * 16 - MLAT) * D + col;
                        __builtin_nontemporal_store(acc[ai][bj][m][0], (f32x4*)(part + off)); __builtin_nontemporal_store(acc[ai][bj][m][1], (f32x4*)(part + off + 4));
                    }
            }
        } else {
#pragma unroll
            for (int ai = 0; ai < 2; ++ai)
#pragma unroll
                for (int m = 0; m < 4; ++m) {
                    const size_t row = (size_t)(row0 + ai * 128 + m * 16);
#pragma unroll
                    for (int bj = 0; bj < 2; ++bj) {
                        const f32x4 v0 = acc[ai][bj][m][0], v1 = acc[ai][bj][m][1];
                        const int col = colb + bj * 128;
                        v4u w; w.x = pk_f16(v0[0], v0[1]); w.y = pk_f16(v0[2], v0[3]); w.z = pk_f16(v1[0], v1[1]); w.w = pk_f16(v1[2], v1[3]);
                        u16* dst = (u.pn < 11) ? ((u16*)(ws_ + WS_GATEB) + row * FF + col) : ((u16*)(ws_ + WS_VALB) + row * FF + (col - FF));
                        if ((LASTNT) & 64) ST16L(64, u.last, dst, w); else ST_NT((v4u*)dst, w);
                    }
                }
        }
    }
};

struct Frame {
    LAS unsigned char* lds;
    volatile LAS unsigned* MISC;
    gu32* ctl;
    int tid, lane, wave, vcu, G;
    float* out;
    unsigned char* ws;
};
#define PHASE_BEGIN(F) do { (F).lane = fresh_lane(); (F).tid = (F).wave * 64 + (F).lane; } while (0)

__device__ __forceinline__ void p0_mod(Frame& F, const float* cvec, const float* cctx, const float* adaw, const float* adab) {
    PHASE_BEGIN(F);
    LAS float* sl = (LAS float*)(F.lds);
    LAS float* red = (LAS float*)(F.lds + 20480);
    float* mod = (float*)(F.ws + WS_MOD);
    const int nchunk = NL * (NMOD / 64);
    if ((int)blockIdx.x >= nchunk) return;
    for (int i = F.tid; i < 5 * 1024; i += NWAVES * 64) { const int s = i >> 10, k = i & 1023; const float c = (s < 4) ? cvec[s * 1024 + k] : cctx[k]; sl[i] = siluf_(c); }
    __syncthreads();
    for (int ci = blockIdx.x; ci < nchunk; ci += F.G) {
        const int l = ci / (NMOD / 64), n = (ci % (NMOD / 64)) * 64 + F.lane;
        const float* w = adaw + (size_t)l * D * NMOD + n;
        float acc[5] = {0.f, 0.f, 0.f, 0.f, 0.f};
        const int k0 = F.wave * 128;
#pragma unroll 1
        for (int k = k0; k < k0 + 128; k += 32) {
            float wv[32];
#pragma unroll
            for (int u = 0; u < 32; ++u) wv[u] = w[(size_t)(k + u) * NMOD];
#pragma unroll
            for (int u = 0; u < 32; ++u)
#pragma unroll
                for (int s = 0; s < 5; ++s) acc[s] += sl[s * 1024 + k + u] * wv[u];
        }
#pragma unroll
        for (int s = 0; s < 5; ++s) red[(F.wave * 5 + s) * 64 + F.lane] = acc[s];
        __syncthreads();
        if (F.tid < 320) { const int s = F.tid >> 6, ln = F.tid & 63; float t = 0.f;
#pragma unroll
            for (int w8 = 0; w8 < 8; ++w8) t += red[(w8 * 5 + s) * 64 + ln];
            const int nn = (ci % (NMOD / 64)) * 64 + ln;
            mod[((size_t)l * 5 + s) * NMOD + nn] = t + adab[l * NMOD + nn]; }
        __syncthreads();
    }
}
__device__ __forceinline__ void p0_transpose_item(const float* W, int K, int N, u16* WT, LAS float* scr, int item, int lane, const bool perm_in = false) {
    const int nblk = N / 32, kb = item / nblk, nb = item % nblk, k0 = 64 * kb, n0 = 32 * nb;
    int d0 = n0;
    if (perm_in && n0 >= 512 && n0 < 1536) { const int isx = n0 >= 1024, c = n0 - (isx ? 1024 : 512); d0 = 512 + 256 * (c >> 7) + 128 * isx + (c & 127); }
    { float wv[32];
#pragma unroll
      for (int i = 0; i < 32; ++i) { const int kk = 2 * i + (lane >> 5); wv[i] = W[(size_t)(k0 + kk) * N + n0 + (lane & 31)]; }
#pragma unroll
      for (int i = 0; i < 32; ++i) { const int kk = 2 * i + (lane >> 5); scr[kk * 33 + (lane & 31)] = wv[i]; } }
    LDS_WAIT(); asm volatile("" ::: "memory");
    const int c = lane & 7;
#pragma unroll
    for (int j = 0; j < 4; ++j) { const int n = (lane >> 3) + 8 * j; const LAS float* s = scr + (8 * c) * 33 + n;
        v4u o; o.x = pk2(s[0 * 33], s[1 * 33]); o.y = pk2(s[2 * 33], s[3 * 33]); o.z = pk2(s[4 * 33], s[5 * 33]); o.w = pk2(s[6 * 33], s[7 * 33]);
        *(GAS v4u*)(WT + (size_t)(d0 + n) * K + k0 + 8 * c) = o; }
    LDS_WAIT(); asm volatile("" ::: "memory");
}
__device__ __forceinline__ void p0_weights(Frame& F, const float* win, const float* wout, const float* fup, const float* fdn, const float* wup, const float* aup, const float* gup) {
    PHASE_BEGIN(F);
    LAS float* scr = (LAS float*)(F.lds + 32768 + F.wave * 8704);
    const int gw = F.vcu * NWAVES + F.wave, NGW = F.G * NWAVES;
    constexpr int I_IN = (D / 64) * (PROJ / 32), I_OUT = (D / 64) * (D / 32), I_UP = (D / 64) * (2 * FF / 32), I_DN = (FF / 64) * (D / 32);
    constexpr int PER_L = I_IN + I_OUT + I_UP + I_DN;
    for (int it = gw; it < NL * PER_L; it += NGW) {
        const int l = it / PER_L; int r = it % PER_L;
        if (r < I_IN) { p0_transpose_item(win + (size_t)l * D * PROJ, D, PROJ, (u16*)(F.ws + WS_WIN) + (size_t)l * PROJ * D, scr, r, F.lane, true); continue; } r -= I_IN;
        if (r < I_OUT) { p0_transpose_item(wout + (size_t)l * D * D, D, D, (u16*)(F.ws + WS_WOUT) + (size_t)l * D * D, scr, r, F.lane); continue; } r -= I_OUT;
        if (r < I_UP) { p0_transpose_item(fup + (size_t)l * D * 2 * FF, D, 2 * FF, (u16*)(F.ws + WS_WUP) + (size_t)l * 2 * FF * D, scr, r, F.lane); continue; } r -= I_UP;
        p0_transpose_item(fdn + (size_t)l * FF * D, FF, D, (u16*)(F.ws + WS_WDN) + (size_t)l * D * FF, scr, r, F.lane);
    }
    const int gt = F.vcu * NWAVES * 64 + F.tid, NGT = F.G * NWAVES * 64;
    u16* bl = (u16*)(F.ws + WS_BLORA);
    for (int e = gt; e < NL * NLORA * (KLORA / 8); e += NGT) {
        const int kc = e % (KLORA / 8), n = (e / (KLORA / 8)) % NLORA, l = e / ((KLORA / 8) * NLORA);
        float f[8];
#pragma unroll
        for (int j = 0; j < 8; ++j) { const int k = kc * 8 + j; float v = 0.f;
            if (n < 1024) { if (k < 64) v = wup[(((size_t)l * 2 + (n >> 9)) * 64 + k) * 512 + (n & 511)]; }
            else if (n < 2048) { if (k >= 64 && k < 128) v = aup[(((size_t)l * 2 + ((n - 1024) >> 9)) * 64 + (k - 64)) * 512 + (n & 511)]; }
            else { if (k >= 128) v = gup[((size_t)l * 128 + (k - 128)) * 512 + (n - 2048)]; }
            f[j] = v; }
        v4u o; o.x = pk2(f[0], f[1]); o.y = pk2(f[2], f[3]); o.z = pk2(f[4], f[5]); o.w = pk2(f[6], f[7]);
        *(v4u*)(bl + ((size_t)l * NLORA + n) * KLORA + kc * 8) = o;
    }
}
template <int NS> __device__ __forceinline__ void norm_ctx_fix(Frame& F, const float* xin32, u16* xcb, const float* gate4, const float* g, const float* modl, int sh_off, int sc_off) {
    const int gw = F.vcu * NWAVES + F.wave, NGW = F.G * NWAVES;
    u16* XN = (u16*)(F.ws + WS_XN);
    const float* part = (const float*)(F.ws + WS_PART);
    for (int rc = gw; rc < MCTX; rc += NGW) {
        pg8::f32x4 v[4]; float ss = 0.f;
#pragma unroll
        for (int jp = 0; jp < 2; ++jp) {
            pg8::f32x4 pv[2][NS], x[2], gt[2];
#pragma unroll
            for (int e = 0; e < 2; ++e) { const int col = 4 * F.lane + 256 * (2 * jp + e);
#pragma unroll
                for (int sp = 0; sp < NS; ++sp) pv[e][sp] = *(const pg8::f32x4*)(part + ((size_t)sp * MCTX + rc) * D + col);
                gt[e] = *(const pg8::f32x4*)(gate4 + col);
                if (xin32) x[e] = *(const pg8::f32x4*)(xin32 + (size_t)rc * D + col);
                else { const v2u xu = *(const v2u*)(xcb + (size_t)rc * D + col); x[e] = (pg8::f32x4){__uint_as_float(xu.x << 16), __uint_as_float(xu.x & 0xffff0000u), __uint_as_float(xu.y << 16), __uint_as_float(xu.y & 0xffff0000u)}; } }
#pragma unroll
            for (int e = 0; e < 2; ++e) { const int j = 2 * jp + e, col = 4 * F.lane + 256 * j;
                pg8::f32x4 sm = pv[e][0];
#pragma unroll
                for (int sp = 1; sp < NS; ++sp) sm = sm + pv[e][sp];
                const pg8::f32x4 y = x[e] + gt[e] * sm;
                v2u o; o.x = pk2(y[0], y[1]); o.y = pk2(y[2], y[3]);
                *(v2u*)(xcb + (size_t)rc * D + col) = o;
                v[j] = (pg8::f32x4){__uint_as_float(o.x << 16), __uint_as_float(o.x & 0xffff0000u), __uint_as_float(o.y << 16), __uint_as_float(o.y & 0xffff0000u)};
                ss += (v[j][0] * v[j][0] + v[j][1] * v[j][1]) + (v[j][2] * v[j][2] + v[j][3] * v[j][3]); }
        }
        const float rstd = rsqrtf(wave_sum(ss) * (1.0f / D) + RMS_EPS);
        const float* shp = modl + 4 * NMOD + sh_off; const float* scp = modl + 4 * NMOD + sc_off;
#pragma unroll
        for (int j = 0; j < 4; ++j) {
            const pg8::f32x4 gv = *(const pg8::f32x4*)(g + 4 * F.lane + 256 * j);
            const pg8::f32x4 sh = *(const pg8::f32x4*)(shp + 4 * F.lane + 256 * j), sc = *(const pg8::f32x4*)(scp + 4 * F.lane + 256 * j);
            const pg8::f32x4 y = (v[j] * rstd) * gv;
            const pg8::f32x4 h = y * (sc + 1.0f) + sh;
            v2u o; o.x = pk2(h[0], h[1]); o.y = pk2(h[2], h[3]);
            *(v2u*)(XN + (size_t)(MLAT + rc) * D + 4 * F.lane + 256 * j) = o;
        }
    }
}
__device__ __forceinline__ void norm_rows(Frame& F, const float* xl, const float* xc, const bool bf, const float* g, const float* modl, int sh_off, int sc_off, int nrows) {
    PHASE_BEGIN(F);
    const int gw = F.vcu * NWAVES + F.wave, NGW = F.G * NWAVES;
    u16* XN = (u16*)(F.ws + WS_XN);
    pg8::f32x4 gv[4];
#pragma unroll
    for (int j = 0; j < 4; ++j) gv[j] = *(const pg8::f32x4*)(g + 4 * F.lane + 256 * j);
#define NR_LOAD(r_, PF_, PB_) do { const int rr_ = (r_); \
        if (bf) { const u16* p16_ = (rr_ < MLAT) ? ((const u16*)xl + (size_t)rr_ * D) : ((const u16*)xc + (size_t)(rr_ - MLAT) * D); \
            _Pragma("unroll") for (int j = 0; j < 4; ++j) PB_[j] = *(const v2u*)(p16_ + 4 * F.lane + 256 * j); } \
        else { const float* p32_ = (rr_ < MLAT) ? (xl + (size_t)rr_ * D) : (xc + (size_t)(rr_ - MLAT) * D); \
            _Pragma("unroll") for (int j = 0; j < 4; ++j) PF_[j] = *(const pg8::f32x4*)(p32_ + 4 * F.lane + 256 * j); } } while (0)
    pg8::f32x4 cf[4], nf[4]; v2u cb2[4], nb2[4];
#pragma unroll
    for (int j = 0; j < 4; ++j) { cf[j] = (pg8::f32x4){0.f, 0.f, 0.f, 0.f}; nf[j] = cf[j]; cb2[j] = (v2u){0u, 0u}; nb2[j] = cb2[j]; }
    int r = gw;
    if (r < nrows) NR_LOAD(r, cf, cb2);
    for (; r < nrows; r += NGW) {
        if (r + NGW < nrows) NR_LOAD(r + NGW, nf, nb2);
        const int s = (r < MLAT) ? (r >> 13) : 4;
        pg8::f32x4 v[4]; float ss = 0.f;
#pragma unroll
        for (int j = 0; j < 4; ++j) {
            if (bf) { const v2u xu = cb2[j]; v[j] = (pg8::f32x4){__uint_as_float(xu.x << 16), __uint_as_float(xu.x & 0xffff0000u), __uint_as_float(xu.y << 16), __uint_as_float(xu.y & 0xffff0000u)}; }
            else v[j] = cf[j];
            ss += (v[j][0] * v[j][0] + v[j][1] * v[j][1]) + (v[j][2] * v[j][2] + v[j][3] * v[j][3]); }
        const float rstd = rsqrtf(wave_sum(ss) * (1.0f / D) + RMS_EPS);
        const float* shp = modl + s * NMOD + sh_off; const float* scp = modl + s * NMOD + sc_off;
#pragma unroll
        for (int j = 0; j < 4; ++j) {
            const pg8::f32x4 sh = *(const pg8::f32x4*)(shp + 4 * F.lane + 256 * j), sc = *(const pg8::f32x4*)(scp + 4 * F.lane + 256 * j);
            const pg8::f32x4 y = (v[j] * rstd) * gv[j];
            const pg8::f32x4 h = y * (sc + 1.0f) + sh;
            v2u o; o.x = pk2(h[0], h[1]); o.y = pk2(h[2], h[3]);
            *(v2u*)(XN + (size_t)r * D + 4 * F.lane + 256 * j) = o;
        }
#pragma unroll
        for (int j = 0; j < 4; ++j) { cf[j] = nf[j]; cb2[j] = nb2[j]; }
    }
#undef NR_LOAD
}
__device__ __forceinline__ void conv_branch(Frame& F, const float* cw, int nrows) {
    PHASE_BEGIN(F);
    const int gw = F.vcu * NWAVES + F.wave, NGW = F.G * NWAVES;
    const u16* Pc = (const u16*)(F.ws + WS_PC); u16* A2 = (u16*)(F.ws + WS_XN);
    const int c0 = 8 * F.lane;
    float w0[8], w1[8], w2[8];
    {
#pragma unroll
      for (int j = 0; j < 8; ++j) { w0[j] = cw[c0 + j]; w1[j] = cw[DC + c0 + j]; w2[j] = cw[2 * DC + c0 + j]; } }
    for (int r = gw; r < nrows; r += NGW) {
        int t, len; if (r < MLAT) { t = r & (T - 1); len = T; } else { t = (r - MLAT) & (TC - 1); len = TC; }
        const u16* p = Pc + (size_t)r * 1536 + c0;
        const v4u ucb = *(const v4u*)p, uu = *(const v4u*)(p + 512);
        v4u pu = {0u, 0u, 0u, 0u}, nu = pu;
        if (t > 0) pu = *(const v4u*)(p - 1536 + 512);
        if (t < len - 1) nu = *(const v4u*)(p + 1536 + 512);
        float cb[8], uc[8], up[8], un[8], o[8];
        unpk8_f16(ucb, cb); unpk8_f16(uu, uc); unpk8_f16(pu, up); unpk8_f16(nu, un);
#pragma unroll
        for (int j = 0; j < 8; ++j) o[j] = cb[j] * (w0[j] * up[j] + w1[j] * uc[j] + w2[j] * un[j]);
        v4u w; w.x = pk2(o[0], o[1]); w.y = pk2(o[2], o[3]); w.z = pk2(o[4], o[5]); w.w = pk2(o[6], o[7]);
        if (((LASTNT) & 32) && r + 2 * NGW >= nrows) __builtin_nontemporal_store(w, (v4u*)(A2 + (size_t)r * D + c0)); else *(v4u*)(A2 + (size_t)r * D + c0) = w;
    }
}
__device__ __forceinline__ void rwkv_out(Frame& F, const float* lng, const float* lnb, const float* rkp, int nrows) {
    PHASE_BEGIN(F);
    const int gw = F.vcu * NWAVES + F.wave, NGW = F.G * NWAVES;
    const u16* Y = (const u16*)(F.ws + WS_PC); const u16* Prkv = (const u16*)(F.ws + WS_PRKV); const u16* GATE = (const u16*)(F.ws + WS_GATE);
    u16* A2 = (u16*)(F.ws + WS_XN);
    const int c0 = 8 * F.lane;
    float lg[8], lb[8], rk[8];
#pragma unroll
    for (int j = 0; j < 8; ++j) { lg[j] = lng[c0 + j]; lb[j] = lnb[c0 + j]; rk[j] = rkp[c0 + j]; }
    for (int r = gw; r < nrows; r += NGW) {
        const v4u uy0 = *(const v4u*)(Y + (size_t)r * 1024 + c0), uy1 = *(const v4u*)(Y + (size_t)r * 1024 + 512 + c0);
        const u16* p = Prkv + (size_t)r * 1536 + c0;
        const v4u ur = *(const v4u*)p, uk = *(const v4u*)(p + 512), uv = *(const v4u*)(p + 1024);
        const v4u ug = *(const v4u*)(GATE + (size_t)r * 512 + c0);
        float y0[8], y1[8], rr[8], kk[8], vv[8], gg[8], y[8], o[8];
        unpk8_f16(uy0, y0); unpk8_f16(uy1, y1); unpk8_f16(ur, rr); unpk8_f16(uk, kk); unpk8_f16(uv, vv); unpk8_f16(ug, gg);
        float s = 0.f, bs = 0.f;
#pragma unroll
        for (int j = 0; j < 8; ++j) { y[j] = y0[j] + y1[j]; s += y[j]; bs += rr[j] * kk[j] * rk[j]; }
        const float mu = group8_sum(s) * (1.0f / 64.0f); bs = group8_sum(bs);
        float q = 0.f;
#pragma unroll
        for (int j = 0; j < 8; ++j) { const float dd = y[j] - mu; q += dd * dd; }
        const float rstd = rsqrtf(group8_sum(q) * (1.0f / 64.0f) + GN_EPS);
#pragma unroll
        for (int j = 0; j < 8; ++j) o[j] = (((y[j] - mu) * rstd) * lg[j] + lb[j] + bs * vv[j]) * gg[j];
        v4u w; w.x = pk2(o[0], o[1]); w.y = pk2(o[2], o[3]); w.z = pk2(o[4], o[5]); w.w = pk2(o[6], o[7]);
        if (((LASTNT) & 32) && r + 2 * NGW >= nrows) __builtin_nontemporal_store(w, (v4u*)(A2 + (size_t)r * D + 512 + c0)); else *(v4u*)(A2 + (size_t)r * D + 512 + c0) = w;
    }
}
namespace ck {
typedef float f32x16 __attribute__((ext_vector_type(16)));
typedef short bf16x8 __attribute__((ext_vector_type(8)));
constexpr int C = 64, PITCH = 144, SLOT = 64 * PITCH;
constexpr int NCHUNK = (TC + T) / C;
constexpr int NQ = 4, CPQ = NCHUNK / NQ;
static_assert(NCHUNK % NQ == 0, "quarters");
constexpr size_t WS_HZ = WS_ALORA;
constexpr size_t WS_GC = WS_ALORA + 4 * MiB;
static_assert(WS_GC + 256 * 8192 <= WS_DEC, "map");
enum { S_KK = 0, S_KT = 1, S_BT = 2, S_RT = 3, S_KKT = 4, S_KTT = 5, S_BTT = 6, S_VT = 7, S_AKK = 8, S_ARK = 9, S_ARB = 10, S_T = 11, S_TT = 12, S_LB = 13, S_AREA = 14 };
enum { S_X1T = S_KK, S_NW1T = S_KT, S_NU0T = S_BT, S_GIMG = S_KTT, S_PIMG = S_VT };
constexpr int AREA_OFF = S_AREA * SLOT;
constexpr int LP = 64;
constexpr int GC_OFF = AREA_OFF + 16384, SEG_OFF = S_LB * SLOT  , END_OFF = GC_OFF + 256;
static_assert(64 * LP * 4 <= 16384 && END_OFF <= LDSCTL_OFF && 8 * 64 * 4 <= SLOT, "chunk-scan LDS map");
#define CK_BAR() do { asm volatile("s_waitcnt lgkmcnt(0)" ::: "memory"); __builtin_amdgcn_s_barrier(); asm volatile("" ::: "memory"); } while (0)
typedef __bf16 bf2_t __attribute__((ext_vector_type(2)));
__device__ __forceinline__ unsigned cvtpk(float lo, float hi) { bf2_t v; v.x = (__bf16)lo; v.y = (__bf16)hi; return __builtin_bit_cast(unsigned, v); }
__device__ __forceinline__ LAS unsigned char* slot(LAS unsigned char* lds, int s) { return lds + s * SLOT; }
template <int KS> __device__ __forceinline__ void tile_mma(f32x16& acc, const LAS unsigned char* A, int arow0, const LAS unsigned char* B, int brow0, int lane, int kb = 0) {
    const int r = lane & 31, h = lane >> 5;
    const LAS unsigned char* pa = A + (arow0 + r) * PITCH + (kb + 8 * h) * 2; const LAS unsigned char* pb = B + (brow0 + r) * PITCH + (kb + 8 * h) * 2;
    bf16x8 a[KS], b[KS];
#pragma unroll
    for (int s = 0; s < KS; ++s) { a[s] = *(const LAS bf16x8*)(pa + 32 * s); b[s] = *(const LAS bf16x8*)(pb + 32 * s); }
    __builtin_amdgcn_sched_barrier(0);
#pragma unroll
    for (int s = 0; s < KS; ++s) acc = __builtin_amdgcn_mfma_f32_32x32x16_bf16(a[s], b[s], acc, 0, 0, 0);
}
template <int KS> __device__ __forceinline__ void tile_mma2(f32x16& acc0, f32x16& acc1, const LAS unsigned char* A0, int arow0, const LAS unsigned char* B0, int brow0, const LAS unsigned char* A1, int arow1, const LAS unsigned char* B1, int brow1, int lane) {
    const int r = lane & 31, h = lane >> 5;
    const LAS unsigned char* pa0 = A0 + (arow0 + r) * PITCH + (8 * h) * 2; const LAS unsigned char* pb0 = B0 + (brow0 + r) * PITCH + (8 * h) * 2;
    const LAS unsigned char* pa1 = A1 + (arow1 + r) * PITCH + (8 * h) * 2; const LAS unsigned char* pb1 = B1 + (brow1 + r) * PITCH + (8 * h) * 2;
    bf16x8 a0[KS], b0[KS], a1[KS], b1[KS];
#pragma unroll
    for (int s = 0; s < KS; ++s) { a0[s] = *(const LAS bf16x8*)(pa0 + 32 * s); b0[s] = *(const LAS bf16x8*)(pb0 + 32 * s); a1[s] = *(const LAS bf16x8*)(pa1 + 32 * s); b1[s] = *(const LAS bf16x8*)(pb1 + 32 * s); }
    __builtin_amdgcn_sched_barrier(0);
#pragma unroll
    for (int s = 0; s < KS; ++s) { acc0 = __builtin_amdgcn_mfma_f32_32x32x16_bf16(a0[s], b0[s], acc0, 0, 0, 0); acc1 = __builtin_amdgcn_mfma_f32_32x32x16_bf16(a1[s], b1[s], acc1, 0, 0, 0); }
}
__device__ __forceinline__ int acc_row(int i, int lane) { return (i & 3) + 8 * (i >> 2) + 4 * (lane >> 5); }
__device__ __forceinline__ f32x16 zero16() { float z; asm volatile("v_mov_b32 %0, 0" : "=v"(z)); f32x16 r; _Pragma("unroll") for (int i = 0; i < 16; ++i) r[i] = z; return r; }
__device__ __forceinline__ unsigned pair_xchg(unsigned p, int lane) {
    const unsigned q = (unsigned)__builtin_amdgcn_update_dpp(0, (int)p, 0xB1, 0xF, 0xF, true);
    return __builtin_amdgcn_perm(q, p, (lane & 1) ? 0x03020706u : 0x05040100u);
}
__device__ __forceinline__ void st_rm(const f32x16& acc, LAS unsigned char* M, int row0, int col0, int lane, float sgn = 1.f) {
#pragma unroll
    for (int i = 0; i < 16; i += 2) {
        const unsigned p = cvtpk(sgn * acc[i], sgn * acc[i + 1]);
        *(LAS unsigned*)(M + (row0 + acc_row(i, lane) + (lane & 1)) * PITCH + (col0 + (lane & 30)) * 2) = pair_xchg(p, lane);
    }
}
__device__ __forceinline__ void st_tr(const f32x16& acc, LAS unsigned char* M, int row0, int col0, int lane, float sgn = 1.f) {
#pragma unroll
    for (int g = 0; g < 4; ++g) {
        v2u w; w.x = cvtpk(sgn * acc[4 * g], sgn * acc[4 * g + 1]); w.y = cvtpk(sgn * acc[4 * g + 2], sgn * acc[4 * g + 3]);
        *(LAS v2u*)(M + (col0 + (lane & 31)) * PITCH + (row0 + 8 * g + 4 * (lane >> 5)) * 2) = w;
    }
}
__device__ __forceinline__ void st_rm_q10(const f32x16& acc, LAS unsigned char* M, int row0, int col0, int lane, float sgn = 1.f) {
    if ((lane & 31) < 16) {
#pragma unroll
        for (int i = 8; i < 16; i += 2) {
            const unsigned p = cvtpk(sgn * acc[i], sgn * acc[i + 1]);
            *(LAS unsigned*)(M + (row0 + acc_row(i, lane) + (lane & 1)) * PITCH + (col0 + (lane & 30)) * 2) = pair_xchg(p, lane);
        }
    }
}
__device__ __forceinline__ void st_tr_q10(const f32x16& acc, LAS unsigned char* M, int row0, int col0, int lane, float sgn = 1.f) {
    if ((lane & 31) < 16) {
#pragma unroll
        for (int g = 2; g < 4; ++g) {
            v2u w; w.x = cvtpk(sgn * acc[4 * g], sgn * acc[4 * g + 1]); w.y = cvtpk(sgn * acc[4 * g + 2], sgn * acc[4 * g + 3]);
            *(LAS v2u*)(M + (col0 + (lane & 31)) * PITCH + (row0 + 8 * g + 4 * (lane >> 5)) * 2) = w;
        }
    }
}
__device__ __forceinline__ void st_img(const f32x16& acc, LAS unsigned char* img, int idx, int lane) {
#pragma unroll
    for (int s = 0; s < 2; ++s) {
        v4u w; w.x = cvtpk(acc[8 * s], acc[8 * s + 1]); w.y = cvtpk(acc[8 * s + 2], acc[8 * s + 3]); w.z = cvtpk(acc[8 * s + 4], acc[8 * s + 5]); w.w = cvtpk(acc[8 * s + 6], acc[8 * s + 7]);
        *(LAS v4u*)(img + ((idx * 2 + s) * 64 + lane) * 16) = w;
    }
}
__device__ __forceinline__ bf16x8 acc_frag(const f32x16& acc, int s) {
    v4u w; w.x = cvtpk(acc[8 * s], acc[8 * s + 1]); w.y = cvtpk(acc[8 * s + 2], acc[8 * s + 3]); w.z = cvtpk(acc[8 * s + 4], acc[8 * s + 5]); w.w = cvtpk(acc[8 * s + 6], acc[8 * s + 7]);
    return __builtin_bit_cast(bf16x8, w);
}
template <int P, int TIX> __device__ __forceinline__ void s1_post(f32x16& acc, LAS unsigned char* lds, int lane) {
    constexpr int ti = (TIX == 0) ? 0 : 1, tj = (TIX == 2) ? 1 : 0;
    if (TIX != 1) {
        const int x = (lane & 31) - 4 * (lane >> 5);
#pragma unroll
        for (int i = 0; i < 16; ++i) { const int ci = (i & 3) + 8 * (i >> 2); const bool keep = (P >= 2) ? (x <= ci) : (x < ci); acc[i] = keep ? acc[i] : 0.f; }
    }
    if (P == 1) {
        LAS float* Lf = (LAS float*)(lds + AREA_OFF) + (32 * ti + 4 * (lane >> 5)) * LP + 32 * tj + (lane & 31);
#pragma unroll
        for (int i = 0; i < 16; ++i) Lf[((i & 3) + 8 * (i >> 2)) * LP] = acc[i];
        if (TIX == 1) st_rm(acc, lds + S_LB * SLOT, 32, 0, lane);
        else st_rm_q10(acc, lds + S_LB * SLOT, 32 * ti, 32 * tj, lane);
    } else st_rm(acc, lds + ((P == 0) ? S_AKK : (P == 2) ? S_ARK : S_ARB) * SLOT, 32 * ti, 32 * tj, lane);
}
template <int PB, int TIX> __device__ __forceinline__ void s1_pair(LAS unsigned char* lds, int lane) {
    constexpr int ti = (TIX == 0) ? 0 : 1, tj = (TIX == 2) ? 1 : 0;
    const LAS unsigned char* B = lds + ((PB & 1) ? S_BT : S_KT) * SLOT;
    f32x16 acc0 = {}, acc1 = {};
    tile_mma2<4>(acc0, acc1, lds + S_KK * SLOT, 32 * ti, B, 32 * tj, lds + S_RT * SLOT, 32 * ti, B, 32 * tj, lane);
    s1_post<PB, TIX>(acc0, lds, lane); s1_post<PB + 2, TIX>(acc1, lds, lane);
}
__device__ __forceinline__ void s3_tile(LAS unsigned char* lds, int q, int lane) {
    const int p = q >> 2, ti = (q >> 1) & 1, tj = q & 1;
    f32x16 acc = {};
    tile_mma<4>(acc, lds + (p ? S_X1T : S_KKT) * SLOT, 32 * ti, lds + S_T * SLOT, 32 * tj, lane);
    st_rm(acc, lds + (p ? S_NU0T : S_NW1T) * SLOT, 32 * ti, 32 * tj, lane, -1.f);
}
struct InRegs { v4u k, r, dec, a, v; };
__device__ __forceinline__ int scan_row(int b, int d, int p) {
    if (p < TC) { const int tc = d ? (TC - 1 - p) : p; return MLAT + b * TC + tc; }
    const int q = p - TC; const int tl = d ? (T - 1 - q) : q; return b * T + tl;
}
__device__ __forceinline__ void load_chunk(Frame& F, InRegs& R, int b, int h, int d, int chunk) {
    const int t = fresh_lane(), cg = F.wave;
    int ch = chunk; if (ch >= NCHUNK) ch = NCHUNK - 1;
    const int row = scan_row(b, d, ch * C + t);
    const u16* Prkv = (const u16*)(F.ws + WS_PRKV) + (size_t)row * 1536 + h * 64 + 8 * cg;
    R.r = *(const v4u*)(Prkv); R.k = *(const v4u*)(Prkv + 512); R.v = *(const v4u*)(Prkv + 1024);
    R.dec = *(const v4u*)((const u16*)(F.ws + WS_DEC) + (size_t)row * 1024 + d * 512 + h * 64 + 8 * cg);
    R.a = *(const v4u*)((const u16*)(F.ws + WS_AA) + (size_t)row * 1024 + d * 512 + h * 64 + 8 * cg);
}
}
__device__ __forceinline__ void scan_phase(Frame& F, const float* kkp, const float* kap) {
    using namespace ck;
    PHASE_BEGIN(F);
    LAS unsigned char* const lds = F.lds;
    const int wave = F.wave; int lane = F.lane, tid = F.tid;
    { unsigned z0; asm volatile("v_mov_b32 %0, 0" : "=v"(z0));
      for (int i = tid; i < 6 * SLOT / 16; i += NWAVES * 64) *(LAS v4u*)(lds + S_AKK * SLOT + i * 16) = (v4u){z0, z0, z0, z0}; }
    CK_BAR();
    for (int unit = F.vcu; unit < 64 * NQ; unit += F.G) {
        const int combo = unit >> 2, qq = unit & 3;
        const int b = combo >> 4, h = (combo >> 1) & 7, d = combo & 1;
        int t_ = lane; const int cg = wave;
        float kkw[8], kaw[8];
#pragma unroll
        for (int j = 0; j < 8; ++j) { kkw[j] = kkp[h * 64 + 8 * cg + j]; kaw[j] = kap[h * 64 + 8 * cg + j]; }
        InRegs R; load_chunk(F, R, b, h, d, qq * CPQ);
        InRegs R2 = R;
        f32x16 H0a = {}, H0b = {};
        if (wave == 2 || wave == 3) {
            const int l2 = fresh_lane();
#pragma unroll
            for (int i = 0; i < 16; ++i) { const float e = (acc_row(i, l2) == (l2 & 31)) ? 1.f : 0.f; if (wave == 2) H0a[i] = e; else H0b[i] = e; }
        }
        unsigned pend[16];
#define CK_YSTORE(cc_) do { const int ly = fresh_lane(); \
              \
            u16* Yg = (wave < 2) ? (u16*)(F.ws + WS_PC) + d * 512 + h * 64 + 32 * wave                         \
                                 : (u16*)(F.ws + WS_DEC) + d * 512 + h * 64 + 32 * (wave - 2);                  \
            const long st_ = d ? -1024 : 1024; \
            Yg += (long)scan_row(b, d, (cc_) * C) * 1024 + st_ * (ly & 31) + 4 * (ly >> 5); \
            _Pragma("unroll") for (int tt_ = 0; tt_ < 2; ++tt_) _Pragma("unroll") for (int g = 0; g < 4; ++g) \
                *(v2u*)(Yg + st_ * 32 * tt_ + 8 * g) = (v2u){pend[8 * tt_ + 2 * g], pend[8 * tt_ + 2 * g + 1]}; } while (0)
        for (int c = qq * CPQ; c < (qq + 1) * CPQ; ++c) {
            lane = fresh_lane(); tid = wave * 64 + lane; t_ = lane;
            if (DUPS & 64) asm volatile("" :: "v"(R2.k), "v"(R2.r), "v"(R2.dec), "v"(R2.a), "v"(R2.v));
            float w[8], a[8], k[8], r[8], v[8];
            unpk8_f16(R.dec, w); unpk8_f16(R.a, a); unpk8_f16(R.k, k); unpk8_f16(R.r, r); unpk8_f16(R.v, v);
            if (wave < 4 && c > qq * CPQ) CK_YSTORE(c - 1);
            typedef float f4 __attribute__((ext_vector_type(4)));
            LAS float* SS = (LAS float*)(lds + AREA_OFF);
            float g[8], gp[8], kk[8], ss = 0.f;
#pragma unroll
            for (int j = 0; j < 8; ++j) {
                float x = w[j];
                x *= dpp1<0x111, 0xF>(x); x *= dpp1<0x112, 0xF>(x); x *= dpp1<0x114, 0xF>(x); x *= dpp1<0x118, 0xF>(x);
                x *= dpp1<0x142, 0xA>(x);
                x *= dpp1<0x143, 0xC>(x);
                g[j] = x; gp[j] = dpp1<0x138, 0xF>(x);
                kk[j] = k[j] * kkw[j]; ss += kk[j] * kk[j];
            }
            SS[cg * 64 + t_] = ss;
            if (t_ == 63) { *(LAS f4*)((LAS float*)(lds + GC_OFF) + 8 * cg) = (f4){g[0], g[1], g[2], g[3]}; *(LAS f4*)((LAS float*)(lds + GC_OFF) + 8 * cg + 4) = (f4){g[4], g[5], g[6], g[7]}; }
            CK_BAR();
#pragma unroll 1
            for (int rp_ = 0; rp_ < ((DUPS & 2) ? 2 : 1); ++rp_) {
                float tot = 0.f;
#pragma unroll
                for (int q = 0; q < 8; ++q) tot += SS[q * 64 + t_];
                const float rn = rsqrtf(fmaxf(tot, 1e-24f));
                float Kk[8], Kt[8], Bt[8], Rt[8];
#pragma unroll
                for (int j = 0; j < 8; ++j) { const float kn = kk[j] * rn, rg = __builtin_amdgcn_rcpf(g[j]);
                    Kk[j] = kn * gp[j]; Kt[j] = (k[j] * (1.0f + (a[j] - 1.0f) * kaw[j])) * rg; Bt[j] = (kn * a[j]) * rg; Rt[j] = r[j] * g[j]; }
                const int ro = t_ * PITCH + 16 * cg;
                *(LAS v4u*)(lds + S_KK * SLOT + ro) = (v4u){cvtpk(Kk[0], Kk[1]), cvtpk(Kk[2], Kk[3]), cvtpk(Kk[4], Kk[5]), cvtpk(Kk[6], Kk[7])};
                *(LAS v4u*)(lds + S_KT * SLOT + ro) = (v4u){cvtpk(Kt[0], Kt[1]), cvtpk(Kt[2], Kt[3]), cvtpk(Kt[4], Kt[5]), cvtpk(Kt[6], Kt[7])};
                *(LAS v4u*)(lds + S_BT * SLOT + ro) = (v4u){cvtpk(Bt[0], Bt[1]), cvtpk(Bt[2], Bt[3]), cvtpk(Bt[4], Bt[5]), cvtpk(Bt[6], Bt[7])};
                *(LAS v4u*)(lds + S_RT * SLOT + ro) = (v4u){cvtpk(Rt[0], Rt[1]), cvtpk(Rt[2], Rt[3]), cvtpk(Rt[4], Rt[5]), cvtpk(Rt[6], Rt[7])};
#pragma unroll
                for (int j = 0; j < 8; j += 2) {
                    const unsigned pk = cvtpk(Kk[j], Kk[j + 1]), pt = cvtpk(Kt[j], Kt[j + 1]), pb = cvtpk(Bt[j], Bt[j + 1]), pv = cvtpk(v[j], v[j + 1]);
                    const int to = (8 * cg + j + (t_ & 1)) * PITCH + 2 * (t_ & 62);
                    *(LAS unsigned*)(lds + S_KKT * SLOT + to) = pair_xchg(pk, t_);
                    *(LAS unsigned*)(lds + S_KTT * SLOT + to) = pair_xchg(pt, t_);
                    *(LAS unsigned*)(lds + S_BTT * SLOT + to) = pair_xchg(pb, t_);
                    *(LAS unsigned*)(lds + S_VT * SLOT + to) = pair_xchg(pv, t_);
                }
            }
            CK_BAR();
            lane = fresh_lane();
            f32x16 accN0 = {}, accN1 = {}, accY0 = {}, accY1 = {};
            if (wave < 2) {
                const int vt = wave;
                tile_mma2<4>(accN0, accN1, lds + S_KTT * SLOT, 0, lds + S_VT * SLOT, 32 * vt, lds + S_KTT * SLOT, 32, lds + S_VT * SLOT, 32 * vt, lane);
                CK_BAR();
                load_chunk(F, R, b, h, d, c + 1);
                if (DUPS & 64) load_chunk(F, R2, b, h, d, c + 1);
                tile_mma2<4>(accY0, accY1, lds + S_VT * SLOT, 32 * vt, lds + S_ARK * SLOT, 0, lds + S_VT * SLOT, 32 * vt, lds + S_ARK * SLOT, 32, lane);
                CK_BAR();
                s3_tile(lds, wave, lane);
                CK_BAR();
                __builtin_amdgcn_s_setprio(3);
                tile_mma2<4>(accN0, accN1, lds + S_BTT * SLOT, 0, lds + S_NU0T * SLOT, 32 * vt, lds + S_BTT * SLOT, 32, lds + S_NU0T * SLOT, 32 * vt, lane);
                tile_mma2<4>(accY0, accY1, lds + S_NU0T * SLOT, 32 * vt, lds + S_ARB * SLOT, 0, lds + S_NU0T * SLOT, 32 * vt, lds + S_ARB * SLOT, 32, lane);
                { const LAS float* gcp = (const LAS float*)(lds + GC_OFF);
#pragma unroll
                  for (int i = 0; i < 16; ++i) { accN0[i] *= gcp[acc_row(i, lane)]; accN1[i] *= gcp[32 + acc_row(i, lane)]; } }
                __builtin_amdgcn_s_setprio(0);
                CK_BAR();
            } else {
                const int wi = wave - 2;
                switch (wi) {
                    case 0: s1_pair<0, 0>(lds, lane); break;
                    case 1: s1_pair<0, 1>(lds, lane); break;
                    case 2: s1_pair<0, 2>(lds, lane); break;
                    case 3: s1_pair<1, 0>(lds, lane); break;
                    case 4: s1_pair<1, 1>(lds, lane); break;
                    default: s1_pair<1, 2>(lds, lane); break;
                }
                CK_BAR();
                if (wave != 7) { load_chunk(F, R, b, h, d, c + 1); if (DUPS & 64) load_chunk(F, R2, b, h, d, c + 1); }
#pragma unroll 1
                for (int rp_ = 0; rp_ < ((DUPS & 8) ? 2 : 1); ++rp_)
                if (wave == 7) {
                    __builtin_amdgcn_s_setprio(3);
                    const int l7 = fresh_lane();
                    const int bq = l7 >> 4, j = l7 & 15;
                    const LAS float* Lf = (const LAS float*)(lds + AREA_OFF) + (16 * bq) * LP + 16 * bq;
                    float Tb[16];
#pragma unroll
                    for (int t4 = 0; t4 < 16; t4 += 4) {
                        f4 lr[4][4];
#pragma unroll
                        for (int u = 0; u < 4; ++u)
#pragma unroll
                            for (int m4 = 0; m4 < (t4 + u + 3) / 4; ++m4) lr[u][m4] = *(const LAS f4*)(Lf + (t4 + u) * LP + 4 * m4);
#pragma unroll
                        for (int u = 0; u < 4; ++u) {
                            const int t = t4 + u;
                            float acc = (j == t) ? 1.f : 0.f;
#pragma unroll
                            for (int m4 = 0; m4 < (t + 3) / 4; ++m4)
#pragma unroll
                                for (int e = 0; e < 4; ++e) if (4 * m4 + e < t) acc -= lr[u][m4][e] * Tb[4 * m4 + e];
                            asm volatile("" : "+v"(acc));
                            Tb[t] = acc;
                        }
                        asm volatile("" ::: "memory");
                    }
#pragma unroll
                    for (int t = 0; t < 16; t += 2) { const unsigned p = cvtpk(Tb[t], Tb[t + 1]);
                        LAS unsigned short* q = (LAS unsigned short*)(lds + S_T * SLOT + (16 * bq + t) * PITCH + (16 * bq + j) * 2); q[0] = (unsigned short)(p & 0xffffu); q[PITCH / 2] = (unsigned short)(p >> 16); }
#pragma unroll
                    for (int t8 = 0; t8 < 2; ++t8) *(LAS v4u*)(lds + S_TT * SLOT + (16 * bq + j) * PITCH + (16 * bq + 8 * t8) * 2) =
                        (v4u){cvtpk(Tb[8 * t8], Tb[8 * t8 + 1]), cvtpk(Tb[8 * t8 + 2], Tb[8 * t8 + 3]), cvtpk(Tb[8 * t8 + 4], Tb[8 * t8 + 5]), cvtpk(Tb[8 * t8 + 6], Tb[8 * t8 + 7])};
                    asm volatile("s_waitcnt lgkmcnt(0)" ::: "memory");
#pragma unroll
                    for (int B = 0; B < 2; ++B) {
                        f32x16 z1 = {};
                        tile_mma<1>(z1, lds + S_LB * SLOT, 32 * B, lds + S_TT * SLOT, 32 * B, lane, 32 * B);
                        st_tr_q10(z1, lds + S_TT * SLOT, 32 * B, 32 * B, lane);
                        asm volatile("s_waitcnt lgkmcnt(0)" ::: "memory");
                        f32x16 x = {};
                        tile_mma<1>(x, lds + S_T * SLOT, 32 * B, lds + S_TT * SLOT, 32 * B, lane, 32 * B + 16);
                        st_rm_q10(x, lds + S_T * SLOT, 32 * B, 32 * B, lane, -1.f);
                        if (B == 0) st_tr_q10(x, lds + S_TT * SLOT, 0, 0, lane, -1.f);
                    }
                    asm volatile("s_waitcnt lgkmcnt(0)" ::: "memory");
                    f32x16 z = {};
                    tile_mma<2>(z, lds + S_LB * SLOT, 32, lds + S_TT * SLOT, 0, lane, 0);
                    st_tr(z, lds + S_TT * SLOT, 32, 0, lane);
                    asm volatile("s_waitcnt lgkmcnt(0)" ::: "memory");
                    f32x16 tba = {};
                    tile_mma<2>(tba, lds + S_T * SLOT, 32, lds + S_TT * SLOT, 0, lane, 32);
                    st_rm(tba, lds + S_T * SLOT, 32, 0, lane, -1.f);
                    __builtin_amdgcn_s_setprio(0);
                } else if (wave < 6) {
                    const int vi = (wave - 2) >> 1, tj = (wave - 2) & 1;
                    f32x16 acc = {};
                    tile_mma<4>(acc, lds + S_VT * SLOT, 32 * vi, lds + S_AKK * SLOT, 32 * tj, lane);
                    st_rm(acc, lds + S_X1T * SLOT, 32 * vi, 32 * tj, lane);
                }
                CK_BAR();
                if (wave == 7) { load_chunk(F, R, b, h, d, c + 1); if (DUPS & 64) load_chunk(F, R2, b, h, d, c + 1); }
                s3_tile(lds, wave, lane);
                CK_BAR();
#pragma unroll 1
                for (int rp_ = 0; rp_ < ((DUPS & 32) ? 2 : 1); ++rp_)
                for (int q = wi; q < 8; q += 6) {
                    const int isphi = q >> 2, to = (q >> 1) & 1, tn = q & 1;
                    f32x16 acc = {};
                    if (isphi) {
#pragma unroll
                        for (int g = 0; g < 4; ++g) { const v2u u = *(const LAS v2u*)(lds + S_RT * SLOT + (32 * tn + (lane & 31)) * PITCH + (32 * to + 8 * g + 4 * (lane >> 5)) * 2);
                            acc[4 * g] = __uint_as_float(u.x << 16); acc[4 * g + 1] = __uint_as_float(u.x & 0xffff0000u); acc[4 * g + 2] = __uint_as_float(u.y << 16); acc[4 * g + 3] = __uint_as_float(u.y & 0xffff0000u); }
                        tile_mma<4>(acc, lds + S_NW1T * SLOT, 32 * to, lds + S_ARB * SLOT, 32 * tn, lane);
                        st_img(acc, lds + S_PIMG * SLOT, tn * 2 + to, lane);
                    } else {
                        tile_mma<4>(acc, lds + S_NW1T * SLOT, 32 * to, lds + S_BTT * SLOT, 32 * tn, lane);
                        const float gc = ((const LAS float*)(lds + GC_OFF))[32 * tn + (lane & 31)];
#pragma unroll
                        for (int i = 0; i < 16; ++i) { float x = acc[i]; if (to == tn && acc_row(i, lane) == (lane & 31)) x += 1.f; acc[i] = x * gc; }
                        st_img(acc, lds + S_GIMG * SLOT, tn * 2 + to, lane);
                    }
                }
                CK_BAR();
            }
            if (wave < 4) {
                lane = fresh_lane();
                bf16x8 hf[4]; hf[0] = acc_frag(H0a, 0); hf[1] = acc_frag(H0a, 1); hf[2] = acc_frag(H0b, 0); hf[3] = acc_frag(H0b, 1);
#pragma unroll
                for (int to = 0; to < 2; ++to) {
                    bf16x8 g0[2], g1[2], p0[2], p1[2];
#pragma unroll
                    for (int s2 = 0; s2 < 2; ++s2) {
                        g0[s2] = *(const LAS bf16x8*)(lds + S_GIMG * SLOT + (((0 * 2 + to) * 2 + s2) * 64 + lane) * 16); g1[s2] = *(const LAS bf16x8*)(lds + S_GIMG * SLOT + (((1 * 2 + to) * 2 + s2) * 64 + lane) * 16);
                        p0[s2] = *(const LAS bf16x8*)(lds + S_PIMG * SLOT + (((0 * 2 + to) * 2 + s2) * 64 + lane) * 16); p1[s2] = *(const LAS bf16x8*)(lds + S_PIMG * SLOT + (((1 * 2 + to) * 2 + s2) * 64 + lane) * 16);
                    }
                    __builtin_amdgcn_sched_barrier(0);
#pragma unroll
                    for (int s2 = 0; s2 < 2; ++s2) { const int ks = 2 * to + s2;
                        accN0 = __builtin_amdgcn_mfma_f32_32x32x16_bf16(g0[s2], hf[ks], accN0, 0, 0, 0); accN1 = __builtin_amdgcn_mfma_f32_32x32x16_bf16(g1[s2], hf[ks], accN1, 0, 0, 0);
                        accY0 = __builtin_amdgcn_mfma_f32_32x32x16_bf16(hf[ks], p0[s2], accY0, 0, 0, 0); accY1 = __builtin_amdgcn_mfma_f32_32x32x16_bf16(hf[ks], p1[s2], accY1, 0, 0, 0);
                    }
                }
                H0a = accN0; H0b = accN1;
                if (wave >= 2) {
#pragma unroll
                    for (int q = 0; q < 8; ++q) { pend[q] = cvtpk(accY0[2 * q], accY0[2 * q + 1]); pend[8 + q] = cvtpk(accY1[2 * q], accY1[2 * q + 1]); }
                } else {
#pragma unroll
                    for (int q = 0; q < 8; ++q) { pend[q] = pk_f16(accY0[2 * q], accY0[2 * q + 1]); pend[8 + q] = pk_f16(accY1[2 * q], accY1[2 * q + 1]); }
                }
            }
        }
        if (wave < 4) CK_YSTORE((qq + 1) * CPQ - 1);
#undef CK_YSTORE
        if (wave < 2) {
            const int l3 = fresh_lane();
            float* hz = (float*)(F.ws + WS_HZ) + (size_t)(unit * 2 + wave) * 2048 + l3;
#pragma unroll
            for (int i = 0; i < 16; ++i) { hz[i * 64] = H0a[i]; hz[1024 + i * 64] = H0b[i]; }
        } else if (wave < 4) {
            const int l3 = fresh_lane();
            u16* gq = (u16*)(F.ws + WS_GC) + (size_t)unit * 4096 + 32 * (wave - 2) + (l3 & 31);
#pragma unroll
            for (int i = 0; i < 16; i += 2) {
                const unsigned pa = cvtpk(H0a[i], H0a[i + 1]), pb = cvtpk(H0b[i], H0b[i + 1]);
                const int r0 = acc_row(i, l3);
                gq[r0 * 64] = (u16)(pa & 0xffffu); gq[(r0 + 1) * 64] = (u16)(pa >> 16); gq[(32 + r0) * 64] = (u16)(pb & 0xffffu); gq[(33 + r0) * 64] = (u16)(pb >> 16);
            }
        }
        CK_BAR();
    }
}
__device__ __forceinline__ void scan_fix(Frame& F) {
    using namespace ck;
    PHASE_BEGIN(F);
    LAS unsigned char* const lds = F.lds;
    const int wave = F.wave;
    enum { X_G1 = 0, X_G2 = 1, X_S1T = 2, X_S2T = 3, X_S3T = 4 };
    for (int unit = F.vcu; unit < 64 * NQ; unit += F.G) {
        const int combo = unit >> 2, j = unit & 3;
        const int b = combo >> 4, h = (combo >> 1) & 7, d = combo & 1;
        int lane = fresh_lane(); const int tid = wave * 64 + lane;
#pragma unroll
        for (int i = 0; i < 2; ++i) {
            const int p = tid + 512 * i, mat = p >> 9, row = (p >> 3) & 63, cg = p & 7;
            const v4u x = *(const v4u*)((const u16*)(F.ws + WS_GC) + (size_t)(combo * 4 + 1 + mat) * 4096 + row * 64 + 8 * cg);
            *(LAS v4u*)(lds + (X_G1 + mat) * SLOT + row * PITCH + 16 * cg) = x;
        }
        const int kt = (wave >> 1) & 1, vt = wave & 1;
        if (wave < 4) {
            const float* hz = (const float*)(F.ws + WS_HZ) + (size_t)((combo * 4 + 0) * 2 + vt) * 2048 + kt * 1024 + lane;
            f32x16 acc;
#pragma unroll
            for (int i = 0; i < 16; ++i) acc[i] = hz[i * 64];
            st_tr(acc, lds + X_S1T * SLOT, 32 * kt, 32 * vt, lane);
        }
        CK_BAR();
#pragma unroll 1
        for (int q = 1; q < 3; ++q) {
            if (wave < 4) {
                lane = fresh_lane();
                const float* hz = (const float*)(F.ws + WS_HZ) + (size_t)((combo * 4 + q) * 2 + vt) * 2048 + kt * 1024 + lane;
                f32x16 acc;
#pragma unroll
                for (int i = 0; i < 16; ++i) acc[i] = hz[i * 64];
                tile_mma<4>(acc, lds + (X_G1 + q - 1) * SLOT, 32 * kt, lds + (X_S1T + q - 1) * SLOT, 32 * vt, lane);
                st_tr(acc, lds + (X_S1T + q) * SLOT, 32 * kt, 32 * vt, lane);
            }
            CK_BAR();
        }
        lane = fresh_lane();
        const int hw = wave >> 2, tt = (wave >> 1) & 1, vt2 = wave & 1, r = lane & 31, h5 = lane >> 5;
        const int lt = (wave & 3) * 64 + lane;
        enum { X_OM = 5, X_YB = 9 };
#define FX_ADDR(cc_, i_) ((size_t)scan_row(b, d, (cc_) * C + ((lt + 256 * (i_)) >> 3)) * 1024 + d * 512 + h * 64 + 8 * ((lt + 256 * (i_)) & 7))
        v4u omr[2], yr[2];
        int c = CPQ + j + 4 * hw;
        if (c < NCHUNK) {
#pragma unroll
            for (int i = 0; i < 2; ++i) { const size_t a_ = FX_ADDR(c, i); omr[i] = *(const v4u*)((const u16*)(F.ws + WS_DEC) + a_); yr[i] = *(const v4u*)((const u16*)(F.ws + WS_PC) + a_); }
        }
        constexpr int NRND = (NCHUNK - CPQ + 7) / 8;
#pragma unroll 1
        for (int n = 0; n < NRND; ++n, c += 8) {
            const bool have = c < NCHUNK;
            LAS unsigned char* const om = lds + (X_OM + 2 * hw + (n & 1)) * SLOT; LAS unsigned char* const yb = lds + (X_YB + 2 * hw + (n & 1)) * SLOT;
            if (have) {
#pragma unroll
                for (int i = 0; i < 2; ++i) { const int p = lt + 256 * i; *(LAS v4u*)(om + (p >> 3) * PITCH + 16 * (p & 7)) = omr[i]; *(LAS v4u*)(yb + (p >> 3) * PITCH + 16 * (p & 7)) = yr[i]; }
            }
            if (c + 8 < NCHUNK) {
#pragma unroll
                for (int i = 0; i < 2; ++i) { const size_t a_ = FX_ADDR(c + 8, i); omr[i] = *(const v4u*)((const u16*)(F.ws + WS_DEC) + a_); yr[i] = *(const v4u*)((const u16*)(F.ws + WS_PC) + a_); }
            }
            CK_BAR();
            if (have) {
                const int q = c / CPQ;
                f32x16 acc = {};
                tile_mma<4>(acc, lds + (X_S1T + q - 1) * SLOT, 32 * vt2, om, 32 * tt, lane);
#pragma unroll
                for (int g = 0; g < 4; ++g) {
                    LAS v2u* yp = (LAS v2u*)(yb + (32 * tt + r) * PITCH + (32 * vt2 + 8 * g + 4 * h5) * 2);
                    const v2u yo = *yp;
                    float y0, y1, y2, y3; unpk_f16(yo.x, y0, y1); unpk_f16(yo.y, y2, y3);
                    v2u w; w.x = pk_f16(y0 + acc[4 * g], y1 + acc[4 * g + 1]); w.y = pk_f16(y2 + acc[4 * g + 2], y3 + acc[4 * g + 3]);
                    *yp = w;
                }
            }
            CK_BAR();
            if (have) {
#pragma unroll
                for (int i = 0; i < 2; ++i) { const int p = lt + 256 * i; const v4u w = *(const LAS v4u*)(yb + (p >> 3) * PITCH + 16 * (p & 7)); *(v4u*)((u16*)(F.ws + WS_PC) + FX_ADDR(c, i)) = w; }
            }
        }
#undef FX_ADDR
#define FX_LOAD(a_, b_, c_) do {} while (0)
#undef FX_LOAD
        CK_BAR();
    }
}
constexpr int CV_R = 16;
__device__ __forceinline__ void ffn_conv(Frame& F, const float* cw, const float* cb, const bool with_ctx, const bool dry = false, const bool only_ctx = false) {
    PHASE_BEGIN(F);
    const int gw = F.vcu * NWAVES + F.wave, NGW = F.G * NWAVES;
    const u16* G = (const u16*)(F.ws + WS_GATEB); u16* V = (u16*)(F.ws + WS_VALB);
    constexpr int NLATI = NB * (128 / CV_R) * 6 * 64;
    const int nitem = NLATI + (with_ctx ? NB * 6 * TC : 0);
    for (int it = gw + (only_ctx ? NLATI : 0); it < nitem; it += NGW) {
        int gc, slice, r_lo, r_hi, nrow, ncol, rowbase;
        if (it < NLATI) { gc = it & 63; int t = it >> 6; slice = t % 6; t /= 6; const int seg = t % (128 / CV_R); const int b = t / (128 / CV_R); r_lo = seg * CV_R; r_hi = r_lo + CV_R; nrow = 128; ncol = 64; rowbase = b * T; }
        else { int t = it - NLATI; gc = t & (TC - 1); t >>= 8; slice = t % 6; const int b = t / 6; r_lo = 0; r_hi = 1; nrow = 1; ncol = TC; rowbase = MLAT + b * TC; }
        const int ch = slice * 64 + F.lane;
        if (ch >= FF / 8) continue;
        const int c0 = 8 * ch;
        typedef __fp16 hh2 __attribute__((ext_vector_type(2)));
        hh2 wt[9][4], bias[4];
#pragma unroll
        for (int q = 0; q < 9; ++q) { const pg8::f32x4 a = *(const pg8::f32x4*)(cw + (size_t)q * FF + c0), b4 = *(const pg8::f32x4*)(cw + (size_t)q * FF + c0 + 4);
            wt[q][0] = __builtin_amdgcn_cvt_pkrtz(a[0], a[1]); wt[q][1] = __builtin_amdgcn_cvt_pkrtz(a[2], a[3]); wt[q][2] = __builtin_amdgcn_cvt_pkrtz(b4[0], b4[1]); wt[q][3] = __builtin_amdgcn_cvt_pkrtz(b4[2], b4[3]); }
        { const pg8::f32x4 a = *(const pg8::f32x4*)(cb + c0), b4 = *(const pg8::f32x4*)(cb + c0 + 4);
          bias[0] = __builtin_amdgcn_cvt_pkrtz(a[0], a[1]); bias[1] = __builtin_amdgcn_cvt_pkrtz(a[2], a[3]); bias[2] = __builtin_amdgcn_cvt_pkrtz(b4[0], b4[1]); bias[3] = __builtin_amdgcn_cvt_pkrtz(b4[2], b4[3]); }
        const bool hasL = gc > 0, hasR = gc + 1 < ncol;
        hh2 P[4], Q[4];
#pragma unroll
        for (int e = 0; e < 4; ++e) { P[e] = (hh2){(__fp16)0.f, (__fp16)0.f}; Q[e] = bias[e]; }
#define CV_LOAD(rr_, L_, M_, R_, V_) do { const int rr = (rr_); L_ = (v4u){0u, 0u, 0u, 0u}; M_ = L_; R_ = L_; \
            if (rr >= 0 && rr <= r_hi && rr < nrow) { const u16* p_ = G + (size_t)(rowbase + rr * ncol + gc) * FF + c0; M_ = *(const v4u*)p_; if (hasL) L_ = *(const v4u*)(p_ - FF); if (hasR) R_ = *(const v4u*)(p_ + FF); } \
            if (rr - 1 >= r_lo && rr - 1 < r_hi) V_ = *(const v4u*)(V + (size_t)(rowbase + (rr - 1) * ncol + gc) * FF + c0); } while (0)
        v4u l0, m0, r0, v0 = {0u, 0u, 0u, 0u}, l1, m1, r1, v1 = v0, l2, m2, r2, v2 = v0;
        CV_LOAD(r_lo - 1, l0, m0, r0, v0); CV_LOAD(r_lo, l1, m1, r1, v1);
        for (int rho = r_lo - 1; rho <= r_hi; ++rho) {
            CV_LOAD(rho + 2, l2, m2, r2, v2);
            const unsigned la[4] = {l0.x, l0.y, l0.z, l0.w}, ma[4] = {m0.x, m0.y, m0.z, m0.w}, ra[4] = {r0.x, r0.y, r0.z, r0.w};
            hh2 N[4];
#pragma unroll
            for (int e = 0; e < 4; ++e) {
                const hh2 a = __builtin_bit_cast(hh2, la[e]), m = __builtin_bit_cast(hh2, ma[e]), c = __builtin_bit_cast(hh2, ra[e]);
                P[e] = P[e] + wt[6][e] * a + wt[7][e] * m + wt[8][e] * c;
                Q[e] = Q[e] + wt[3][e] * a + wt[4][e] * m + wt[5][e] * c;
                N[e] = bias[e] + wt[0][e] * a + wt[1][e] * m + wt[2][e] * c;
            }
            if (rho - 1 >= r_lo) {
                float v[8], o[8], p[8]; unpk8_f16(v0, v);
#pragma unroll
                for (int e = 0; e < 4; ++e) { p[2 * e] = (float)P[e].x; p[2 * e + 1] = (float)P[e].y; }
#pragma unroll
                for (int e = 0; e < 8; ++e) o[e] = siluf_(p[e]) * v[e];
                v4u w; w.x = pk2(o[0], o[1]); w.y = pk2(o[2], o[3]); w.z = pk2(o[4], o[5]); w.w = pk2(o[6], o[7]);
                if (!dry) ST_NT3((v4u*)(V + (size_t)(rowbase + (rho - 1) * ncol + gc) * FF + c0), w); else asm volatile("" :: "v"(w));
            }
#pragma unroll
            for (int e = 0; e < 4; ++e) { P[e] = Q[e]; Q[e] = N[e]; }
            l0 = l1; m0 = m1; r0 = r1; v0 = v1; l1 = l2; m1 = m2; r1 = r2; v1 = v2;
        }
#undef CV_LOAD
    }
}
__device__ __forceinline__ void ffn_conv_first256(Frame& F, const float* cw, const float* cb) {
    const int gw = F.vcu * NWAVES + F.wave, NGW = F.G * NWAVES, lane_ = fresh_lane();
    const u16* G = (const u16*)(F.ws + WS_GATEB); u16* V = (u16*)(F.ws + WS_VALB);
    constexpr int R = 8, NITEM = NB * (128 / R / 2) * 64;
    for (int it = gw; it < NITEM; it += NGW) {
        const int gc = it & 63, t = it >> 6, segp = t % (128 / R / 2), b = t / (128 / R / 2);
        const int r_lo = (2 * segp + (lane_ >> 5)) * R, r_hi = r_lo + R, nrow = 128, ncol = 64, rowbase = b * T;
        const int c0 = 8 * (lane_ & 31);
        typedef __fp16 hh2 __attribute__((ext_vector_type(2)));
        hh2 wt[9][4], bias[4];
#pragma unroll
        for (int q = 0; q < 9; ++q) { const pg8::f32x4 a = *(const pg8::f32x4*)(cw + (size_t)q * FF + c0), b4 = *(const pg8::f32x4*)(cw + (size_t)q * FF + c0 + 4);
            wt[q][0] = __builtin_amdgcn_cvt_pkrtz(a[0], a[1]); wt[q][1] = __builtin_amdgcn_cvt_pkrtz(a[2], a[3]); wt[q][2] = __builtin_amdgcn_cvt_pkrtz(b4[0], b4[1]); wt[q][3] = __builtin_amdgcn_cvt_pkrtz(b4[2], b4[3]); }
        { const pg8::f32x4 a = *(const pg8::f32x4*)(cb + c0), b4 = *(const pg8::f32x4*)(cb + c0 + 4);
          bias[0] = __builtin_amdgcn_cvt_pkrtz(a[0], a[1]); bias[1] = __builtin_amdgcn_cvt_pkrtz(a[2], a[3]); bias[2] = __builtin_amdgcn_cvt_pkrtz(b4[0], b4[1]); bias[3] = __builtin_amdgcn_cvt_pkrtz(b4[2], b4[3]); }
        const bool hasL = gc > 0, hasR = gc + 1 < ncol;
        hh2 P[4], Q[4];
#pragma unroll
        for (int e = 0; e < 4; ++e) { P[e] = (hh2){(__fp16)0.f, (__fp16)0.f}; Q[e] = bias[e]; }
        v4u gl[R + 2], gm[R + 2], gr[R + 2], vv[R];
#pragma unroll
        for (int i = 0; i < R + 2; ++i) { const int rr = r_lo - 1 + i; gl[i] = (v4u){0u, 0u, 0u, 0u}; gm[i] = gl[i]; gr[i] = gl[i];
            if (rr >= 0 && rr < nrow) { const u16* p_ = G + (size_t)(rowbase + rr * ncol + gc) * FF + c0; gm[i] = *(const v4u*)p_; if (hasL) gl[i] = *(const v4u*)(p_ - FF); if (hasR) gr[i] = *(const v4u*)(p_ + FF); } }
#pragma unroll
        for (int i = 0; i < R; ++i) vv[i] = *(const v4u*)(V + (size_t)(rowbase + (r_lo + i) * ncol + gc) * FF + c0);
#pragma unroll
        for (int i = 0; i < R + 2; ++i) {
            const int rho = r_lo - 1 + i;
            const unsigned la[4] = {gl[i].x, gl[i].y, gl[i].z, gl[i].w}, ma[4] = {gm[i].x, gm[i].y, gm[i].z, gm[i].w}, ra[4] = {gr[i].x, gr[i].y, gr[i].z, gr[i].w};
            hh2 N[4];
#pragma unroll
            for (int e = 0; e < 4; ++e) {
                const hh2 a = __builtin_bit_cast(hh2, la[e]), m = __builtin_bit_cast(hh2, ma[e]), c = __builtin_bit_cast(hh2, ra[e]);
                P[e] = P[e] + wt[6][e] * a + wt[7][e] * m + wt[8][e] * c;
                Q[e] = Q[e] + wt[3][e] * a + wt[4][e] * m + wt[5][e] * c;
                N[e] = bias[e] + wt[0][e] * a + wt[1][e] * m + wt[2][e] * c;
            }
            if (i >= 2) {
                float v[8], o[8], p[8]; unpk8_f16(vv[i - 2], v);
#pragma unroll
                for (int e = 0; e < 4; ++e) { p[2 * e] = (float)P[e].x; p[2 * e + 1] = (float)P[e].y; }
#pragma unroll
                for (int e = 0; e < 8; ++e) o[e] = siluf_(p[e]) * v[e];
                v4u w; w.x = pk2(o[0], o[1]); w.y = pk2(o[2], o[3]); w.z = pk2(o[4], o[5]); w.w = pk2(o[6], o[7]);
                ST_NT3((v4u*)(V + (size_t)(rowbase + (rho - 1) * ncol + gc) * FF + c0), w);
            }
#pragma unroll
            for (int e = 0; e < 4; ++e) { P[e] = Q[e]; Q[e] = N[e]; }
        }
    }
}
__device__ __forceinline__ void final_norm(Frame& F, const float* fg) {
    PHASE_BEGIN(F);
    const int gw = F.vcu * NWAVES + F.wave, NGW = F.G * NWAVES;
    pg8::f32x4 gv[4];
#pragma unroll
    for (int j = 0; j < 4; ++j) gv[j] = *(const pg8::f32x4*)(fg + 4 * F.lane + 256 * j);
    for (int r = gw; r < MLAT; r += NGW) {
        float* xr = F.out + (size_t)r * D;
        const u16* xs = (const u16*)(F.ws + WS_XN) + (size_t)r * D;
        pg8::f32x4 v[4]; float ss = 0.f;
#pragma unroll
        for (int j = 0; j < 4; ++j) { const v2u xu = *(const v2u*)(xs + 4 * F.lane + 256 * j);
            v[j] = (pg8::f32x4){__uint_as_float(xu.x << 16), __uint_as_float(xu.x & 0xffff0000u), __uint_as_float(xu.y << 16), __uint_as_float(xu.y & 0xffff0000u)};
            ss += (v[j][0] * v[j][0] + v[j][1] * v[j][1]) + (v[j][2] * v[j][2] + v[j][3] * v[j][3]); }
        const float rstd = rsqrtf(wave_sum(ss) * (1.0f / D) + RMS_EPS);
#pragma unroll
        for (int j = 0; j < 4; ++j) { const pg8::f32x4 o = (v[j] * rstd) * gv[j];
#ifdef NT_FINAL
            __builtin_nontemporal_store(o, (pg8::f32x4*)(xr + 4 * F.lane + 256 * j));
#else
            *(pg8::f32x4*)(xr + 4 * F.lane + 256 * j) = o;
#endif
        }
    }
}

struct Args;

#ifndef CVP
#define CVP 0
#endif
#ifndef LORA_KBLOCK
#define LORA_KBLOCK 1
#endif
#ifndef CV_AUX
#define CV_AUX 0
#endif
struct OneUnit {
    pg8::Unit u;
    __device__ bool next(int i, pg8::Unit& o) const { if (i > 0) return false; o = u; return true; }
    __device__ __forceinline__ void a_ready(const pg8::Unit&) const {}
    __device__ __forceinline__ void done(const pg8::Unit&) const {}
};
struct EpiConv {
    static constexpr bool PERM = true, AFTER_DRAIN = true;
    EpiArgs a;
    __device__ __forceinline__ void operator()(const pg8::f32x4 (&)[2][2][4][2], const pg8::Unit&, int, int, int, int) const {}
    __device__ __forceinline__ void fused(const pg8::f32x4 (&acc)[2][2][4][2], const pg8::Unit& u, int wr, int wc, int, int, LAS unsigned char* lds, int wid, int) const {
        using pg8::f32x4;
        typedef __fp16 hh2 __attribute__((ext_vector_type(2)));
        const int l_ = fresh_lane(), fr = l_ & 15, fq = l_ >> 4;
        unsigned char* const ws_ = a.ws;
        const int row0 = u.pm * 256 + wr * 64 + fr;
        const bool ctx = u.pm >= MLAT / 256;
        const int bt = u.pm >> 5, gy0 = (u.pm & 31) * 4;
        const u16* const G = (const u16*)(ws_ + WS_GATEB);
        const float* const cw = inp(*a.ap, IN_FCW) + (size_t)a.l * 9 * FF;
        const float* const cb = inp(*a.ap, IN_FCB) + (size_t)a.l * FF;
        const int q16 = wc * 4 + fq;
#pragma unroll
        for (int bj = 0; bj < 2; ++bj) {
            const int cbase = (u.pn + a.goff) * 256 + bj * 128;
            {
                const int chunk = fr ^ ((wid & 3) * 4 + fq);
                const unsigned voff = (unsigned)((wid * 4 + fq) * FF + chunk * 8) * 2u;
#pragma unroll
                for (int sg = 0; sg < 6; ++sg) {
                    const int gy = gy0 - 1 + sg;
                    const bool have = ctx ? (sg >= 1 && sg <= 4) : (gy >= 0 && gy < 128);
                    const int rowb = ctx ? (MLAT + (u.pm - MLAT / 256) * TC + (sg - 1) * 64) : (bt * T + gy * 64);
                    const char* const ub = (const char*)(G + (size_t)rowb * FF + cbase);
#pragma unroll
                    for (int jp = 0; jp < 2; ++jp) {
                        const int i = 16 * sg + 8 * jp + wid;
                        if (have)
                            __builtin_amdgcn_global_load_lds((const unsigned*)(ub + (size_t)jp * 32 * FF * 2 + voff), (LAS unsigned*)(lds + 256 + i * 1024), 16, 0, CV_AUX);
                        else { unsigned z0 = 0u; asm volatile("" : "+v"(z0)); *(LAS v4u*)(lds + 256 + i * 1024 + l_ * 16) = (v4u){z0, z0, z0, z0}; }
                    }
                }
            }
            const int c0 = cbase + q16 * 8;
            hh2 wt[9][4], bias[4];
            const float* cwb = cw; const float* cbb = cb; asm volatile("" : "+s"(cwb), "+s"(cbb));
#pragma unroll
            for (int q = 0; q < 9; ++q) { const f32x4 x = *(const f32x4*)(cwb + (size_t)q * FF + c0), y = *(const f32x4*)(cwb + (size_t)q * FF + c0 + 4);
                wt[q][0] = __builtin_amdgcn_cvt_pkrtz(x[0], x[1]); wt[q][1] = __builtin_amdgcn_cvt_pkrtz(x[2], x[3]); wt[q][2] = __builtin_amdgcn_cvt_pkrtz(y[0], y[1]); wt[q][3] = __builtin_amdgcn_cvt_pkrtz(y[2], y[3]); }
            { const f32x4 x = *(const f32x4*)(cbb + c0), y = *(const f32x4*)(cbb + c0 + 4);
              bias[0] = __builtin_amdgcn_cvt_pkrtz(x[0], x[1]); bias[1] = __builtin_amdgcn_cvt_pkrtz(x[2], x[3]); bias[2] = __builtin_amdgcn_cvt_pkrtz(y[0], y[1]); bias[3] = __builtin_amdgcn_cvt_pkrtz(y[2], y[3]); }
            if (ctx) {
#pragma unroll
                for (int q = 0; q < 9; ++q) if (q < 3 || q >= 6) {
#pragma unroll
                    for (int e = 0; e < 4; ++e) wt[q][e] = __builtin_bit_cast(hh2, 0u); }
            }
#pragma unroll
            for (int q = 0; q < 9; ++q) asm volatile("" : "+v"(wt[q][0]), "+v"(wt[q][1]), "+v"(wt[q][2]), "+v"(wt[q][3]));
            const LAS unsigned char* bp[2][3];
#pragma unroll
            for (int dx = 0; dx < 3; ++dx) {
                const int sw = (q16 ^ ((fr + dx - 1) & 15)) << 4;
                bp[0][dx] = lds + 256 + (wr * 64 + fr + dx - 1) * 256 + sw; bp[1][dx] = bp[0][dx] + 2 * 64 * 256;
            }
            const unsigned mLa[2] = {(fr == 0 && (!ctx || wr == 0)) ? 0u : 0xffffffffu, (fr == 0 && !ctx) ? 0u : 0xffffffffu};
            const unsigned mRa[2] = {(fr == 15 && !ctx) ? 0u : 0xffffffffu, (fr == 15 && (!ctx || wr == 1)) ? 0u : 0xffffffffu};
            asm volatile("s_waitcnt vmcnt(0) lgkmcnt(0)" ::: "memory");
            __builtin_amdgcn_s_barrier();
            asm volatile("" ::: "memory");
            v4u tt[2][3];
#define CV_LD(dst_, ai_, m_, dy_) do { _Pragma("unroll") for (int dx = 0; dx < 3; ++dx) dst_[dx] = *(const LAS v4u*)(bp[ai_][dx] + ((dy_) * 64 + 16 * (m_)) * 256); } while (0)
#define CV_FMA(src_, ai_, m_, dy_) do { _Pragma("unroll") for (int dx = 0; dx < 3; ++dx) { v4u tp = src_[dx]; \
                if ((m_) == 0 && dx == 0) { const unsigned mk = mLa[ai_]; tp.x &= mk; tp.y &= mk; tp.z &= mk; tp.w &= mk; } \
                if ((m_) == 3 && dx == 2) { const unsigned mk = mRa[ai_]; tp.x &= mk; tp.y &= mk; tp.z &= mk; tp.w &= mk; } \
                const unsigned ta[4] = {tp.x, tp.y, tp.z, tp.w}; \
                _Pragma("unroll") for (int e = 0; e < 4; ++e) P[e] = P[e] + wt[3 * (dy_) + dx][e] * __builtin_bit_cast(hh2, ta[e]); } } while (0)
            CV_LD(tt[0], 0, 0, 0);
#pragma unroll
            for (int ai = 0; ai < 2; ++ai)
#pragma unroll
                for (int m = 0; m < 4; ++m) {
                    hh2 P[4] = {bias[0], bias[1], bias[2], bias[3]};
                    CV_LD(tt[(m & 1) ^ 1], ai, m, 1);
                    __builtin_amdgcn_sched_barrier(0);
                    CV_FMA(tt[m & 1], ai, m, 0);
                    __builtin_amdgcn_sched_barrier(0);
                    CV_LD(tt[m & 1], ai, m, 2);
                    __builtin_amdgcn_sched_barrier(0);
                    CV_FMA(tt[(m & 1) ^ 1], ai, m, 1);
                    __builtin_amdgcn_sched_barrier(0);
                    if (ai * 4 + m < 7) CV_LD(tt[(m & 1) ^ 1], (ai * 4 + m + 1) >> 2, (m + 1) & 3, 0);
                    __builtin_amdgcn_sched_barrier(0);
                    CV_FMA(tt[m & 1], ai, m, 2);
                    const f32x4 v0 = acc[ai][bj][m][0], v1 = acc[ai][bj][m][1];
                    const float vv[8] = {v0[0], v0[1], v0[2], v0[3], v1[0], v1[1], v1[2], v1[3]};
                    float o[8];
#pragma unroll
                    for (int e = 0; e < 4; ++e) { o[2 * e] = siluf_((float)P[e].x) * vv[2 * e]; o[2 * e + 1] = siluf_((float)P[e].y) * vv[2 * e + 1]; }
                    v4u w; w.x = pk2(o[0], o[1]); w.y = pk2(o[2], o[3]); w.z = pk2(o[4], o[5]); w.w = pk2(o[6], o[7]);
                    ST16L(8, u.last, (u16*)(ws_ + WS_VALB) + (size_t)(row0 + ai * 128 + m * 16) * FF + c0, w);
                    asm volatile("" ::: "memory");
                }
#undef CV_LD
#undef CV_FMA
            asm volatile("s_waitcnt lgkmcnt(0)" ::: "memory");
            __builtin_amdgcn_s_barrier();
            asm volatile("" ::: "memory");
        }
    }
};
struct Args { const float* in[26]; float* out; unsigned char* ws; };
__device__ __forceinline__ const float* inp(const Args& a, int i) { asm volatile("" : "+s"(i)); return a.in[i]; }
struct RepeatOrder {
    int nM, nN, R, c;
    __device__ bool next(int i, pg8::Unit& u) const { if (i >= R) return false; u.pm = c % nM; u.pn = (c / 8) % nN; u.koff = 0; return true; }
    __device__ __forceinline__ void a_ready(const pg8::Unit&) const {}
    __device__ __forceinline__ void done(const pg8::Unit&) const {}
};
template <int MODE> __device__ __forceinline__ void run_gemm_rep(Frame& F, const u16* A, const u16* Bt, int Mr, int N, int K, int R, const EpiArgs& ea) {
    pg8::Gemm g{A, Bt, Mr, N, K, K}; RepeatOrder S{Mr / 256, N / 256, R, (int)blockIdx.x};
    Epi<MODE> E{ea};
    pg8::gemm_phase<Epi<MODE>, RepeatOrder, true, true>(F.lds + RING_OFF, g, S, E, F.wave);
}
template <int MODE> __device__ __forceinline__ void run_gemm_k(Frame& F, const u16* A, const u16* Bt, int Mr, int N, int K, int ld, const EpiArgs& ea) {
    pg8::Gemm g{A, Bt, Mr, N, K, ld}; pg8::StaticOrder S; S.init(Mr, N, F.G, (int)blockIdx.x);
    Epi<MODE> E{ea};
    pg8::gemm_phase<Epi<MODE>, pg8::StaticOrder, true, true>(F.lds + RING_OFF, g, S, E, F.wave);
}
template <int MODE, bool AL> __device__ __forceinline__ void run_gemm_al(Frame& F, const u16* A, const u16* Bt, int Mr, int N, int K, const EpiArgs& ea) {
    pg8::Gemm g{A, Bt, Mr, N, K, K}; pg8::StaticOrder S; S.init(Mr, N, F.G, (int)blockIdx.x);
    Epi<MODE> E{ea};
    pg8::gemm_phase<Epi<MODE>, pg8::StaticOrder, AL, true>(F.lds + RING_OFF, g, S, E, F.wave);
}
#ifndef GV_AL
#define GV_AL true
#endif
#ifndef GV_SP
#define GV_SP true
#endif
#ifndef GV_MODE
#define GV_MODE -1
#endif
template <int MODE> __device__ __forceinline__ void run_gemm(Frame& F, const u16* A, const u16* Bt, int Mr, int N, int K, const EpiArgs& ea) {
    pg8::Gemm g{A, Bt, Mr, N, K, K}; pg8::StaticOrder S; S.init(Mr, N, F.G, (int)blockIdx.x);
    Epi<MODE> E{ea};
    if constexpr (MODE == GV_MODE) pg8::gemm_phase<Epi<MODE>, pg8::StaticOrder, GV_AL, GV_SP>(F.lds + RING_OFF, g, S, E, F.wave);
    else pg8::gemm_phase<Epi<MODE>, pg8::StaticOrder, true, true>(F.lds + RING_OFF, g, S, E, F.wave);
}
struct CtxSplitOrder {
    int nsplit, ksb, total, G, c;
    __device__ bool next(int i, pg8::Unit& u) const {
        const int L = i * G + c; if (L >= total) return false;
        const int t = L / nsplit, ks = L - t * nsplit;
        u.pm = MLAT / 256 + (t >> 2); u.pn = t & 3; u.koff = ks * ksb; u.last = ks; return true; }
    __device__ __forceinline__ void a_ready(const pg8::Unit&) const {}
    __device__ __forceinline__ void done(const pg8::Unit&) const {}
};
__device__ __forceinline__ void run_gemm_ctx(Frame& F, const u16* A, const u16* Bt, int K, int nsplit, const EpiArgs& ea) {
    pg8::Gemm g{A, Bt, M, D, K / nsplit, K}; CtxSplitOrder S{nsplit, (K / nsplit) * 2, 16 * nsplit, F.G, (int)blockIdx.x};
    Epi<5> E{ea};
    pg8::gemm_phase<Epi<5>, CtxSplitOrder, true, true>(F.lds + RING_OFF, g, S, E, F.wave);
}
__device__ __forceinline__ void run_gemm_conv(Frame& F, const u16* A, const u16* Bt, int Mr, int N, int K, const EpiArgs& ea) {
    pg8::Gemm g{A, Bt, Mr, N, K, K}; pg8::StaticOrder S; S.init(Mr, N, F.G, (int)blockIdx.x);
    EpiConv E{ea};
#pragma unroll 1
    for (int i = 0;; ++i) {
        OneUnit O; if (!S.next(i, O.u)) break;
        pg8::gemm_phase<EpiConv, OneUnit, false, true>(F.lds + RING_OFF, g, O, E, F.wave);
    }
}
__global__ void __launch_bounds__(NWAVES * 64, 2) mk_fwd(Args args) {
    extern __shared__ __attribute__((aligned(16))) unsigned char lds[];
    Frame F;
    F.lds = (LAS unsigned char*)lds;
    F.MISC = (volatile LAS unsigned*)(F.lds + MISC_OFF);
    F.tid = threadIdx.x; F.lane = F.tid & 63; F.wave = __builtin_amdgcn_readfirstlane(F.tid >> 6);
    F.G = gridDim.x; { const int bx = blockIdx.x; F.vcu = (F.G % 8 == 0) ? (bx % 8) * (F.G / 8) + bx / 8 : bx; }
    unsigned char* ws = args.ws; F.ws = ws;
    F.ctl = (gu32*)(ws + WS_CTL);
    F.out = args.out;
    for (int u = F.tid; u < (LDS_BYTES - LDSCTL_OFF) / 4; u += NWAVES * 64) ((LAS unsigned*)(F.lds + LDSCTL_OFF))[u] = 0u;
    __syncthreads();
    XcdBarrier bar = xcd_barrier_post((unsigned*)(F.ctl + CW_BAR), F.MISC + 8);
#ifdef DUPBAR
#define GRID_BAR() do { xcd_barrier(bar, F.wave); xcd_barrier(bar, F.wave); } while (0)
#else
#define GRID_BAR() xcd_barrier(bar, F.wave)
#endif

#if (PHM & 1)
        for (int rep_ = 0; rep_ < (((DUPM) & 1) ? 2 : 1); ++rep_) {
    p0_mod(F, inp(args, IN_C), inp(args, IN_CCTX), inp(args, IN_ADAW), inp(args, IN_ADAB));
        }
#endif
#if (PHM & 2)
        for (int rep_ = 0; rep_ < (((DUPM) & 2) ? 2 : 1); ++rep_) {
    p0_weights(F, inp(args, IN_WIN), inp(args, IN_WOUT), inp(args, IN_FUP), inp(args, IN_FDN), inp(args, IN_WUP), inp(args, IN_AUP), inp(args, IN_GUP));
        }
#endif
    GRID_BAR();

    float* xctx = (float*)(ws + WS_XCTX);
    const float* mod = (const float*)(ws + WS_MOD);
    for (int l = 0; l < NL; ++l) {
        const float* modl = mod + (size_t)l * 5 * NMOD;
        const float* xl = (l == 0) ? inp(args, IN_X) : F.out;
        const float* xc = (l == 0) ? inp(args, IN_CTX) : xctx;
        const int Mpost = (l == NL - 1) ? MLAT : M;
#if (PHM & 4)
        for (int rep_ = 0; rep_ < (((DUPM) & 4) ? 2 : 1); ++rep_) {
        norm_rows(F, xl, xc, l != 0, inp(args, IN_N1G) + l * D, modl, 0, 1024, (l == 0) ? M : MLAT);
        if (l > 0) norm_ctx_fix<11>(F, nullptr, (u16*)xctx, mod + (size_t)(l - 1) * 5 * NMOD + 5120 + 4 * NMOD, inp(args, IN_N1G) + l * D, modl, 0, 1024);
        }
#endif
        GRID_BAR();
#ifdef PROBE_G1
        { EpiArgs ea{ws, F.out, &args, l, 0, 0}; run_gemm<0>(F, (const u16*)(ws + WS_XN), (const u16*)(ws + WS_WIN) + (size_t)l * PROJ * D, M, PROJ, D, ea); }
#endif
#if (PHM & 8)
        for (int rep_ = 0; rep_ < (((DUPM) & 8) ? 2 : 1); ++rep_) {
        { EpiArgs ea{ws, F.out, &args, l, 0, 0};
          run_gemm<1>(F, (const u16*)(ws + WS_XN), (const u16*)(ws + WS_WIN) + (size_t)l * PROJ * D, M, PROJ, D, ea); }
        }
#endif
        GRID_BAR();
#if (PHM & 16)
        for (int rep_ = 0; rep_ < (((DUPM) & 16) ? 2 : 1); ++rep_) {
        conv_branch(F, inp(args, IN_CONVA) + (size_t)l * 3 * DC, Mpost);
        }
#endif
#if (PHM & 32)
        for (int rep_ = 0; rep_ < (((DUPM) & 32) ? 2 : 1); ++rep_) {
        { EpiArgs ea{ws, F.out, &args, l, 0, 0};
#if LORA_KBLOCK
          { pg8::Gemm g{(const u16*)(ws + WS_ALORA), (const u16*)(ws + WS_BLORA) + (size_t)l * NLORA * KLORA, M, NLORA, KLORA / 2, KLORA};
            pg8::KBlockOrder S; S.init(M, NLORA, F.G, (int)blockIdx.x, 8, (KLORA / 2) * 2);
            Epi<2> E{ea};
            pg8::gemm_phase<Epi<2>, pg8::KBlockOrder, true, true>(F.lds + RING_OFF, g, S, E, F.wave); } }
#else
          run_gemm<2>(F, (const u16*)(ws + WS_ALORA), (const u16*)(ws + WS_BLORA) + (size_t)l * NLORA * KLORA, M, NLORA, KLORA, ea); }
#endif
        }
#endif
        GRID_BAR();
#if (PHM & 64)
        for (int rep_ = 0; rep_ < (((DUPM) & 64) ? 2 : 1); ++rep_) {
        scan_phase(F, inp(args, IN_KK) + l * DR, inp(args, IN_KA) + l * DR);
        }
#endif
        GRID_BAR();
#if (PHM & 64)
        scan_fix(F);
#endif
        GRID_BAR();
#if (PHM & 128)
        for (int rep_ = 0; rep_ < (((DUPM) & 128) ? 2 : 1); ++rep_) {
        rwkv_out(F, inp(args, IN_LNG) + l * DR, inp(args, IN_LNB) + l * DR, inp(args, IN_RK) + l * DR, Mpost);
        }
#endif
        GRID_BAR();
#ifdef PROBE_G24
        { EpiArgs ea{ws, F.out, &args, l, 0, 0}; run_gemm<0>(F, (const u16*)(ws + WS_XN), (const u16*)(ws + WS_WOUT) + (size_t)l * D * D, PROBE_G24 ? MLAT : Mpost, D, D, ea); }
#endif
#if (PHM & 256)
        for (int rep_ = 0; rep_ < (((DUPM) & 256) ? 2 : 1); ++rep_) {
        { EpiArgs ea{ws, F.out, &args, l, l == 0 ? 1 : 0, 2048};
          run_gemm<3>(F, (const u16*)(ws + WS_XN), (const u16*)(ws + WS_WOUT) + (size_t)l * D * D, MLAT, D, D, ea);
          if (l < NL - 1) run_gemm_ctx(F, (const u16*)(ws + WS_XN), (const u16*)(ws + WS_WOUT) + (size_t)l * D * D, D, 8, ea); }
        }
#endif
        GRID_BAR();
#if (PHM & 512)
        for (int rep_ = 0; rep_ < (((DUPM) & 512) ? 2 : 1); ++rep_) {
        norm_rows(F, F.out, xctx, true, inp(args, IN_N2G) + l * D, modl, 3072, 4096, MLAT);
        if (l < NL - 1) norm_ctx_fix<8>(F, (l == 0) ? inp(args, IN_CTX) : nullptr, (u16*)xctx, mod + (size_t)l * 5 * NMOD + 2048 + 4 * NMOD, inp(args, IN_N2G) + l * D, modl, 3072, 4096);
        }
#endif
        GRID_BAR();
#ifdef PROBE_G3R
        { EpiArgs ea{ws, F.out, &args, l, 0, 0}; run_gemm_rep<0>(F, (const u16*)(ws + WS_XN), (const u16*)(ws + WS_WUP) + (size_t)l * 2 * FF * D, Mpost, 2 * FF, D, (l == 0) ? 12 : 11, ea); }
#endif
#ifdef PROBE_G3K
        { EpiArgs ea{ws, F.out, &args, l, 0, 0}; int kk_ = PROBE_G3K; asm volatile("" : "+s"(kk_)); int ld_ = PROBE_G3LD; asm volatile("" : "+s"(ld_)); run_gemm_k<0>(F, (const u16*)(ws + WS_XN), (const u16*)(ws + WS_WUP) + (size_t)l * 2 * FF * D, Mpost, 2 * FF, kk_, ld_, ea); }
#endif
#ifdef PROBE_G3B
        { EpiArgs ea{ws, F.out, &args, l, 0, 0}; run_gemm_al<0, false>(F, (const u16*)(ws + WS_XN), (const u16*)(ws + WS_WUP) + (size_t)l * 2 * FF * D, Mpost, 2 * FF, D, ea); }
#endif
#ifdef PROBE_G3
        { EpiArgs ea{ws, F.out, &args, l, 0, 0}; run_gemm<0>(F, (const u16*)(ws + WS_XN), (const u16*)(ws + WS_WUP) + (size_t)l * 2 * FF * D, Mpost, 2 * FF, D, ea); }
#endif
#if (PHM & 1024)
        for (int rep_ = 0; rep_ < (((DUPM) & 1024) ? 2 : 1); ++rep_)
        { EpiArgs ea{ws, F.out, &args, l, 0, 0};
          const int unfa = (__builtin_amdgcn_readfirstlane(l) == NL - 1) ? 1 : 0;
          run_gemm<4>(F, (const u16*)(ws + WS_XN), (const u16*)(ws + WS_WUP) + (size_t)l * 2 * FF * D, Mpost, FF + unfa * 256, D, ea); }
        GRID_BAR();
        for (int rep_ = 0; rep_ < (((DUPM) & 2048) ? 2 : 1); ++rep_)
        { const int unf = (__builtin_amdgcn_readfirstlane(l) == NL - 1) ? 1 : 0;
          EpiArgs ea{ws, F.out, &args, l, 0, unf};
          run_gemm_conv(F, (const u16*)(ws + WS_XN), (const u16*)(ws + WS_WUP) + ((size_t)l * 2 * FF + FF + unf * 256) * D, Mpost, FF - unf * 256, D, ea);
        }
        if (__builtin_amdgcn_readfirstlane(l) == NL - 1) ffn_conv_first256(F, inp(args, IN_FCW) + (size_t)l * 9 * FF, inp(args, IN_FCB) + (size_t)l * FF);
#endif
        GRID_BAR();
#ifdef PROBE_G24
        { EpiArgs ea{ws, F.out, &args, l, 0, 0}; run_gemm<0>(F, (const u16*)(ws + WS_VALB), (const u16*)(ws + WS_WDN) + (size_t)l * D * FF, PROBE_G24 ? MLAT : Mpost, D, FF, ea); }
#endif
#if (PHM & 4096)
        for (int rep_ = 0; rep_ < (((DUPM) & 4096) ? 2 : 1); ++rep_) {
        { EpiArgs ea{ws, F.out, &args, l, 0, 5120};
          run_gemm<3>(F, (const u16*)(ws + WS_VALB), (const u16*)(ws + WS_WDN) + (size_t)l * D * FF, MLAT, D, FF, ea);
          if (l < NL - 1) run_gemm_ctx(F, (const u16*)(ws + WS_VALB), (const u16*)(ws + WS_WDN) + (size_t)l * D * FF, FF, 11, ea); }
        }
#endif
        GRID_BAR();
    }
#if (PHM & 8192)
        for (int rep_ = 0; rep_ < (((DUPM) & 8192) ? 2 : 1); ++rep_) {
    final_norm(F, inp(args, IN_FG));
        }
#endif
}

extern "C" void kernel_launch(void* const* d_in, const int* in_sizes, int n_in, void* d_out, int out_size, void* d_ws, size_t ws_size, hipStream_t stream) {
    static int grid = 0;
    if (grid == 0) {
        if (n_in != 26 || out_size != MLAT * D || ws_size < WS_END) { fprintf(stderr, "kernel_launch: unexpected shapes n_in %d out %d ws %zu\n", n_in, out_size, ws_size); grid = -1; return; }
        int dev = 0, cus = 0, per_cu = 0;
        if (hipGetDevice(&dev) != hipSuccess || hipDeviceGetAttribute(&cus, hipDeviceAttributeMultiprocessorCount, dev) != hipSuccess) { grid = -1; return; }
        if (hipFuncSetAttribute((const void*)mk_fwd, hipFuncAttributeMaxDynamicSharedMemorySize, LDS_BYTES) != hipSuccess) { fprintf(stderr, "kernel_launch: hipFuncSetAttribute failed\n"); grid = -1; return; }
        if (hipOccupancyMaxActiveBlocksPerMultiprocessor(&per_cu, (const void*)mk_fwd, NWAVES * 64, LDS_BYTES) != hipSuccess || per_cu < 1) fprintf(stderr, "kernel_launch: occupancy query says %d\n", per_cu);
        (void)hipGetLastError();
        grid = cus;
    }
    if (grid < 0) return;
    if (hipMemsetAsync((char*)d_ws + WS_CTL, 0, CTL_ZERO_BYTES, stream) != hipSuccess) { fprintf(stderr, "kernel_launch: memset failed\n"); return; }
    Args a{};
    for (int i = 0; i < 26; ++i) a.in[i] = (const float*)d_in[i];
    a.out = (float*)d_out; a.ws = (unsigned char*)d_ws;
    hipLaunchKernelGGL(mk_fwd, dim3(grid), dim3(NWAVES * 64), LDS_BYTES, stream, a);
    const hipError_t le = hipPeekAtLastError();
    if (le != hipSuccess) fprintf(stderr, "kernel_launch: launch failed: %s\n", hipGetErrorName(le));
}
```
